# Optimizing an MI355X kernel written in HIP

```python
import math
import jax
import jax.numpy as jnp
from jax import lax
import numpy as np

D_MODEL = 4096
BATCH = 2
SEQ = 4096
DEPTH = 2

GRID_W = 64
CTX_LEN = 256
HEAD_DIM = 128
A_HEADS = 12
A_KV_HEADS = 4
A_GROUP = A_HEADS // A_KV_HEADS
B_HEADS = 12
NA_KH = 8
NA_KW = 16
C_HEADS = 8
C_QK_DIM = 64
C_V_DIM = 2 * C_QK_DIM
FFN_DIM = 7168
Q_BLOCK = 128
ROPE_THETA = 10000.0
EPS = 1e-6
N_MOD = 9

A_Q_W = A_HEADS * HEAD_DIM
A_KV_W = A_KV_HEADS * HEAD_DIM
B_W = B_HEADS * HEAD_DIM
C_QK_W = C_HEADS * 2 * C_QK_DIM
C_V_W = C_HEADS * C_V_DIM
IN_SIZES = (A_Q_W, A_KV_W, A_KV_W, B_W, B_W, B_W, C_QK_W, C_QK_W, C_V_W, 3 * D_MODEL)
IN_WIDTH = 22528

kernel_name = "hybrid_gated_dit_trunk"


def rms_norm(x, g):
    xf = x.astype(jnp.float32)
    y = xf * lax.rsqrt(jnp.mean(xf * xf, axis=-1, keepdims=True) + EPS)
    return (y * g.astype(jnp.float32)).astype(x.dtype)


def mod_norm(x, g, shift, scale):
    return rms_norm(x, g) * (1.0 + scale) + shift


def ada_mod(cvec, w_ada, b_ada):
    m = jax.nn.silu(cvec) @ w_ada + b_ada
    return m.reshape(cvec.shape[0], N_MOD, 1, D_MODEL)


def swiglu(h, w_in, w_out):
    gate, up = jnp.split(h @ w_in, 2, axis=-1)
    return (jax.nn.silu(gate) * up) @ w_out


def heads(t, n, d):
    return t.reshape(*t.shape[:-1], n, d)


def split_projection(p):
    offsets = tuple(int(o) for o in np.cumsum(IN_SIZES)[:-1])
    return jnp.split(p, offsets, axis=-1)


def axial_rope(n_tok, dim):
    t = jnp.arange(n_tok, dtype=jnp.int32)
    row = (t // GRID_W).astype(jnp.float32)
    col = (t % GRID_W).astype(jnp.float32)
    n_pairs = dim // 4
    inv = ROPE_THETA ** (-jnp.arange(n_pairs, dtype=jnp.float32) / n_pairs)
    ang = jnp.concatenate([row[:, None] * inv, col[:, None] * inv], axis=-1)
    return jnp.cos(ang), jnp.sin(ang)


def apply_rope(x, cos, sin):
    shape = (cos.shape[0],) + (1,) * (x.ndim - 3) + (cos.shape[1],)
    c, s = cos.reshape(shape), sin.reshape(shape)
    xf = x.astype(jnp.float32).reshape(*x.shape[:-1], -1, 2)
    x1, x2 = xf[..., 0], xf[..., 1]
    out = jnp.stack([x1 * c - x2 * s, x1 * s + x2 * c], axis=-1)
    return out.reshape(x.shape).astype(x.dtype)


def sweep_query_blocks(fn, q):
    b, s = q.shape[:2]
    nb = s // Q_BLOCK
    qb = jnp.moveaxis(q.reshape(b, nb, Q_BLOCK, *q.shape[2:]), 1, 0)
    ob = lax.map(fn, qb)
    return jnp.moveaxis(ob, 0, 1).reshape(b, s, *ob.shape[3:])


def gqa_core(q, k, v):
    s = jnp.einsum('bqhgd,bkhd->bhgqk', q, k, preferred_element_type=jnp.float32) * (q.shape[-1] ** -0.5)
    p = jax.nn.softmax(s, axis=-1).astype(v.dtype)
    o = jnp.einsum('bhgqk,bkhd->bqhgd', p, v)
    return o.reshape(*o.shape[:2], -1)


def diff_core(q, k, v, lam):
    s = jnp.einsum('bqhcd,bkhcd->bhcqk', q, k, preferred_element_type=jnp.float32) * (q.shape[-1] ** -0.5)
    p = jax.nn.softmax(s, axis=-1)
    a = (p[:, :, 0] - lam * p[:, :, 1]).astype(v.dtype)
    return jnp.einsum('bhqk,bkhd->bqhd', a, v)


def diff_heads_out(o, subln_g, lam_init):
    return (rms_norm(o, subln_g) * (1.0 - lam_init)).reshape(*o.shape[:2], -1)


def neighbourhood_attention(q, k, v, k_ctx, v_ctx, rel_bias, rows):
    b, s, h, d = q.shape
    kh, kw = min(NA_KH, rows), NA_KW
    qg = q.reshape(b, rows, GRID_W, h, d)
    kg = k.reshape(b, rows, GRID_W, h, d)
    vg = v.reshape(b, rows, GRID_W, h, d)
    cols = jnp.arange(GRID_W, dtype=jnp.int32)
    cs = jnp.clip(cols - kw // 2, 0, GRID_W - kw)
    col_idx = cs[:, None] + jnp.arange(kw, dtype=jnp.int32)[None]
    dc = col_idx - cols[:, None]
    scale = d ** -0.5
    n_win = kh * kw

    def row_block(r):
        rs = jnp.clip(r - kh // 2, 0, rows - kh)
        k_band = lax.dynamic_slice_in_dim(kg, rs, kh, axis=1)
        v_band = lax.dynamic_slice_in_dim(vg, rs, kh, axis=1)
        k_win = k_band[:, :, col_idx]
        v_win = v_band[:, :, col_idx]
        q_r = lax.dynamic_index_in_dim(qg, r, axis=1, keepdims=False)
        dr = rs + jnp.arange(kh, dtype=jnp.int32) - r
        bias = rel_bias[:, dr[:, None, None] + (NA_KH - 1), dc[None] + (NA_KW - 1)]
        bias = jnp.transpose(bias, (0, 2, 1, 3)).reshape(h, GRID_W, n_win)
        s_win = jnp.einsum('bchd,bicjhd->bhcij', q_r, k_win,
                           preferred_element_type=jnp.float32).reshape(b, h, GRID_W, n_win) * scale + bias
        s_ctx = jnp.einsum('bchd,blhd->bhcl', q_r, k_ctx, preferred_element_type=jnp.float32) * scale
        p = jax.nn.softmax(jnp.concatenate([s_win, s_ctx], axis=-1), axis=-1).astype(v.dtype)
        p_win = p[..., :n_win].reshape(b, h, GRID_W, kh, kw)
        p_ctx = p[..., n_win:]
        return (jnp.einsum('bhcij,bicjhd->bchd', p_win, v_win)
                + jnp.einsum('bhcl,blhd->bchd', p_ctx, v_ctx))

    o = lax.map(row_block, jnp.arange(rows, dtype=jnp.int32))
    return jnp.moveaxis(o, 0, 1).reshape(b, s, h * d)


def prep_a(qa, ka, va, gain, rope):
    q = rms_norm(heads(qa, A_HEADS, HEAD_DIM), gain[0])
    k = rms_norm(heads(ka, A_KV_HEADS, HEAD_DIM), gain[1])
    if rope is not None:
        q, k = apply_rope(q, *rope), apply_rope(k, *rope)
    q = q.reshape(*q.shape[:2], A_KV_HEADS, A_GROUP, HEAD_DIM)
    return q, k, heads(va, A_KV_HEADS, HEAD_DIM)


def prep_b(qb, kb, vb, gain):
    q = rms_norm(heads(qb, B_HEADS, HEAD_DIM), gain[0])
    k = rms_norm(heads(kb, B_HEADS, HEAD_DIM), gain[1])
    return q, k, heads(vb, B_HEADS, HEAD_DIM)


def prep_c(qc, kc, vc, gain, rope):
    q = rms_norm(qc.reshape(*qc.shape[:-1], C_HEADS, 2, C_QK_DIM), gain[0])
    k = rms_norm(kc.reshape(*kc.shape[:-1], C_HEADS, 2, C_QK_DIM), gain[1])
    if rope is not None:
        q, k = apply_rope(q, *rope), apply_rope(k, *rope)
    return q, k, heads(vc, C_HEADS, C_V_DIM)


def gated_merge(o_a, o_b, o_c, gates, w_br_a, w_br_b, w_br_c, w_out):
    g_a, g_b, g_c = jnp.split(jax.nn.sigmoid(gates), 3, axis=-1)
    m = g_a * (o_a @ w_br_a) + g_b * (o_b @ w_br_b) + g_c * (o_c @ w_br_c)
    return m @ w_out


def token_mixing(hx, hc, w_in, qk_gain_a, qk_gain_b, qk_gain_c, na_rel_bias, diff_lambda, diff_subln,
                 lam_init, w_br_a, w_br_b, w_br_c, w_out, rope_a, rope_c, rows, with_ctx_out):
    qa, ka, va, qb, kb, vb, qc, kc, vc, gx = split_projection(hx @ w_in)
    qa_c, ka_c, va_c, qb_c, kb_c, vb_c, qc_c, kc_c, vc_c, gc = split_projection(hc @ w_in)

    qa, ka, va = prep_a(qa, ka, va, qk_gain_a, rope_a)
    qa_c, ka_c, va_c = prep_a(qa_c, ka_c, va_c, qk_gain_a, None)
    ka_all = jnp.concatenate([ka, ka_c], axis=1)
    va_all = jnp.concatenate([va, va_c], axis=1)
    o_a = sweep_query_blocks(lambda q: gqa_core(q, ka_all, va_all), qa)

    qb, kb, vb = prep_b(qb, kb, vb, qk_gain_b)
    qb_c, kb_c, vb_c = prep_b(qb_c, kb_c, vb_c, qk_gain_b)
    o_b = neighbourhood_attention(qb, kb, vb, kb_c, vb_c, na_rel_bias, rows)

    lam = (jnp.exp(jnp.sum(diff_lambda[0] * diff_lambda[1]).astype(jnp.float32))
           - jnp.exp(jnp.sum(diff_lambda[2] * diff_lambda[3]).astype(jnp.float32)) + lam_init)
    qc, kc, vc = prep_c(qc, kc, vc, qk_gain_c, rope_c)
    qc_c, kc_c, vc_c = prep_c(qc_c, kc_c, vc_c, qk_gain_c, None)
    kc_all = jnp.concatenate([kc, kc_c], axis=1)
    vc_all = jnp.concatenate([vc, vc_c], axis=1)
    o_c = diff_heads_out(sweep_query_blocks(lambda q: diff_core(q, kc_all, vc_all, lam), qc), diff_subln, lam_init)

    y_lat = gated_merge(o_a, o_b, o_c, gx, w_br_a, w_br_b, w_br_c, w_out)
    if not with_ctx_out:
        return y_lat, None
    o_a_c = gqa_core(qa_c, ka_c, va_c)
    o_b_c = gqa_core(qb_c[:, :, :, None], kb_c, vb_c)
    o_c_c = diff_heads_out(diff_core(qc_c, kc_c, vc_c, lam), diff_subln, lam_init)
    y_ctx = gated_merge(o_a_c, o_b_c, o_c_c, gc, w_br_a, w_br_b, w_br_c, w_out)
    return y_lat, y_ctx


def setup_inputs(seed: int = 0) -> dict:
    key = jax.random.key(seed)
    ks = jax.random.split(key, 24)
    f32 = jnp.float32

    def nrm(k, shape, fan_in, gain=1.0):
        return jax.random.normal(k, shape, f32) * (gain * fan_in ** -0.5)

    def near_one(k, shape):
        return 1.0 + 0.05 * jax.random.normal(k, shape, f32)

    return {
        "x": jax.random.normal(ks[0], (BATCH, SEQ, D_MODEL), f32),
        "c": jax.random.normal(ks[1], (BATCH, D_MODEL), f32),
        "ctx": jax.random.normal(ks[2], (BATCH, CTX_LEN, D_MODEL), f32),
        "c_ctx": jax.random.normal(ks[3], (D_MODEL,), f32),
        "w_ada": nrm(ks[4], (DEPTH, D_MODEL, N_MOD * D_MODEL), D_MODEL, 0.5),
        "b_ada": 0.02 * jax.random.normal(ks[5], (DEPTH, N_MOD * D_MODEL), f32),
        "norm_g": near_one(ks[6], (DEPTH, 3, D_MODEL)),
        "ffn1_in": nrm(ks[7], (DEPTH, D_MODEL, 2 * FFN_DIM), D_MODEL),
        "ffn1_out": nrm(ks[8], (DEPTH, FFN_DIM, D_MODEL), FFN_DIM),
        "ffn2_in": nrm(ks[9], (DEPTH, D_MODEL, 2 * FFN_DIM), D_MODEL),
        "ffn2_out": nrm(ks[10], (DEPTH, FFN_DIM, D_MODEL), FFN_DIM),
        "w_in": nrm(ks[11], (DEPTH, D_MODEL, IN_WIDTH), D_MODEL),
        "qk_gain_a": near_one(ks[12], (DEPTH, 2, HEAD_DIM)),
        "qk_gain_b": near_one(ks[13], (DEPTH, 2, HEAD_DIM)),
        "qk_gain_c": near_one(ks[14], (DEPTH, 2, C_QK_DIM)),
        "na_rel_bias": 0.1 * jax.random.normal(ks[15], (DEPTH, B_HEADS, 2 * NA_KH - 1, 2 * NA_KW - 1), f32),
        "diff_lambda": 0.1 * jax.random.normal(ks[16], (DEPTH, 4, C_QK_DIM), f32),
        "diff_subln": near_one(ks[17], (DEPTH, C_V_DIM)),
        "w_br_a": nrm(ks[18], (DEPTH, A_Q_W, D_MODEL), A_Q_W),
        "w_br_b": nrm(ks[19], (DEPTH, B_W, D_MODEL), B_W),
        "w_br_c": nrm(ks[20], (DEPTH, C_V_W, D_MODEL), C_V_W),
        "w_out": nrm(ks[21], (DEPTH, D_MODEL, D_MODEL), D_MODEL),
    }


def reference(x, c, ctx, c_ctx, w_ada, b_ada, norm_g, ffn1_in, ffn1_out, ffn2_in, ffn2_out, w_in,
              qk_gain_a, qk_gain_b, qk_gain_c, na_rel_bias, diff_lambda, diff_subln,
              w_br_a, w_br_b, w_br_c, w_out):
    n_tok = x.shape[1]
    rows = n_tok // GRID_W
    rope_a = axial_rope(n_tok, HEAD_DIM)
    rope_c = axial_rope(n_tok, C_QK_DIM)
    cx = ctx
    for l in range(DEPTH):
        last = l == DEPTH - 1
        lam_init = 0.8 - 0.6 * math.exp(-0.3 * l)
        mx = ada_mod(c, w_ada[l], b_ada[l])
        mc = ada_mod(c_ctx[None], w_ada[l], b_ada[l])
        x = x + 0.5 * mx[:, 2] * swiglu(mod_norm(x, norm_g[l, 0], mx[:, 0], mx[:, 1]), ffn1_in[l], ffn1_out[l])
        cx = cx + 0.5 * mc[:, 2] * swiglu(mod_norm(cx, norm_g[l, 0], mc[:, 0], mc[:, 1]), ffn1_in[l], ffn1_out[l])
        hx = mod_norm(x, norm_g[l, 1], mx[:, 3], mx[:, 4])
        hc = mod_norm(cx, norm_g[l, 1], mc[:, 3], mc[:, 4])
        y_lat, y_ctx = token_mixing(hx, hc, w_in[l], qk_gain_a[l], qk_gain_b[l], qk_gain_c[l], na_rel_bias[l],
                                    diff_lambda[l], diff_subln[l], lam_init, w_br_a[l], w_br_b[l], w_br_c[l],
                                    w_out[l], rope_a, rope_c, rows, not last)
        x = x + mx[:, 5] * y_lat
        x = x + 0.5 * mx[:, 8] * swiglu(mod_norm(x, norm_g[l, 2], mx[:, 6], mx[:, 7]), ffn2_in[l], ffn2_out[l])
        if not last:
            cx = cx + mc[:, 5] * y_ctx
            cx = cx + 0.5 * mc[:, 8] * swiglu(mod_norm(cx, norm_g[l, 2], mc[:, 6], mc[:, 7]), ffn2_in[l], ffn2_out[l])
    return x
```

```cpp
#include <hip/hip_runtime.h>
#include <cstdio>
#include <cstdint>

#ifndef DUPMASK
#define DUPMASK 0
#endif
#define DUP(k) ((DUPMASK >> (k)) & 1)
#ifndef MK_N_LAUNCHES
#define MK_N_LAUNCHES 1
#endif

constexpr int DM = 4096, NB = 2, SEQ = 4096, CTXL = 256, TPB = SEQ + CTXL  , MROWS = NB * TPB  ;
constexpr int FFN = 7168, NMOD = 9, MODW = NMOD * DM  , DEPTH = 2;
constexpr int INW = 22528, QKVW = 10240, SGW = 12288;
constexpr int PAN_PER_B = TPB / 256;
constexpr float EPS = 1e-6f;
constexpr int CQA = 0, CKA = 1536, CVA = 2048, CQB = 2560, CKB = 4096, CVB = 5632, CQC = 7168, CKC = 8192, CVC = 9216;

#define GAS __attribute__((address_space(1)))
#define LAS __attribute__((address_space(3)))
typedef unsigned short u16;
typedef unsigned v4u __attribute__((ext_vector_type(4)));
typedef unsigned v2u __attribute__((ext_vector_type(2)));
typedef float f32x4 __attribute__((ext_vector_type(4)));
typedef float f32x2 __attribute__((ext_vector_type(2)));
typedef GAS unsigned gu32;
#define RLX_AGENT __ATOMIC_RELAXED, __HIP_MEMORY_SCOPE_AGENT
#define LDS_WAIT() asm volatile("s_waitcnt lgkmcnt(0)" ::: "memory")
#define VM_WAIT() asm volatile("s_waitcnt vmcnt(0)" ::: "memory")
__device__ __forceinline__ unsigned f2bf(float f) { unsigned u = __builtin_bit_cast(unsigned, f); return (u + 0x7fffu + ((u >> 16) & 1u)) >> 16; }
__device__ __forceinline__ unsigned pk2(float lo, float hi) { return f2bf(lo) | (f2bf(hi) << 16); }
__device__ __forceinline__ float bf_lo(unsigned w) { return __builtin_bit_cast(float, w << 16); }
__device__ __forceinline__ float bf_hi(unsigned w) { return __builtin_bit_cast(float, w & 0xffff0000u); }
__device__ __forceinline__ unsigned cvt_pk_bf16(float lo, float hi) { unsigned r; asm volatile("v_cvt_pk_bf16_f32 %0, %1, %2" : "=v"(r) : "v"(lo), "v"(hi)); return r; }
__device__ __forceinline__ unsigned pk4_fp8(float a, float b, float c, float d) { unsigned w = 0; w = __builtin_amdgcn_cvt_pk_fp8_f32(a, b, w, false); w = __builtin_amdgcn_cvt_pk_fp8_f32(c, d, w, true); return w; }
__device__ __forceinline__ float fast_sigmoid(float v) { return __builtin_amdgcn_rcpf(1.0f + __builtin_amdgcn_exp2f(-1.4426950408889634f * v)); }

__device__ __forceinline__ int tid_of(int wv) { int t = (wv << 6) | (int)__builtin_amdgcn_mbcnt_hi(~0u, __builtin_amdgcn_mbcnt_lo(~0u, 0u)); asm volatile("" : "+v"(t)); return t; }

namespace pg8 {
#define PG8_LAS __attribute__((address_space(3)))
typedef unsigned short bf16_t;
typedef short bf16x8 __attribute__((ext_vector_type(8)));
typedef float f32x4 __attribute__((ext_vector_type(4)));
typedef unsigned u32x4 __attribute__((ext_vector_type(4)));
typedef unsigned u32x2 __attribute__((ext_vector_type(2)));
typedef int i32x4 __attribute__((ext_vector_type(4)));
constexpr int BM = 256, BK = 64, HALF = 128, HTB = HALF * BK * 2  , STAGE_BYTES = 8 * HTB, NXCD = 8, WGM = 4;

__host__ __device__ __forceinline__ int lds_byte(int r, int c) { const int st = (r >> 4) * 2 + (c >> 5), rr = r & 15, cc = c & 31, ob = rr * 64 + cc * 2; return st * 1024 + (ob ^ (((ob >> 9) & 1) << 5)); }
__host__ __device__ __forceinline__ void stage_rc(int b, int& R, int& C) { const int st = b / 1024, sb = b % 1024, swz = sb ^ (((sb >> 9) & 1) << 5); R = (st >> 1) * 16 + swz / 64; C = (st & 1) * 32 + (swz % 64) / 2; }
__host__ __device__ __forceinline__ int perm32(int rho) { const int n = rho >> 4, i = rho & 15; return 8 * (i >> 2) + 4 * n + (i & 3); }

struct Unit { int pm, pn, kt0, nt; };
struct Gemm { const bf16_t* A; const bf16_t* Bt; int M, N, K; };

struct StaticOrder {
    int nM, nN, nwg, G, c, ntf, lat;
    __host__ __device__ void init(int M, int N, int K, int G_, int c_, int lat_only = 0) { lat = lat_only; nM = lat ? 32 : M / BM; nN = N / BM; nwg = nM * nN; G = G_; c = c_; ntf = K / BK; }
    __host__ __device__ __forceinline__ bool map(long L, Unit& u) const {
        if (L >= nwg) return false;
        int wgid = (int)L; { const int q = nwg / NXCD, r = nwg % NXCD, xcd = wgid % NXCD, off = wgid / NXCD; wgid = (xcd < r ? xcd * (q + 1) : r * (q + 1) + (xcd - r) * q) + off; }
        const int nig = WGM * nN, gid = wgid / nig, fm = gid * WGM, gsz = (nM - fm) < WGM ? (nM - fm) : WGM;
        u.pm = fm + ((wgid % nig) % gsz); u.pn = (wgid % nig) / gsz; if (lat) u.pm += u.pm >> 4; u.kt0 = 0; u.nt = ntf; return true;
    }
    __host__ __device__ __forceinline__ bool next(int i, Unit& u) const { return map((long)i * G + c, u); }
    __device__ __forceinline__ void a_ready(const Unit&) const {}
    __device__ __forceinline__ void done(const Unit&) const {}
};
template <int MODE> struct MapOrder { StaticOrder S; int extra;
    __host__ __device__ __forceinline__ bool next(int i, Unit& u) const { const int nl = S.G - extra, pre = extra > 0 ? 2 * nl : 0; long L;
        if (extra > 0 && S.c >= extra) L = i < 2 ? (long)i * nl + (S.c - extra) : (long)pre + (long)(i - 2) * S.G + S.c; else L = (long)pre + (long)i * S.G + S.c;
        const bool ok = S.map(L, u); const int p = u.pn;
        u.pn = p; return ok; }
    __device__ __forceinline__ void a_ready(const Unit&) const {}
    __device__ __forceinline__ void done(const Unit&) const {} };
struct ResidOrder {
    StaticOrder S; int KS, ctx;
    __host__ __device__ void init(int N, int K, int G_, int c_, int KS_, int ctx_) { S.init(MROWS, N, K, G_, c_, 1); KS = KS_; ctx = ctx_; }
    __host__ __device__ __forceinline__ bool next(int i, Unit& u) const {
        const long L = (long)i * S.G + S.c; const bool islat = L < S.nwg;
        Unit a; (void)S.map(islat ? L : 0, a);
        const long L2 = islat ? 0 : L - S.nwg; const int ks = (int)(L2 % KS), t = (int)(L2 / KS), cnt = S.ntf / KS;
        u.pn = islat ? a.pn : t % S.nN; u.pm = islat ? a.pm : (t / S.nN) * PAN_PER_B + (PAN_PER_B - 1); u.nt = islat ? a.nt : cnt; u.kt0 = islat ? 0 : ks * cnt;
        return islat || (ctx && L2 < 2 * S.nN * KS);
    }
    __device__ __forceinline__ void a_ready(const Unit&) const {}
    __device__ __forceinline__ void done(const Unit&) const {}
};


__device__ __forceinline__ size_t panel_off(int pm, bool& is_ctx, int& b) { b = pm / PAN_PER_B; const int j = pm - b * PAN_PER_B; is_ctx = (j == PAN_PER_B - 1); return is_ctx ? (size_t)(b * CTXL) * DM : (size_t)(b * SEQ + j * 256) * DM; }

struct EpiResid {
    static constexpr bool PERM = true, AFTER_DRAIN = false; static constexpr size_t WS_PART_OFF = (size_t)884 << 20, WS_HN_OFF = (size_t)17 << 20;
    __device__ static __forceinline__ bool keep(const Unit&) { return false; }
    const float* src_lat; float* dst_lat; unsigned char* wsb;
    const float* gsn; unsigned scale_off, rowss_off, xg8_off;
    unsigned gate_off; float coef; int ntf;
    __device__ __forceinline__ void operator()(const f32x4 (&acc)[2][2][4][2], const Unit& u, int wr, int wc, int fr, int fq) const {
        bool isc; int b; const size_t po = panel_off(u.pm, isc, b); const bool split = u.nt != ntf;
        const float* s = src_lat + po; float* d = dst_lat + po; const float* g = (const float*)(wsb + gate_off) + (size_t)b * MODW; float* part = (float*)(wsb + WS_PART_OFF);
        const int row0 = wr * 64 + fr, col0 = u.pn * BM + wc * 32 + 8 * fq;
        f32x4 gv[2][2];
#pragma unroll
        for (int bj = 0; bj < 2; ++bj)
#pragma unroll
            for (int n = 0; n < 2; ++n) gv[bj][n] = *(const f32x4*)(g + col0 + bj * HALF + n * 4) * coef;
        if (split) {
            float* pp = part + ((size_t)((u.kt0 * 8) / ntf) * (NB * CTXL) + (size_t)b * CTXL) * DM;
#pragma unroll
            for (int ai = 0; ai < 2; ++ai)
#pragma unroll
                for (int m = 0; m < 4; ++m) { const size_t off = (size_t)(row0 + ai * HALF + m * 16) * DM + col0;
#pragma unroll
                    for (int bj = 0; bj < 2; ++bj)
#pragma unroll
                        for (int n = 0; n < 2; ++n) *(f32x4*)(pp + off + bj * HALF + n * 4) = acc[ai][bj][m][n]; }
        } else {
            const bool mk = gsn != nullptr; float* rsp = (float*)(wsb + rowss_off) + u.pm * BM + row0; const float* scp = (const float*)(wsb + scale_off) + (size_t)b * MODW;
            bf16_t* xg = (bf16_t*)(wsb + WS_HN_OFF) + (size_t)u.pm * BM * DM; unsigned char* xg8 = wsb + ((size_t)xg8_off << 20) + (size_t)u.pm * BM * DM;
#pragma unroll
            for (int ai = 0; ai < 2; ++ai)
#pragma unroll
              for (int mp = 0; mp < 2; ++mp) {
                f32x4 sv[2][2][2];
#pragma unroll
                for (int mm = 0; mm < 2; ++mm) { const size_t off = (size_t)(row0 + ai * HALF + (mp * 2 + mm) * 16) * DM + col0;
#pragma unroll
                    for (int bj = 0; bj < 2; ++bj)
#pragma unroll
                        for (int n = 0; n < 2; ++n) sv[mm][bj][n] = __builtin_nontemporal_load((const f32x4*)(s + off + bj * HALF + n * 4)); }
#pragma unroll
                for (int mm = 0; mm < 2; ++mm) { const int m = mp * 2 + mm; const size_t off = (size_t)(row0 + ai * HALF + m * 16) * DM + col0; float q = 0.f;
#pragma unroll
                    for (int bj = 0; bj < 2; ++bj) { f32x4 xn[2];
#pragma unroll
                        for (int n = 0; n < 2; ++n) { xn[n] = sv[mm][bj][n] + gv[bj][n] * acc[ai][bj][m][n]; *(f32x4*)(d + off + bj * HALF + n * 4) = xn[n]; }
                        if (mk) { f32x4 y[2];
#pragma unroll
                            for (int n = 0; n < 2; ++n) { y[n] = xn[n] * (*(const f32x4*)(gsn + col0 + bj * HALF + n * 4) * (*(const f32x4*)(scp + col0 + bj * HALF + n * 4) + 1.0f)); q += (xn[n][0] * xn[n][0] + xn[n][1] * xn[n][1]) + (xn[n][2] * xn[n][2] + xn[n][3] * xn[n][3]); }
                            if (!xg8_off) { u32x4 w; w.x = cvt_pk_bf16(y[0][0], y[0][1]); w.y = cvt_pk_bf16(y[0][2], y[0][3]); w.z = cvt_pk_bf16(y[1][0], y[1][1]); w.w = cvt_pk_bf16(y[1][2], y[1][3]); *(u32x4*)(xg + off + bj * HALF) = w; }
                            else {   u32x2 w8; w8.x = pk4_fp8(y[0][0], y[0][1], y[0][2], y[0][3]); w8.y = pk4_fp8(y[1][0], y[1][1], y[1][2], y[1][3]); *(u32x2*)(xg8 + off + bj * HALF) = w8; } } }
                    if (mk) { q += __builtin_bit_cast(float, __builtin_amdgcn_ds_swizzle(__builtin_bit_cast(int, q), (16 << 10) | 0x1f));
                        if ((fq & 1) == 0) unsafeAtomicAdd(rsp + ai * HALF + m * 16, q); } }
                asm volatile("" ::: "memory"); }
        }
    }
};
struct NormFix {
    const float* rowss;
    const float* sw;
    int N;
    __device__ __forceinline__ void rows(const Unit& u, int wr, int fr, float (&rs)[2][4]) const {
#pragma unroll
        for (int ai = 0; ai < 2; ++ai)
#pragma unroll
            for (int m = 0; m < 4; ++m) rs[ai][m] = __builtin_amdgcn_rsqf(rowss[u.pm * BM + wr * 64 + fr + ai * HALF + m * 16] * (1.0f / DM) + EPS);
    }
    __device__ __forceinline__ const float* vecp(const Unit& u) const { const int b = u.pm / PAN_PER_B; return sw + (size_t)((u.pm - b * PAN_PER_B == PAN_PER_B - 1) ? 2 : b) * N; }
};
struct EpiSwiglu {
    static constexpr bool PERM = true, AFTER_DRAIN = false;
    __device__ static __forceinline__ bool keep(const Unit&) { return false; }
    bf16_t* H; NormFix nf;
    __device__ __forceinline__ void operator()(const f32x4 (&acc)[2][2][4][2], const Unit& u, int wr, int wc, int fr, int fq) const {
        const int row0 = u.pm * BM + wr * 64 + fr, col0 = u.pn * HALF + wc * 32 + 8 * fq;
        float rs[2][4]; nf.rows(u, wr, fr, rs);
        const float* swp = nf.vecp(u) + u.pn * BM + wc * 32 + 8 * fq; f32x4 sg[2], su[2];
#pragma unroll
        for (int n = 0; n < 2; ++n) { sg[n] = *(const f32x4*)(swp + 4 * n); su[n] = *(const f32x4*)(swp + HALF + 4 * n); }
#pragma unroll
        for (int ai = 0; ai < 2; ++ai)
#pragma unroll
            for (int m = 0; m < 4; ++m) { bf16_t* rowp = H + (size_t)(row0 + ai * HALF + m * 16) * FFN + col0;
                float h[8];
#pragma unroll
                for (int n = 0; n < 2; ++n)
#pragma unroll
                    for (int j = 0; j < 4; ++j) { const float gt = acc[ai][0][m][n][j] * rs[ai][m] + sg[n][j], up = acc[ai][1][m][n][j] * rs[ai][m] + su[n][j]; h[n * 4 + j] = gt * fast_sigmoid(gt) * up; }
                u32x4 w; w.x = cvt_pk_bf16(h[0], h[1]); w.y = cvt_pk_bf16(h[2], h[3]); w.z = cvt_pk_bf16(h[4], h[5]); w.w = cvt_pk_bf16(h[6], h[7]);
                *(u32x4*)rowp = w; }
    }
};
struct EpiInProj {
    static constexpr bool PERM = true, AFTER_DRAIN = false;
    __device__ static __forceinline__ bool keep(const Unit&) { return false; }
    bf16_t* QKV; bf16_t* SG; NormFix nf; int pn0; float ascale;
    __device__ __forceinline__ void operator()(const f32x4 (&acc)[2][2][4][2], const Unit& u, int wr, int wc, int fr, int fq) const {
        const int row0 = u.pm * BM + wr * 64 + fr, pn = u.pn + pn0; const bool isg = pn >= QKVW / BM;
        bf16_t* base = isg ? SG : QKV; const int ldc = isg ? SGW : QKVW; const int col0 = (isg ? pn - QKVW / BM : pn) * BM + wc * 32 + 8 * fq;
        float rs[2][4]; nf.rows(u, wr, fr, rs);
#pragma unroll
        for (int ai = 0; ai < 2; ++ai)
#pragma unroll
            for (int m = 0; m < 4; ++m) rs[ai][m] *= ascale;
        const float* swp = nf.vecp(u) + pn * BM + wc * 32 + 8 * fq; f32x4 sv[2][2];
#pragma unroll
        for (int bj = 0; bj < 2; ++bj)
#pragma unroll
            for (int n = 0; n < 2; ++n) sv[bj][n] = *(const f32x4*)(swp + bj * HALF + 4 * n);
#pragma unroll
        for (int ai = 0; ai < 2; ++ai)
#pragma unroll
            for (int m = 0; m < 4; ++m) { bf16_t* rowp = base + (size_t)(row0 + ai * HALF + m * 16) * ldc + col0;
#pragma unroll
                for (int bj = 0; bj < 2; ++bj) { f32x4 v0 = acc[ai][bj][m][0] * rs[ai][m] + sv[bj][0], v1 = acc[ai][bj][m][1] * rs[ai][m] + sv[bj][1];
                    if (isg) {
#pragma unroll
                        for (int j = 0; j < 4; ++j) { v0[j] = fast_sigmoid(v0[j]); v1[j] = fast_sigmoid(v1[j]); } }
                    u32x4 w; w.x = cvt_pk_bf16(v0[0], v0[1]); w.y = cvt_pk_bf16(v0[2], v0[3]); w.z = cvt_pk_bf16(v1[0], v1[1]); w.w = cvt_pk_bf16(v1[2], v1[3]);
                    *(u32x4*)(rowp + bj * HALF) = w; } }
    }
};
struct EpiGate {
    static constexpr bool PERM = true, AFTER_DRAIN = false;
    __device__ static __forceinline__ bool keep(const Unit& u) { return u.kt0 + u.nt < DM / BK; }
    const bf16_t* SG; bf16_t* MXB;
    __device__ __forceinline__ void operator()(f32x4 (&acc)[2][2][4][2], const Unit& u, int wr, int wc, int fr, int fq) const {
        const int row0 = u.pm * BM + wr * 64 + fr, col0 = u.pn * BM + wc * 32 + 8 * fq;
        const bool lastbr = !keep(u); const int gc0 = (u.kt0 == 0 ? 0 : (u.kt0 == 24 ? DM : 2 * DM));
#pragma unroll
        for (int ai = 0; ai < 2; ++ai)
#pragma unroll
            for (int mp = 0; mp < 2; ++mp) {
                u32x4 gw[2][2], hw[2][2];
#pragma unroll
                for (int mm = 0; mm < 2; ++mm) { const bf16_t* rp = SG + (size_t)(row0 + ai * HALF + (mp * 2 + mm) * 16) * SGW + gc0 + col0;
#pragma unroll
                    for (int bj = 0; bj < 2; ++bj) { gw[mm][bj] = *(const u32x4*)(rp + bj * HALF); if (!lastbr) hw[mm][bj] = *(const u32x4*)(rp + DM + bj * HALF); } }
#pragma unroll
                for (int mm = 0; mm < 2; ++mm) { const int m = mp * 2 + mm;
#pragma unroll
                    for (int bj = 0; bj < 2; ++bj) { const u32x4 a = gw[mm][bj]; f32x4 g[2];
                        g[0][0] = fmaxf(bf_lo(a.x), 1e-20f); g[0][1] = fmaxf(bf_hi(a.x), 1e-20f); g[0][2] = fmaxf(bf_lo(a.y), 1e-20f); g[0][3] = fmaxf(bf_hi(a.y), 1e-20f);
                        g[1][0] = fmaxf(bf_lo(a.z), 1e-20f); g[1][1] = fmaxf(bf_hi(a.z), 1e-20f); g[1][2] = fmaxf(bf_lo(a.w), 1e-20f); g[1][3] = fmaxf(bf_hi(a.w), 1e-20f);
                        if (!lastbr) { const u32x4 h = hw[mm][bj];
                            g[0][0] *= __builtin_amdgcn_rcpf(fmaxf(bf_lo(h.x), 1e-20f)); g[0][1] *= __builtin_amdgcn_rcpf(fmaxf(bf_hi(h.x), 1e-20f)); g[0][2] *= __builtin_amdgcn_rcpf(fmaxf(bf_lo(h.y), 1e-20f)); g[0][3] *= __builtin_amdgcn_rcpf(fmaxf(bf_hi(h.y), 1e-20f));
                            g[1][0] *= __builtin_amdgcn_rcpf(fmaxf(bf_lo(h.z), 1e-20f)); g[1][1] *= __builtin_amdgcn_rcpf(fmaxf(bf_hi(h.z), 1e-20f)); g[1][2] *= __builtin_amdgcn_rcpf(fmaxf(bf_lo(h.w), 1e-20f)); g[1][3] *= __builtin_amdgcn_rcpf(fmaxf(bf_hi(h.w), 1e-20f));
                            acc[ai][bj][m][0] = acc[ai][bj][m][0] * g[0]; acc[ai][bj][m][1] = acc[ai][bj][m][1] * g[1];
                        } else { const f32x4 v0 = acc[ai][bj][m][0] * g[0], v1 = acc[ai][bj][m][1] * g[1]; u32x4 w; w.x = cvt_pk_bf16(v0[0], v0[1]); w.y = cvt_pk_bf16(v0[2], v0[3]); w.z = cvt_pk_bf16(v1[0], v1[1]); w.w = cvt_pk_bf16(v1[2], v1[3]);
                            *(u32x4*)(MXB + (size_t)(row0 + ai * HALF + m * 16) * DM + col0 + bj * HALF) = w; } } }
                asm volatile("" ::: "memory"); }
    }
};
struct GateOrder {
    StaticOrder S;
    __host__ __device__ __forceinline__ bool next(int i, Unit& u) const { const int ti = i / 3, br = i - 3 * ti; const bool ok = S.next(ti, u); u.kt0 = br * 24; u.nt = br == 2 ? 16 : 24; return ok; }
    __device__ __forceinline__ void a_ready(const Unit&) const {}
    __device__ __forceinline__ void done(const Unit&) const {}
};

template <class Epi, class Sched, bool ALIGN_EPI = false, bool SP2 = false, bool FP8 = false>
__device__ __forceinline__ void gemm_phase(PG8_LAS unsigned char* lds, const Gemm g, const Sched& S, const Epi& E, int wv  ) {
    int tid_ = tid_of(wv);
    const int tid = tid_, wid = wv, lane = tid & 63, wr = wid >> 2, wc = wid & 3, fr = lane & 15, fq = lane >> 4;
    const int K = g.K;
    unsigned voffA[2], voffB[2];
#pragma unroll
    for (int i = 0; i < 2; ++i) { int R, C; stage_rc(tid * 16 + i * 8192, R, C); const int Rb = Epi::PERM ? ((R & ~31) + perm32(R & 31)) : R;
        voffA[i] = (unsigned)(R * K + C) * 2u; voffB[i] = (unsigned)(Rb * K + C) * 2u; }
    const size_t kstep = (size_t)(BK * 2);
    const size_t hstep = (size_t)HALF * K * 2;
    const size_t tstep = 2 * hstep;
    const unsigned ldsw = (unsigned)wid * 1024u;
    const int aoff = lds_byte(wr * 64 + fr, fq * 8), boff = lds_byte(wc * 32 + fr, fq * 8);
#define PG8_SA(b, h) (((b) * 2 + (h)) * HTB)
#define PG8_SB(b, h) ((4 + (b) * 2 + (h)) * HTB)
#define PG8_STAGE(bufoff, gbase, voff) do { _Pragma("unroll") for (int _i = 0; _i < 2; ++_i) { unsigned vo_ = (voff)[_i]; asm volatile("" : "+v"(vo_));     \
        __builtin_amdgcn_global_load_lds((const unsigned*)((const char*)(gbase) + vo_), (PG8_LAS unsigned*)(lds + (bufoff) + ldsw + _i * 8192), 16, 0, 0); } } while (0)
#define PG8_LDA(dst, b, h) do { _Pragma("unroll") for (int m = 0; m < 4; ++m) _Pragma("unroll") for (int k = 0; k < 2; ++k) dst[m][k] = *(const PG8_LAS bf16x8*)(lds + PG8_SA(b, h) + aoff + m * 2048 + k * 1024); } while (0)
#define PG8_LDB(dst, b, h) do { _Pragma("unroll") for (int n = 0; n < 2; ++n) _Pragma("unroll") for (int k = 0; k < 2; ++k) dst[n][k] = *(const PG8_LAS bf16x8*)(lds + PG8_SB(b, h) + boff + n * 2048 + k * 1024); } while (0)
#define PG8_CAT(x, y) __builtin_shufflevector(__builtin_bit_cast(i32x4, x), __builtin_bit_cast(i32x4, y), 0, 1, 2, 3, 4, 5, 6, 7)
#define PG8_MMA(ai, bj, At, Bt) do { __builtin_amdgcn_s_setprio(1); _Pragma("unroll") for (int m = 0; m < 4; ++m) _Pragma("unroll") for (int n = 0; n < 2; ++n) { \
        if constexpr (FP8) acc[ai][bj][m][n] = __builtin_amdgcn_mfma_scale_f32_16x16x128_f8f6f4(PG8_CAT(Bt[n][0], Bt[n][1]), PG8_CAT(At[m][0], At[m][1]), acc[ai][bj][m][n], 0, 0, 0, 0x7F7F7F7F, 0, 0x7F7F7F7F); \
        else { _Pragma("unroll") for (int k = 0; k < 2; ++k) acc[ai][bj][m][n] = __builtin_amdgcn_mfma_f32_16x16x32_bf16(Bt[n][k], At[m][k], acc[ai][bj][m][n], 0, 0, 0); } } __builtin_amdgcn_s_setprio(0); } while (0)
#define PG8_WAIT_V(n) asm volatile("s_waitcnt vmcnt(" #n ")" ::: "memory")
#define PG8_WAIT_L(n) asm volatile("s_waitcnt lgkmcnt(" #n ")" ::: "memory")
#define PG8_BAR __builtin_amdgcn_s_barrier()
#define PG8_SCHED __builtin_amdgcn_sched_barrier(0)
    Unit cur, nxt; int ui = 0;
    if (!S.next(0, cur)) return;
    f32x4 acc[2][2][4][2];
#pragma unroll
    for (int a = 0; a < 2; ++a)
#pragma unroll
        for (int b = 0; b < 2; ++b)
#pragma unroll
            for (int m = 0; m < 4; ++m)
#pragma unroll
                for (int n = 0; n < 2; ++n) acc[a][b][m][n] = (f32x4){0.f, 0.f, 0.f, 0.f};
    bf16x8 At[4][2], B0[2][2], B1[2][2];
    const char* cA = (const char*)g.A + (size_t)cur.pm * tstep + (size_t)cur.kt0 * kstep; const char* cB = (const char*)g.Bt + (size_t)cur.pn * tstep + (size_t)cur.kt0 * kstep;
    S.a_ready(cur);
    if constexpr (SP2) {
        PG8_STAGE(PG8_SB(0, 0), cB, voffB); PG8_STAGE(PG8_SB(0, 1), cB + hstep, voffB); PG8_STAGE(PG8_SA(0, 0), cA, voffA); PG8_STAGE(PG8_SA(0, 1), cA + hstep, voffA);
        if (wr == 1) PG8_BAR;
        PG8_WAIT_V(2); PG8_BAR;
        PG8_STAGE(PG8_SB(1, 0), cB + kstep, voffB); PG8_STAGE(PG8_SA(1, 0), cA + kstep, voffA); PG8_STAGE(PG8_SB(1, 1), cB + hstep + kstep, voffB);
        PG8_WAIT_V(6); PG8_BAR;
    } else {
        PG8_STAGE(PG8_SB(0, 0), cB, voffB); PG8_STAGE(PG8_SA(0, 0), cA, voffA); PG8_STAGE(PG8_SB(0, 1), cB + hstep, voffB); PG8_STAGE(PG8_SA(0, 1), cA + hstep, voffA);
        if (wr == 1) PG8_BAR;
        PG8_WAIT_V(4); PG8_BAR;
        PG8_STAGE(PG8_SB(1, 0), cB + kstep, voffB); PG8_STAGE(PG8_SA(1, 0), cA + kstep, voffA); PG8_STAGE(PG8_SB(1, 1), cB + hstep + kstep, voffB);
        PG8_WAIT_V(6); PG8_BAR;
    }
    for (;;) {
        const bool has_next = S.next(ui + 1, nxt);
        const char* nA = has_next ? (const char*)g.A + (size_t)nxt.pm * tstep + (size_t)nxt.kt0 * kstep : cA; const char* nB = has_next ? (const char*)g.Bt + (size_t)nxt.pn * tstep + (size_t)nxt.kt0 * kstep : cB;
        const int nt = cur.nt;
        for (int t = 0; t < nt; t += 2) {
            const bool last = (t == nt - 2);
            const char* a1 = cA + (size_t)(t + 1) * kstep;
            const char* a2 = last ? nA : cA + (size_t)(t + 2) * kstep; const char* b2 = last ? nB : cB + (size_t)(t + 2) * kstep;
            const char* a3 = a2 + kstep; const char* b3 = b2 + kstep;
            if (last && has_next) S.a_ready(nxt);
            if constexpr (SP2) {
            PG8_LDB(B0, 0, 0); PG8_LDB(B1, 0, 1); PG8_SCHED; PG8_LDA(At, 0, 0); PG8_STAGE(PG8_SA(1, 1), a1 + hstep, voffA);
            PG8_WAIT_V(8); PG8_WAIT_L(0); PG8_BAR; PG8_MMA(0, 0, At, B0); PG8_MMA(0, 1, At, B1); PG8_BAR; PG8_SCHED;
            PG8_LDA(At, 0, 1); PG8_STAGE(PG8_SB(0, 0), b2, voffB); PG8_STAGE(PG8_SB(0, 1), b2 + hstep, voffB); PG8_STAGE(PG8_SA(0, 0), a2, voffA);
            PG8_WAIT_V(8); PG8_WAIT_L(0); PG8_BAR; PG8_MMA(1, 0, At, B0); PG8_MMA(1, 1, At, B1); PG8_BAR; PG8_SCHED;
            PG8_LDB(B0, 1, 0); PG8_LDB(B1, 1, 1); PG8_SCHED; PG8_LDA(At, 1, 0); PG8_STAGE(PG8_SA(0, 1), a2 + hstep, voffA);
            PG8_WAIT_V(8); PG8_WAIT_L(0); PG8_BAR; PG8_MMA(0, 0, At, B0); PG8_MMA(0, 1, At, B1); PG8_BAR; PG8_SCHED;
            PG8_LDA(At, 1, 1); PG8_STAGE(PG8_SB(1, 0), b3, voffB); PG8_STAGE(PG8_SB(1, 1), b3 + hstep, voffB); PG8_STAGE(PG8_SA(1, 0), a3, voffA);
            PG8_WAIT_V(8); PG8_WAIT_L(0); PG8_BAR; PG8_MMA(1, 0, At, B0); PG8_MMA(1, 1, At, B1); PG8_BAR; PG8_SCHED;
            } else {
            PG8_LDB(B0, 0, 0); PG8_SCHED; PG8_LDA(At, 0, 0); PG8_STAGE(PG8_SA(1, 1), a1 + hstep, voffA);
            PG8_WAIT_L(8); PG8_BAR; PG8_WAIT_L(0); PG8_MMA(0, 0, At, B0); PG8_BAR; PG8_SCHED;
            PG8_LDB(B1, 0, 1); PG8_STAGE(PG8_SB(0, 0), b2, voffB);
            PG8_BAR; PG8_WAIT_L(0); PG8_MMA(0, 1, At, B1); PG8_BAR;
            PG8_LDA(At, 0, 1); PG8_STAGE(PG8_SA(0, 0), a2, voffA);
            PG8_BAR; PG8_WAIT_L(0); PG8_MMA(1, 0, At, B0); PG8_BAR; PG8_SCHED;
            PG8_STAGE(PG8_SB(0, 1), b2 + hstep, voffB);
            PG8_WAIT_V(6); PG8_BAR; PG8_MMA(1, 1, At, B1); PG8_BAR;
            PG8_LDB(B0, 1, 0); PG8_SCHED; PG8_LDA(At, 1, 0); PG8_STAGE(PG8_SA(0, 1), a2 + hstep, voffA);
            PG8_WAIT_L(8); PG8_BAR; PG8_WAIT_L(0); PG8_MMA(0, 0, At, B0); PG8_BAR; PG8_SCHED;
            PG8_LDB(B1, 1, 1); PG8_STAGE(PG8_SB(1, 0), b3, voffB);
            PG8_BAR; PG8_WAIT_L(0); PG8_MMA(0, 1, At, B1); PG8_BAR;
            PG8_LDA(At, 1, 1); PG8_STAGE(PG8_SA(1, 0), a3, voffA);
            PG8_BAR; PG8_WAIT_L(0); PG8_MMA(1, 0, At, B0); PG8_BAR; PG8_SCHED;
            PG8_STAGE(PG8_SB(1, 1), b3 + hstep, voffB);
            PG8_WAIT_V(6); PG8_BAR; PG8_MMA(1, 1, At, B1); PG8_BAR;
            }
        }
        if constexpr (ALIGN_EPI) { if (wr == 0) PG8_BAR; }
        if constexpr (!Epi::AFTER_DRAIN) { const int t_e = tid_of(wv); const int fr_e = t_e & 15, fq_e = (t_e & 63) >> 4;
            E(acc, cur, wr, wc, fr_e, fq_e); S.done(cur); }
        if (!has_next) break;
        if (!Epi::keep(cur))
#pragma unroll
        for (int a = 0; a < 2; ++a)
#pragma unroll
            for (int b = 0; b < 2; ++b)
#pragma unroll
                for (int m = 0; m < 4; ++m)
#pragma unroll
                    for (int n = 0; n < 2; ++n) acc[a][b][m][n] = (f32x4){0.f, 0.f, 0.f, 0.f};
        cur = nxt; cA = nA; cB = nB; ++ui;
        if constexpr (ALIGN_EPI) { if (wr == 1) PG8_BAR; }
    }
    PG8_WAIT_V(0);
    if constexpr (!ALIGN_EPI) { if (wr == 0) PG8_BAR; }
    PG8_BAR;
#undef PG8_SA
#undef PG8_SB
#undef PG8_STAGE
#undef PG8_LDA
#undef PG8_LDB
#undef PG8_MMA
#undef PG8_CAT
#undef PG8_WAIT_V
#undef PG8_WAIT_L
#undef PG8_BAR
#undef PG8_SCHED
}
}

namespace att {
using bf16x8 = __attribute__((ext_vector_type(8))) short;
using s16x4  = __attribute__((ext_vector_type(4))) short;
using f32x16 = __attribute__((ext_vector_type(16))) float;
using u32x4  = __attribute__((ext_vector_type(4))) unsigned;
constexpr int NW = 8, QBLK = 32, KVBLK = 64;
constexpr int SHM_V = 16384, SHM_K = 16384;
constexpr int OFF_V = 0, OFF_K = 2 * SHM_V, OFF_WS = OFF_K + 2 * SHM_K, OFF_BIAS = OFF_WS + 2048, OFF_SLOT = OFF_BIAS + 2048, ATT_LDS = OFF_SLOT + 64;
constexpr float THR = 8.f;
constexpr int LD = QKVW;
#define KSWZ128(row, colB) ((row) * 256 + ((colB) ^ (((row) & 7) << 4)))
#define KSWZ64(row, colB) ((row) * 128 + ((colB) ^ ((((row) >> 1) & 7) << 4)))
#define SBAR() __builtin_amdgcn_sched_barrier(0)
__device__ __forceinline__ int crow(int r, int hi) { return (r & 3) + 8 * (r >> 2) + 4 * hi; }
__device__ __forceinline__ unsigned cvtpk(float lo, float hi) { unsigned r; asm volatile("v_cvt_pk_bf16_f32 %0, %1, %2" : "=v"(r) : "v"(lo), "v"(hi)); return r; }

struct Unit {
    const u16* Q;
    const u16* K;
    const u16* V;
    u16* O; int ldo;
    int NT, n0, base0, base1;
    int r0, first;
    const float* qgain;
    const float* qrope; int t0;
};

template <int DQK>
__device__ __forceinline__ void partialSM(f32x16& p0, f32x16& p1, float& m_reg, float& mn, float& alpha) {
  constexpr float SCALE = DQK == 128 ? 0.08838834764831845f : 0.125f;
  constexpr float C = SCALE * 1.4426950408889634f;
  float pmax = p0[0];
#pragma unroll
  for (int r = 1; r < 16; ++r) pmax = fmaxf(pmax, p0[r]);
#pragma unroll
  for (int r = 0; r < 16; ++r) pmax = fmaxf(pmax, p1[r]);
  { auto rr = __builtin_amdgcn_permlane32_swap(__float_as_uint(pmax), __float_as_uint(pmax), false, false);
    pmax = fmaxf(__uint_as_float(rr[0]), __uint_as_float(rr[1])); }
  if (__builtin_expect(__all(pmax - m_reg <= THR / SCALE), 1)) { mn = m_reg; alpha = 1.f; }
  else { mn = fmaxf(m_reg, pmax); alpha = __builtin_amdgcn_exp2f((m_reg - mn) * C); m_reg = mn; }
  float mnC = -mn * C;
#pragma unroll
  for (int r = 0; r < 16; ++r) p0[r] = fmaf(p0[r], C, mnC);
#pragma unroll
  for (int r = 0; r < 16; ++r) p1[r] = fmaf(p1[r], C, mnC);
#pragma unroll
  for (int r = 0; r < 16; ++r) p0[r] = __builtin_amdgcn_exp2f(p0[r]);
}
__device__ __forceinline__ void finishSM(f32x16& p0, f32x16& p1, float alpha, float& l_reg, bf16x8& pa0, bf16x8& pa1, bf16x8& pa2, bf16x8& pa3) {
#pragma unroll
  for (int r = 0; r < 16; ++r) p1[r] = __builtin_amdgcn_exp2f(p1[r]);
  float ps = 0;
#pragma unroll
  for (int r = 0; r < 16; ++r) ps += p0[r];
#pragma unroll
  for (int r = 0; r < 16; ++r) ps += p1[r];
  { auto rr = __builtin_amdgcn_permlane32_swap(__float_as_uint(ps), __float_as_uint(ps), false, false);
    ps = __uint_as_float(rr[0]) + __uint_as_float(rr[1]); }
  l_reg = l_reg * alpha + ps;
#define PK4(P, BASE, OUT) do { unsigned a0 = cvtpk(P[BASE + 0], P[BASE + 1]), a1 = cvtpk(P[BASE + 2], P[BASE + 3]);   \
    unsigned b0 = cvtpk(P[BASE + 4], P[BASE + 5]), b1 = cvtpk(P[BASE + 6], P[BASE + 7]);                              \
    auto r0 = __builtin_amdgcn_permlane32_swap(a0, b0, false, false); auto r1 = __builtin_amdgcn_permlane32_swap(a1, b1, false, false); \
    u32x4 w = {r0[0], r1[0], r0[1], r1[1]}; OUT = *reinterpret_cast<bf16x8*>(&w); } while (0)
  PK4(p0, 0, pa0); PK4(p0, 8, pa1); PK4(p1, 0, pa2); PK4(p1, 8, pa3);
#undef PK4
}
template <int DQK>
__device__ __forceinline__ void qkt(f32x16& p0, f32x16& p1, const char* Ks, const bf16x8* qr, int r32, int hi) {
  p0 = f32x16{}; p1 = f32x16{};
#pragma unroll
  for (int d0 = 0; d0 < DQK / 16; ++d0) { const int cb = (d0 * 16 + hi * 8) * 2;
    bf16x8 b0, b1;
    if constexpr (DQK == 128) { b0 = *reinterpret_cast<const bf16x8*>(Ks + KSWZ128(r32, cb)); b1 = *reinterpret_cast<const bf16x8*>(Ks + KSWZ128(32 + r32, cb)); }
    else                      { b0 = *reinterpret_cast<const bf16x8*>(Ks + KSWZ64(r32, cb));  b1 = *reinterpret_cast<const bf16x8*>(Ks + KSWZ64(32 + r32, cb)); }
    p0 = __builtin_amdgcn_mfma_f32_32x32x16_bf16(b0, qr[d0], p0, 0, 0, 0);
    p1 = __builtin_amdgcn_mfma_f32_32x32x16_bf16(b1, qr[d0], p1, 0, 0, 0); }
}
__device__ __forceinline__ int v_st(int k, int c) { const int kk = (k & ~0xC) | ((k & 4) << 1) | ((k & 8) >> 1); return ((kk >> 3) * 4 + (c >> 5)) * 512 + ((kk & 7) * 32 + (c & 31)) * 2; }
__device__ __forceinline__ int v_rd_base(int lane) { return ((lane & 3) << 3) | (((lane >> 2) & 3) << 6) | (((lane >> 4) & 1) << 5) | (((lane >> 5) & 1) << 8); }
constexpr int v_rd_off(int d0, int ks, int half) { return d0 * 512 + ks * 4096 + half * 2048; }
template <int OFF> __device__ __forceinline__ s16x4 tr_read(int vb) {
  s16x4 r; asm volatile("ds_read_b64_tr_b16 %0, %1 offset:%2" : "=&v"(r) : "v"(vb), "i"(OFF) : "memory"); return r;
}
template <int D0> __device__ __forceinline__ void pv_one(f32x16& od, int vb, bf16x8 pa0, bf16x8 pa1, bf16x8 pa2, bf16x8 pa3) {
  const s16x4 l0 = tr_read<v_rd_off(D0, 0, 0)>(vb), h0 = tr_read<v_rd_off(D0, 0, 1)>(vb), l1 = tr_read<v_rd_off(D0, 1, 0)>(vb), h1 = tr_read<v_rd_off(D0, 1, 1)>(vb);
  const s16x4 l2 = tr_read<v_rd_off(D0, 2, 0)>(vb), h2 = tr_read<v_rd_off(D0, 2, 1)>(vb), l3 = tr_read<v_rd_off(D0, 3, 0)>(vb), h3 = tr_read<v_rd_off(D0, 3, 1)>(vb);
  asm volatile("s_waitcnt lgkmcnt(0)" ::: "memory"); SBAR();
#define PK(L, H) (bf16x8){L[0], L[1], L[2], L[3], H[0], H[1], H[2], H[3]}
  od = __builtin_amdgcn_mfma_f32_32x32x16_bf16(pa0, PK(l0, h0), od, 0, 0, 0);
  od = __builtin_amdgcn_mfma_f32_32x32x16_bf16(pa1, PK(l1, h1), od, 0, 0, 0);
  od = __builtin_amdgcn_mfma_f32_32x32x16_bf16(pa2, PK(l2, h2), od, 0, 0, 0);
  od = __builtin_amdgcn_mfma_f32_32x32x16_bf16(pa3, PK(l3, h3), od, 0, 0, 0);
#undef PK
}
__device__ __forceinline__ void pv_d0(f32x16* o, int vb, bf16x8 pa0, bf16x8 pa1, bf16x8 pa2, bf16x8 pa3) {
  pv_one<0>(o[0], vb, pa0, pa1, pa2, pa3); pv_one<1>(o[1], vb, pa0, pa1, pa2, pa3); pv_one<2>(o[2], vb, pa0, pa1, pa2, pa3); pv_one<3>(o[3], vb, pa0, pa1, pa2, pa3);
}

template <int DQK, int MODE, int SD>
__device__ __forceinline__ void attn_unit(const Unit& U, char* lds, int wv) {
  constexpr int ND = DQK / 16;
  int tid_ = tid_of(wv);
  const int tid = tid_, wid = wv, lane = tid & 63, r32 = lane & 31, hi = lane >> 5;
  char* V_lds = lds + OFF_V; char* K_lds = lds + OFF_K;
  float* ws = (float*)(lds + OFF_WS) + wid * 64; float* li_l = ws; float* al_l = ws + 32;
  const float* biasq = (const float*)(lds + OFF_BIAS);
  float m_reg = -1e30f, l_reg = 0; f32x16 o[4] = {}; bf16x8 qr[ND];
  { const char* Qw = (const char*)U.Q + (unsigned)(((wid * QBLK + r32) * LD + hi * 8) * 2);
#pragma unroll
    for (int d0 = 0; d0 < ND; ++d0) qr[d0] = *reinterpret_cast<const bf16x8*>(Qw + d0 * 32);
    float ssq = 0.f;
#pragma unroll
    for (int d0 = 0; d0 < ND; ++d0) { const u32x4 w = *reinterpret_cast<const u32x4*>(&qr[d0]);
#pragma unroll
      for (int e = 0; e < 4; ++e) { const float a = bf_lo(w[e]), b = bf_hi(w[e]); ssq += a * a + b * b; } }
    { auto rr = __builtin_amdgcn_permlane32_swap(__float_as_uint(ssq), __float_as_uint(ssq), false, false); ssq = __uint_as_float(rr[0]) + __uint_as_float(rr[1]); }
    const float rstdq = 1.0f / sqrtf(ssq * (1.0f / DQK) + EPS);
    const int tq = U.t0 + wid * QBLK + r32, gq = (tq >> 6) & 63, cq = tq & 63; constexpr int NP = DQK / 4;
#pragma unroll
    for (int d0 = 0; d0 < ND; ++d0) { const u32x4 w = *reinterpret_cast<const u32x4*>(&qr[d0]); const int dd = d0 * 16 + hi * 8;
      const f32x4 g0 = *(const f32x4*)(U.qgain + dd), g1 = *(const f32x4*)(U.qgain + dd + 4);
      float x[8]; x[0] = bf_lo(w[0]) * rstdq * g0[0]; x[1] = bf_hi(w[0]) * rstdq * g0[1]; x[2] = bf_lo(w[1]) * rstdq * g0[2]; x[3] = bf_hi(w[1]) * rstdq * g0[3];
      x[4] = bf_lo(w[2]) * rstdq * g1[0]; x[5] = bf_hi(w[2]) * rstdq * g1[1]; x[6] = bf_lo(w[3]) * rstdq * g1[2]; x[7] = bf_hi(w[3]) * rstdq * g1[3];
      if (U.qrope != nullptr) { const int i0 = dd >> 1; const float* tp = U.qrope + 2 * ((i0 < NP) ? gq * NP + i0 : cq * NP + i0 - NP);
        const f32x4 c01 = *(const f32x4*)tp, c23 = *(const f32x4*)(tp + 4); float y;
        y = x[0] * c01[0] - x[1] * c01[1]; x[1] = x[0] * c01[1] + x[1] * c01[0]; x[0] = y;
        y = x[2] * c01[2] - x[3] * c01[3]; x[3] = x[2] * c01[3] + x[3] * c01[2]; x[2] = y;
        y = x[4] * c23[0] - x[5] * c23[1]; x[5] = x[4] * c23[1] + x[5] * c23[0]; x[4] = y;
        y = x[6] * c23[2] - x[7] * c23[3]; x[7] = x[6] * c23[3] + x[7] * c23[2]; x[6] = y; }
      u32x4 o = {cvtpk(x[0], x[1]), cvtpk(x[2], x[3]), cvtpk(x[4], x[5]), cvtpk(x[6], x[7])}; qr[d0] = *reinterpret_cast<bf16x8*>(&o); } }
  const int sr = tid >> 4, sc = (tid & 15) * 8, vst0 = v_st(sr, sc), vst1 = v_st(32 + sr, sc);
  const int kr64 = tid >> 3, kc64 = (tid & 7) * 8;
  const unsigned gofs = (unsigned)((sr * LD + sc) * 2), gofs64 = (unsigned)((kr64 * LD + kc64) * 2);
  const int vb0 = (int)(uintptr_t)V_lds + v_rd_base(lane);
  struct { bf16x8 vs0, vs1, ks0, ks1; } sr_[SD];
  const int n0 = U.n0, base0 = U.base0, base1 = U.base1;
#define TROW(j) ((j) < n0 ? base0 + 64 * (j) : base1 + 64 * ((j) - n0))
#define SLOAD(i, j) do { const size_t tb_ = (size_t)(TROW(j)) * (LD * 2); const char* vp_ = (const char*)U.V + tb_; const char* kp_ = (const char*)U.K + tb_; \
    sr_[i].vs0 = *reinterpret_cast<const bf16x8*>(vp_ + gofs); sr_[i].vs1 = *reinterpret_cast<const bf16x8*>(vp_ + 32 * LD * 2 + gofs); \
    if constexpr (DQK == 128) { sr_[i].ks0 = *reinterpret_cast<const bf16x8*>(kp_ + gofs); sr_[i].ks1 = *reinterpret_cast<const bf16x8*>(kp_ + 32 * LD * 2 + gofs); } \
    else { sr_[i].ks0 = *reinterpret_cast<const bf16x8*>(kp_ + gofs64); } } while (0)
#define SWRITE(b, i) do { *(bf16x8*)(V_lds + (b) * SHM_V + vst0) = sr_[i].vs0; *(bf16x8*)(V_lds + (b) * SHM_V + vst1) = sr_[i].vs1; \
    if constexpr (DQK == 128) { const int kc = sc * 2; *(bf16x8*)(K_lds + (b) * SHM_K + KSWZ128(sr, kc)) = sr_[i].ks0; *(bf16x8*)(K_lds + (b) * SHM_K + KSWZ128(32 + sr, kc)) = sr_[i].ks1; } \
    else { *(bf16x8*)(K_lds + (b) * SHM_K + KSWZ64(kr64, kc64 * 2)) = sr_[i].ks0; } } while (0)
#define SWAIT() do { if constexpr (SD == 1) asm volatile("s_waitcnt vmcnt(0)" ::: "memory"); else if constexpr (DQK == 128) asm volatile("s_waitcnt vmcnt(4)" ::: "memory"); else asm volatile("s_waitcnt vmcnt(3)" ::: "memory"); } while (0)
#define RESC(a) do { if (__any((a) < 1.f)) { if (hi == 0) al_l[r32] = (a); asm volatile("s_waitcnt lgkmcnt(0)" ::: "memory"); \
    _Pragma("unroll") for (int d = 0; d < 4; ++d) _Pragma("unroll") for (int r = 0; r < 16; ++r) o[d][r] *= al_l[crow(r, hi)]; } } while (0)
#define MASK(P0, P1, j) do { if constexpr (MODE == 1) { if ((j) >= n0) { const int kr_ = U.first + ((j) - n0); \
      const int qgr_ = U.r0 + (wid >> 1), qc_ = 32 * (wid & 1) + r32, rs_ = min(max(qgr_ - 4, 0), 56), cs_ = min(max(qc_ - 8, 0), 48); \
      if ((unsigned)(kr_ - rs_) < 8u) { const float* brow_ = biasq + (kr_ - qgr_ + 7) * 31 + 15 - qc_; \
        _Pragma("unroll") for (int r = 0; r < 16; ++r) { const int kc_ = crow(r, hi); \
          P0[r] = ((unsigned)(kc_ - cs_) < 16u) ? P0[r] + brow_[kc_] : -__builtin_inff(); \
          P1[r] = ((unsigned)(kc_ + 32 - cs_) < 16u) ? P1[r] + brow_[kc_ + 32] : -__builtin_inff(); } } \
      else { _Pragma("unroll") for (int r = 0; r < 16; ++r) { P0[r] = -__builtin_inff(); P1[r] = -__builtin_inff(); } } } } } while (0)
  f32x16 pA0, pA1, pB0, pB1; float mnA, mnB, alA, alB; bf16x8 pa0, pa1, pa2, pa3; const int NT = U.NT;
  constexpr int SE = 0, SO = SD - 1;
  SLOAD(SE, 0); asm volatile("s_waitcnt vmcnt(0)" ::: "memory"); SWRITE(0, SE); __syncthreads();
  qkt<DQK>(pA0, pA1, K_lds, qr, r32, hi); MASK(pA0, pA1, 0); partialSM<DQK>(pA0, pA1, m_reg, mnA, alA);
  SLOAD(SO, 1); if constexpr (SD == 2) { if (2 < NT) SLOAD(SE, 2); }
  SWAIT(); SWRITE(1, SO); __syncthreads();
  for (int j = 1; j + 1 < NT; j += 2) {
    SBAR(); qkt<DQK>(pB0, pB1, K_lds + SHM_K, qr, r32, hi);
    finishSM(pA0, pA1, alA, l_reg, pa0, pa1, pa2, pa3); SBAR();
    SLOAD(SO, j + SD); SBAR();
    pv_d0(o, vb0, pa0, pa1, pa2, pa3); MASK(pB0, pB1, j); partialSM<DQK>(pB0, pB1, m_reg, mnB, alB);
    __syncthreads(); SWAIT(); SWRITE(0, SE);
    RESC(alB); __syncthreads();
    SBAR(); qkt<DQK>(pA0, pA1, K_lds, qr, r32, hi);
    finishSM(pB0, pB1, alB, l_reg, pa0, pa1, pa2, pa3); SBAR();
    if (SD == 1 || j + 3 < NT) SLOAD(SE, j + 1 + SD); SBAR();
    pv_d0(o, vb0 + SHM_V, pa0, pa1, pa2, pa3); MASK(pA0, pA1, j + 1); partialSM<DQK>(pA0, pA1, m_reg, mnA, alA);
    __syncthreads(); SWAIT(); SWRITE(1, SO);
    RESC(alA); __syncthreads();
  }
  SBAR(); qkt<DQK>(pB0, pB1, K_lds + SHM_K, qr, r32, hi);
  finishSM(pA0, pA1, alA, l_reg, pa0, pa1, pa2, pa3); SBAR();
  pv_d0(o, vb0, pa0, pa1, pa2, pa3); MASK(pB0, pB1, NT - 1); partialSM<DQK>(pB0, pB1, m_reg, mnB, alB);
  __syncthreads(); RESC(alB);
  finishSM(pB0, pB1, alB, l_reg, pa0, pa1, pa2, pa3); SBAR();
  pv_d0(o, vb0 + SHM_V, pa0, pa1, pa2, pa3);
  if (hi == 0) li_l[r32] = l_reg; asm volatile("s_waitcnt lgkmcnt(0)" ::: "memory");
  char* Ow = (char*)U.O + (size_t)(wid * QBLK) * U.ldo * 2;
  __syncthreads();
  { char* Os = lds + wid * 8192;
#pragma unroll
    for (int r = 0; r < 16; ++r) { const int orow = crow(r, hi); const float rl = __builtin_amdgcn_rcpf(li_l[orow]);
#pragma unroll
      for (int d0 = 0; d0 < 4; ++d0) *(u16*)(Os + orow * 256 + (d0 * 32 + r32) * 2) = (u16)f2bf(o[d0][r] * rl); }
    asm volatile("s_waitcnt lgkmcnt(0)" ::: "memory");
#pragma unroll
    for (int i = 0; i < 8; ++i) { const int row = i * 4 + (lane >> 4); const v4u v = *(const v4u*)(Os + row * 256 + (lane & 15) * 16); *(v4u*)(Ow + (size_t)row * U.ldo * 2 + (lane & 15) * 16) = v; } }
#undef TROW
#undef SLOAD
#undef SWRITE
#undef SWAIT
#undef RESC
#undef MASK
}
#undef SBAR
}

constexpr size_t MiB = 1u << 20;
constexpr size_t al1(size_t x) { return (x + MiB - 1) / MiB * MiB; }
constexpr size_t WS_CTL = 0, CTL_ZERO_BYTES = 8 * MiB;
constexpr size_t WS_MOD = 1 * MiB;
constexpr size_t WS_ROWSS = 2 * MiB;
constexpr size_t WS_SW = 4 * MiB;
constexpr int SW_STRIDE = 3 * INW;
constexpr size_t WS_MISC = 8 * MiB;
constexpr size_t WS_XC = 9 * MiB;
constexpr size_t WS_HN = WS_XC + al1((size_t)NB * CTXL * DM * 4);
constexpr size_t WS_HD = WS_HN + al1((size_t)MROWS * DM * 2);
constexpr size_t WS_QKV = WS_HD + al1((size_t)MROWS * FFN * 2);
constexpr size_t WS_SG = WS_QKV + al1((size_t)MROWS * QKVW * 2);
constexpr size_t WS_OCAT = WS_SG + al1((size_t)MROWS * SGW * 2);
constexpr size_t WS_OCR = WS_OCAT + al1((size_t)MROWS * DM * 2);
constexpr size_t WS_MX = WS_OCR + al1((size_t)MROWS * 2048 * 2);
constexpr size_t WS_MXB = WS_MX + al1((size_t)MROWS * DM * 4);
constexpr size_t WS_PART = WS_MXB + al1((size_t)MROWS * DM * 2);
constexpr size_t WS_W = WS_PART + al1((size_t)8 * NB * CTXL * DM * 4);
constexpr size_t WO_1IN = 0, WO_1OUT = WO_1IN + (size_t)2 * FFN * DM * 2, WO_2IN = WO_1OUT + (size_t)DM * FFN * 2, WO_2OUT = WO_2IN + (size_t)2 * FFN * DM * 2,
                 WO_IN = WO_2OUT + (size_t)DM * FFN * 2, WO_BR = WO_IN + (size_t)INW * DM * 2  ,
                 WO_OUT = WO_BR + (size_t)DM * DM * 2, W_LAYER = WO_OUT + (size_t)DM * DM * 2;
constexpr size_t WS_W8 = WS_W + DEPTH * W_LAYER;
constexpr size_t W8_LAYER = (size_t)INW * DM;
constexpr size_t WS_XG8 = WS_W8 + DEPTH * W8_LAYER;
constexpr size_t WS_END = WS_XG8 + al1((size_t)MROWS * DM);
static_assert((WS_XG8 & (MiB - 1)) == 0 && WS_ROWSS + (size_t)DEPTH * 3 * MROWS * 4 <= WS_SW && WS_SW + (size_t)DEPTH * 3 * SW_STRIDE * 4 <= CTL_ZERO_BYTES && WS_PART == pg8::EpiResid::WS_PART_OFF && WS_HN == pg8::EpiResid::WS_HN_OFF && WS_MOD + (size_t)DEPTH * 3 * MODW * 4 < ((size_t)1 << 32), "EpiResid's workspace offsets");
constexpr int MI_TA = 0, MI_TC = 64 * 32 * 2, MI_LAM = MI_TC + 64 * 16 * 2;
constexpr int CW_TMO = 0, CW_BAR = 4096, CW_ATTQ = 16384;

constexpr int RING_OFF = 0, RING_BYTES = 131072;
constexpr int LDSCTL_OFF = RING_BYTES, MISC_OFF = LDSCTL_OFF + 320;
constexpr int LDS_BYTES = 147456;
constexpr int NWAVES = 8;

#define XB_TMO      128
#define XB_XCNT(j)  (256  + 64 * (j))
#define XB_XSUB(j)  (1280 + 64 * (j))
#define XB_XGEN(j)  (2304 + 64 * (j))
#define XB_TOP      3328
#define XB_TOPGEN   3392
#define XCD_BAR_WORDS 3456
#define XB_SPIN_CAP (1u << 18)

__device__ __forceinline__ unsigned xb_ld(unsigned* p)              { return __hip_atomic_load(p, __ATOMIC_RELAXED, __HIP_MEMORY_SCOPE_AGENT); }
__device__ __forceinline__ unsigned xb_add(unsigned* p, unsigned v) { return __hip_atomic_fetch_add(p, v, __ATOMIC_RELAXED, __HIP_MEMORY_SCOPE_AGENT); }
__device__ __forceinline__ unsigned xb_xcc_id() { return (unsigned)__builtin_amdgcn_s_getreg((3 << 11) | 20) & 0xFu; }
#define XB_SPIN(cond, bar) do { unsigned _sp = 0; while (cond) { __builtin_amdgcn_s_sleep(1); \
    if ((++_sp & 255u) == 0u) { if (xb_ld(&(bar)[XB_TMO])) break; if (_sp > XB_SPIN_CAP) { atomicAdd(&(bar)[XB_TMO], 1u); break; } } } } while (0)

struct XcdBarrier {
    unsigned* bar; unsigned x;
    volatile LAS unsigned* st;
};
__device__ __forceinline__ XcdBarrier xcd_barrier_post(unsigned* bar, volatile LAS unsigned* st, bool lead  ) {
    XcdBarrier b; b.bar = bar; b.x = xb_xcc_id(); b.st = st;
    if (lead) (void)xb_add(&bar[XB_XCNT(b.x)], 1u);
    return b;
}
__device__ __forceinline__ void xcd_barrier_complete(unsigned* bar, unsigned x, unsigned& nloc, unsigned& nx) {
    const unsigned G = gridDim.x * gridDim.y * gridDim.z;
    unsigned sum, cnt, mine, sp = 0u;
    for (;;) {
        sum = 0u; cnt = 0u; mine = 0u;
#pragma unroll
        for (unsigned j = 0; j < 16; ++j) { const unsigned c = xb_ld(&bar[XB_XCNT(j)]); sum += c; cnt += (c > 0u) ? 1u : 0u; mine = (j == x) ? c : mine; }
        if (sum == G) break;
        __builtin_amdgcn_s_sleep(1);
        if ((++sp & 255u) == 0u) { if (xb_ld(&bar[XB_TMO])) break; if (sp > XB_SPIN_CAP) { atomicAdd(&bar[XB_TMO], 1u); break; } }
    }
    nloc = mine > 0u ? mine : 1u; nx = cnt > 0u ? cnt : 1u;
}
__device__ __forceinline__ void xcd_barrier(const XcdBarrier& b, bool lead  ) {
    asm volatile("s_waitcnt vmcnt(0)" ::: "memory");
    __syncthreads();
    if (lead) {
        unsigned* bar = b.bar;
        __builtin_amdgcn_s_waitcnt(0);
        unsigned nloc = b.st[0], nx = b.st[1];
        if (nloc == 0u) { xcd_barrier_complete(bar, b.x, nloc, nx); b.st[0] = nloc; b.st[1] = nx; }
        const unsigned old = xb_add(&bar[XB_XSUB(b.x)], 1u);
        const unsigned gen = old / nloc;
        if (old + 1u == (gen + 1u) * nloc) {
            __builtin_amdgcn_fence(__ATOMIC_RELEASE, "agent");
            asm volatile("s_waitcnt vmcnt(0)" ::: "memory");
            const unsigned og = xb_add(&bar[XB_TOP], 1u);
            const unsigned tg = og / nx;
            if (og + 1u == (tg + 1u) * nx) xb_add(&bar[XB_TOPGEN], 1u);
            else XB_SPIN(xb_ld(&bar[XB_TOPGEN]) == tg, bar);
            __builtin_amdgcn_fence(__ATOMIC_ACQUIRE, "agent");
            xb_add(&bar[XB_XGEN(b.x)], 1u);
            asm volatile("s_waitcnt vmcnt(0)" ::: "memory");
        } else {
            XB_SPIN(xb_ld(&bar[XB_XGEN(b.x)]) == gen, bar);
            __builtin_amdgcn_fence(__ATOMIC_ACQUIRE, "agent");
            asm volatile("s_waitcnt vmcnt(0)" ::: "memory");
        }
    }
    __syncthreads();
}

struct Args {
    const float* in[22];
    float* out; unsigned char* ws;
    int ph_lo, ph_hi;
};
struct Frame {
    LAS unsigned char* lds;
    volatile LAS unsigned* MISC;
    gu32* ctl;
    int tid, lane, wave, vcu, G;
};
template <int X> __device__ __forceinline__ float swz_xor(float v) { return __builtin_bit_cast(float, __builtin_amdgcn_ds_swizzle(__builtin_bit_cast(int, v), (X << 10) | 0x1f)); }
__device__ __forceinline__ float sum16(float v) { v += swz_xor<1>(v); v += swz_xor<2>(v); v += swz_xor<4>(v); v += swz_xor<8>(v); return v; }
__device__ __forceinline__ float sum8(float v) { v += swz_xor<1>(v); v += swz_xor<2>(v); v += swz_xor<4>(v); return v; }
__device__ __forceinline__ float wave_sum(float v) {
    v = sum16(v); v += swz_xor<16>(v);
    const float lo = __builtin_bit_cast(float, __builtin_amdgcn_readlane(__builtin_bit_cast(int, v), 0)), hi = __builtin_bit_cast(float, __builtin_amdgcn_readlane(__builtin_bit_cast(int, v), 32));
    return lo + hi;
}
template <int NKB>
__device__ __forceinline__ void p0_transpose_item(const float* W, int K, int Nsrc, u16* WT, int Kdst, int nblk, int smap, LAS float* scr, int item, int lane, const float* shift, float* sw, int Nsw, unsigned char* W8 = nullptr) {
    const int kbg = item / nblk, nb = item - kbg * nblk, n0 = 32 * nb;
    const int s0 = smap ? (((n0 & 255) >> 7) * FFN + (n0 >> 8) * 128 + (n0 & 127)) : n0;
    float a0 = 0.f, a1 = 0.f, a2 = 0.f;
    for (int kq = 0; kq < NKB; ++kq) {
        const int k0 = 64 * (kbg * NKB + kq);
        { f32x4 v[8];
#pragma unroll
          for (int i = 0; i < 8; ++i) v[i] = __builtin_nontemporal_load((const f32x4*)(W + (size_t)(k0 + 8 * i + (lane >> 3)) * Nsrc + s0 + (lane & 7) * 4));
#pragma unroll
          for (int i = 0; i < 8; ++i) { LAS float* d = scr + (8 * i + (lane >> 3)) * 33 + (lane & 7) * 4; d[0] = v[i].x; d[1] = v[i].y; d[2] = v[i].z; d[3] = v[i].w; } }
        if (NKB > 1) { scr[2112 + lane] = shift[k0 + lane]; scr[2176 + lane] = shift[MODW + k0 + lane]; scr[2240 + lane] = shift[2 * MODW + k0 + lane]; }
        LDS_WAIT(); asm volatile("" ::: "memory");
        const int c = lane & 7;
#pragma unroll
        for (int j = 0; j < 4; ++j) { const int n = (lane >> 3) + 8 * j; const LAS float* s = scr + (8 * c) * 33 + n;
            if (W8 != nullptr) {
                v2u o; o.x = pk4_fp8(s[0 * 33] * 64.f, s[1 * 33] * 64.f, s[2 * 33] * 64.f, s[3 * 33] * 64.f); o.y = pk4_fp8(s[4 * 33] * 64.f, s[5 * 33] * 64.f, s[6 * 33] * 64.f, s[7 * 33] * 64.f);
                *(GAS v2u*)(W8 + (size_t)(n0 + n) * Kdst + k0 + 8 * c) = o;
            } else {
            v4u o; o.x = pk2(s[0 * 33], s[1 * 33]); o.y = pk2(s[2 * 33], s[3 * 33]); o.z = pk2(s[4 * 33], s[5 * 33]); o.w = pk2(s[6 * 33], s[7 * 33]);
            *(GAS v4u*)(WT + (size_t)(n0 + n) * Kdst + k0 + 8 * c) = o; } }
        if (NKB > 1) { const int n = lane & 31, kh = 32 * (lane >> 5);
#pragma unroll 8
            for (int kk = 0; kk < 32; ++kk) { const float w = scr[(kh + kk) * 33 + n]; a0 += w * scr[2112 + kh + kk]; a1 += w * scr[2176 + kh + kk]; a2 += w * scr[2240 + kh + kk]; } }
        LDS_WAIT(); asm volatile("" ::: "memory");
    }
    if (NKB > 1) { float* o = sw + n0 + (lane & 31); unsafeAtomicAdd(o, a0); unsafeAtomicAdd(o + Nsw, a1); unsafeAtomicAdd(o + 2 * Nsw, a2); }
}
__device__ __forceinline__ void p0_ada_item(const float* c, const float* c_ctx, const float* w_ada, const float* b_ada, float* MOD, LAS float* scr, int item, int lane) {
    const int l = item / (32 * 144), r = item - l * (32 * 144), kc = r / 144, cg = r - kc * 144, k0 = kc * 128, col = cg * 256 + lane * 4;
#pragma unroll
    for (int i = 0; i < 2; ++i) { const int k = k0 + i * 64 + lane;
        const float a = c[k], b = c[DM + k], d = c_ctx[k];
        scr[i * 64 + lane] = a * fast_sigmoid(a); scr[256 + i * 64 + lane] = b * fast_sigmoid(b); scr[512 + i * 64 + lane] = d * fast_sigmoid(d); }
    LDS_WAIT(); asm volatile("" ::: "memory");
    const float* wp = w_ada + (size_t)l * DM * MODW + (size_t)k0 * MODW + col;
    f32x4 a0 = {0.f, 0.f, 0.f, 0.f}, a1 = a0, a2 = a0;
#pragma unroll 8
    for (int k = 0; k < 128; ++k) { const f32x4 w = __builtin_nontemporal_load((const f32x4*)(wp + (size_t)k * MODW)); a0 += w * scr[k]; a1 += w * scr[256 + k]; a2 += w * scr[512 + k]; }
    if (kc == 0) { const f32x4 bv = *(const f32x4*)(b_ada + (size_t)l * MODW + col); a0 += bv; a1 += bv; a2 += bv; }
    float* m = MOD + (size_t)l * 3 * MODW + col;
#pragma unroll
    for (int j = 0; j < 4; ++j) { unsafeAtomicAdd(m + j, a0[j]); unsafeAtomicAdd(m + MODW + j, a1[j]); unsafeAtomicAdd(m + 2 * MODW + j, a2[j]); }
    LDS_WAIT(); asm volatile("" ::: "memory");
}

__device__ __forceinline__ void modnorm_phase(const Frame& F, const float* xl, const float* xc, const float* g, const float* modl  , int sub, u16* HN, float* xc_copy  ,
                                              const float* part  , const float* pgate, float pcoef, float* xc_out, float* rowss, bool ctx_only  , unsigned char* hn8  ) {
    const int gw = F.vcu * NWAVES + F.wave, NGW = F.G * NWAVES;
    for (int it = gw; it < (ctx_only ? NB * CTXL : MROWS); it += NGW) {
        const int row = ctx_only ? (it / CTXL) * TPB + SEQ + it % CTXL : it;
        const int b = row / TPB, t = row - b * TPB; const bool isc = t >= SEQ;
        const float* xr = isc ? xc + (size_t)(b * CTXL + t - SEQ) * DM : xl + (size_t)(b * SEQ + t) * DM;
        const float* mv = modl + (size_t)(isc ? 2 : b) * MODW + (size_t)(3 * sub) * DM;
        f32x4 v[16]; float ss = 0.f;
#pragma unroll
        for (int j = 0; j < 16; ++j) { v[j] = *(const f32x4*)(xr + j * 256 + F.lane * 4); ss += (v[j].x * v[j].x + v[j].y * v[j].y) + (v[j].z * v[j].z + v[j].w * v[j].w); }
        if (isc && part) {
            const int cr = b * CTXL + t - SEQ; ss = 0.f;
#pragma unroll
            for (int j = 0; j < 16; ++j) { const int c0 = j * 256 + F.lane * 4; f32x4 a = *(const f32x4*)(part + (size_t)cr * DM + c0);
#pragma unroll
                for (int ks = 1; ks < 8; ++ks) a += *(const f32x4*)(part + ((size_t)ks * (NB * CTXL) + cr) * DM + c0);
                v[j] += a * (*(const f32x4*)(pgate + c0) * pcoef); *(f32x4*)(xc_out + (size_t)cr * DM + c0) = v[j];
                ss += (v[j].x * v[j].x + v[j].y * v[j].y) + (v[j].z * v[j].z + v[j].w * v[j].w); }
        }
        ss = wave_sum(ss); if (F.lane == 0) rowss[row] = ss;
        if (isc && xc_copy) { float* cr = xc_copy + (size_t)(b * CTXL + t - SEQ) * DM;
#pragma unroll
            for (int j = 0; j < 16; ++j) *(f32x4*)(cr + j * 256 + F.lane * 4) = v[j]; }
        u16* orow = HN + (size_t)row * DM;
#pragma unroll
        for (int j = 0; j < 16; ++j) { const int c0 = j * 256 + F.lane * 4;
            const f32x4 gg = *(const f32x4*)(g + c0), sc = *(const f32x4*)(mv + DM + c0);
            const f32x4 y = v[j] * gg * (sc + 1.0f);
            v2u w; w.x = pk2(y.x, y.y); w.y = pk2(y.z, y.w); *(v2u*)(orow + c0) = w;
            if (hn8) *(unsigned*)(hn8 + (size_t)row * DM + c0) = pk4_fp8(y.x, y.y, y.z, y.w); }
    }
}

__device__ __forceinline__ void ctxnorm_phase(const Frame& F, float* xc, const float* g, const float* modl, int sub, u16* HN, const float* part, const float* pgate, float pcoef, float* rowss, unsigned char* hn8) {
    const int gw = F.vcu * NWAVES + F.wave, NGW = F.G * NWAVES;
    const float* mv = modl + (size_t)2 * MODW + (size_t)(3 * sub) * DM;
    for (int it = gw; it < NB * CTXL * 4; it += NGW) {
        const int cr = it >> 2, q = it & 3, b = cr / CTXL, row = b * TPB + SEQ + (cr - b * CTXL);
        float* xr = xc + (size_t)cr * DM + q * 1024 + F.lane * 4;
        f32x4 v[4]; float ss = 0.f;
#pragma unroll
        for (int j = 0; j < 4; ++j) v[j] = *(const f32x4*)(xr + j * 256);
        if (part) {
#pragma unroll
            for (int j = 0; j < 4; ++j) { const int c0 = q * 1024 + j * 256 + F.lane * 4; f32x4 a = *(const f32x4*)(part + (size_t)cr * DM + c0);
#pragma unroll
                for (int ks = 1; ks < 8; ++ks) a += *(const f32x4*)(part + ((size_t)ks * (NB * CTXL) + cr) * DM + c0);
                v[j] += a * (*(const f32x4*)(pgate + c0) * pcoef); *(f32x4*)(xr + j * 256) = v[j]; }
        }
#pragma unroll
        for (int j = 0; j < 4; ++j) ss += (v[j].x * v[j].x + v[j].y * v[j].y) + (v[j].z * v[j].z + v[j].w * v[j].w);
        ss = wave_sum(ss); if (F.lane == 0) unsafeAtomicAdd(rowss + row, ss);
#pragma unroll
        for (int j = 0; j < 4; ++j) { const int c0 = q * 1024 + j * 256 + F.lane * 4;
            const f32x4 gg = *(const f32x4*)(g + c0), sc = *(const f32x4*)(mv + DM + c0);
            const f32x4 y = v[j] * gg * (sc + 1.0f);
            if (hn8) *(unsigned*)(hn8 + (size_t)row * DM + c0) = pk4_fp8(y.x, y.y, y.z, y.w);
            else { v2u w; w.x = pk2(y.x, y.y); w.y = pk2(y.z, y.w); *(v2u*)(HN + (size_t)row * DM + c0) = w; } }
    }
}

template <int KIND  >
__device__ __forceinline__ v4u qk_one(v4u w, const float* gain, bool lat, int gr, int gcl, const f32x2* T, int sub) {
    float x[8]; x[0] = bf_lo(w.x); x[1] = bf_hi(w.x); x[2] = bf_lo(w.y); x[3] = bf_hi(w.y); x[4] = bf_lo(w.z); x[5] = bf_hi(w.z); x[6] = bf_lo(w.w); x[7] = bf_hi(w.w);
    float ss = 0.f;
#pragma unroll
    for (int e = 0; e < 8; ++e) ss += x[e] * x[e];
    ss = (KIND != 2) ? sum16(ss) : sum8(ss);
    const float rstd = 1.0f / sqrtf(ss * (KIND == 2 ? 1.0f / 64.0f : 1.0f / 128.0f) + EPS);
    const int s = KIND == 2 ? (sub & 7) : sub;
    const f32x4 g0 = *(const f32x4*)(gain + 8 * s), g1 = *(const f32x4*)(gain + 8 * s + 4);
    x[0] *= rstd * g0[0]; x[1] *= rstd * g0[1]; x[2] *= rstd * g0[2]; x[3] *= rstd * g0[3]; x[4] *= rstd * g1[0]; x[5] *= rstd * g1[1]; x[6] *= rstd * g1[2]; x[7] *= rstd * g1[3];
    if (KIND != 1 && lat) {
        constexpr int NP = KIND == 0 ? 32 : 16;
        const int i0 = 4 * s; const f32x2* tp = (i0 < NP) ? T + gr * NP + i0 : T + gcl * NP + i0 - NP;
        const f32x4 c01 = *(const f32x4*)tp, c23 = *(const f32x4*)(tp + 2);
        float y;
        y = x[0] * c01[0] - x[1] * c01[1]; x[1] = x[0] * c01[1] + x[1] * c01[0]; x[0] = y;
        y = x[2] * c01[2] - x[3] * c01[3]; x[3] = x[2] * c01[3] + x[3] * c01[2]; x[2] = y;
        y = x[4] * c23[0] - x[5] * c23[1]; x[5] = x[4] * c23[1] + x[5] * c23[0]; x[4] = y;
        y = x[6] * c23[2] - x[7] * c23[3]; x[7] = x[6] * c23[3] + x[7] * c23[2]; x[6] = y;
    }
    v4u o; o.x = pk2(x[0], x[1]); o.y = pk2(x[2], x[3]); o.z = pk2(x[4], x[5]); o.w = pk2(x[6], x[7]); return o;
}
__device__ __forceinline__ void qkprep_phase(const Frame& F, u16* QKV, u16* QOUT, const float* ga, const float* gb, const float* gc, const float* misc) {
    const int gw = F.vcu * NWAVES + F.wave, NGW = F.G * NWAVES, sub = F.lane & 15;
    const f32x2* TA = (const f32x2*)(misc + MI_TA); const f32x2* TC = (const f32x2*)(misc + MI_TC);
    for (int row = gw; row < MROWS; row += NGW) {
        const int t = row % TPB; const bool lat = t < SEQ; const int gr = (t >> 6) & 63, gcl = t & 63;
        u16* rp = QKV + (size_t)row * QKVW + F.lane * 8; u16* wp = QOUT + (size_t)row * QKVW + F.lane * 8;
        v4u v[6];
#pragma unroll
        for (int jj = 0; jj < 6; ++jj) { const int j = jj == 0 ? 3 : (jj < 4 ? 6 + jj : 8 + jj); const int col = j < 4 ? j * 512 : (j < 10 ? CQB + (j - 4) * 512 : CQC + (j - 10) * 512); v[jj] = *(const v4u*)(rp + col); }
#pragma unroll
        for (int jj = 0; jj < 6; ++jj) { const int j = jj == 0 ? 3 : (jj < 4 ? 6 + jj : 8 + jj); const int col = j < 4 ? j * 512 : (j < 10 ? CQB + (j - 4) * 512 : CQC + (j - 10) * 512);
            v4u o;
            if (j < 4)       o = qk_one<0>(v[jj], ga + 128, lat, gr, gcl, TA, sub);
            else if (j < 10) o = qk_one<1>(v[jj], gb + 128, lat, gr, gcl, TA, sub);
            else             o = qk_one<2>(v[jj], gc + 64, lat, gr, gcl, TC, sub);
            *(v4u*)(wp + col) = o; }
    }
}

__device__ __forceinline__ void ccombine_phase(const Frame& F, const u16* OCR, u16* OC, const float* subln, float lam, float one_m_li) {
    const int gw = F.vcu * NWAVES + F.wave, NGW = F.G * NWAVES, sub = F.lane & 15, grp = F.lane >> 4;
    const f32x4 s0 = *(const f32x4*)(subln + 8 * sub) * one_m_li, s1 = *(const f32x4*)(subln + 8 * sub + 4) * one_m_li;
    for (int row = gw; row < MROWS; row += NGW) {
        const u16* rp = OCR + (size_t)row * 2048 + grp * 256 + sub * 8;
        v4u a[2], b[2];
#pragma unroll
        for (int j = 0; j < 2; ++j) { a[j] = *(const v4u*)(rp + j * 1024); b[j] = *(const v4u*)(rp + j * 1024 + 128); }
#pragma unroll
        for (int j = 0; j < 2; ++j) {
            float d[8]; d[0] = bf_lo(a[j].x) - lam * bf_lo(b[j].x); d[1] = bf_hi(a[j].x) - lam * bf_hi(b[j].x); d[2] = bf_lo(a[j].y) - lam * bf_lo(b[j].y); d[3] = bf_hi(a[j].y) - lam * bf_hi(b[j].y);
            d[4] = bf_lo(a[j].z) - lam * bf_lo(b[j].z); d[5] = bf_hi(a[j].z) - lam * bf_hi(b[j].z); d[6] = bf_lo(a[j].w) - lam * bf_lo(b[j].w); d[7] = bf_hi(a[j].w) - lam * bf_hi(b[j].w);
            float ss = 0.f;
#pragma unroll
            for (int e = 0; e < 8; ++e) ss += d[e] * d[e];
            ss = sum16(ss);
            const float rstd = 1.0f / sqrtf(ss * (1.0f / 128.0f) + EPS);
            v4u o; o.x = pk2(d[0] * rstd * s0[0], d[1] * rstd * s0[1]); o.y = pk2(d[2] * rstd * s0[2], d[3] * rstd * s0[3]); o.z = pk2(d[4] * rstd * s1[0], d[5] * rstd * s1[1]); o.w = pk2(d[6] * rstd * s1[2], d[7] * rstd * s1[3]);
            *(v4u*)(OC + (size_t)row * DM + 3072 + (j * 4 + grp) * 128 + sub * 8) = o;
        }
    }
}

constexpr int PPL = 13, NPH = 2 + DEPTH * PPL;
typedef const float* __attribute__((address_space(4))) const* kargp_t;
#define KARGS() kargp_t kp_ = (kargp_t)__builtin_amdgcn_kernarg_segment_ptr(); asm volatile("" : "+s"(kp_))
#define KIN(i) ((const float*)kp_[i])
#define KOUT() ((float*)kp_[22])
#define KWS() ((unsigned char*)kp_[23])
constexpr int H_FIN = (DM / 512) * (2 * FFN / 32), H_IN = (DM / 512) * (INW / 32), H_LAYER = 2 * H_FIN + H_IN;
constexpr int I_FOUT = (FFN / 64) * (DM / 32), I_BRA = (1536 / 64) * (DM / 32), I_BRC = (1024 / 64) * (DM / 32), I_OUT = (DM / 64) * (DM / 32), I_LAYER = 2 * I_FOUT + 2 * I_BRA + I_BRC + I_OUT;
constexpr int TAIL_L1 = 22528, TAIL_H = 12800, T2_H = 7168;
__device__ __forceinline__ void conv_heavy(kargp_t kp_, unsigned char* ws, LAS float* scr, int l, int r, int lane) {
    int ai, Nsrc, smap, which, ksh; size_t wo;
    if (r < H_FIN) { ai = 7; Nsrc = 2 * FFN; wo = WO_1IN; smap = 1; which = 0; ksh = 0; }
    else if ((r -= H_FIN) < H_IN) { ai = 11; Nsrc = INW; wo = WO_IN; smap = 0; which = 1; ksh = 3; }
    else { r -= H_IN; ai = 9; Nsrc = 2 * FFN; wo = WO_2IN; smap = 1; which = 2; ksh = 6; }
    p0_transpose_item<8>(KIN(ai) + (size_t)l * DM * Nsrc, DM, Nsrc, (u16*)(ws + WS_W + (size_t)l * W_LAYER + wo), DM, Nsrc / 32, smap, scr, r, lane,
                         (const float*)(ws + WS_MOD) + (size_t)l * 3 * MODW + (size_t)ksh * DM, (float*)(ws + WS_SW) + (size_t)(l * 3 + which) * SW_STRIDE, Nsrc,
                         which == 1 ? ws + WS_W8 + (size_t)l * W8_LAYER : nullptr);
}
__device__ __forceinline__ void conv_light(kargp_t kp_, unsigned char* ws, LAS float* scr, int l, int r, int lane) {
    int ai, K, Kdst = 0; size_t wo;
    if (r < I_FOUT) { ai = 8; K = FFN; wo = WO_1OUT; }
    else if ((r -= I_FOUT) < I_FOUT) { ai = 10; K = FFN; wo = WO_2OUT; }
    else if ((r -= I_FOUT) < I_BRA) { ai = 18; K = 1536; wo = WO_BR; Kdst = DM; }
    else if ((r -= I_BRA) < I_BRA) { ai = 19; K = 1536; wo = WO_BR + 1536 * 2; Kdst = DM; }
    else if ((r -= I_BRA) < I_BRC) { ai = 20; K = 1024; wo = WO_BR + 3072 * 2; Kdst = DM; }
    else { r -= I_BRC; ai = 21; K = DM; wo = WO_OUT; }
    p0_transpose_item<1>(KIN(ai) + (size_t)l * K * DM, K, DM, (u16*)(ws + WS_W + (size_t)l * W_LAYER + wo), Kdst ? Kdst : K, DM / 32, 0, scr, r, lane, nullptr, nullptr, 0);
}
__device__ __forceinline__ int l0_early(int j) { return j < I_FOUT ? j : j + I_FOUT; }
__device__ __forceinline__ int l0_late(int j) { return j < I_FOUT ? j + I_FOUT : j + 2 * I_BRA + I_BRC + I_FOUT; }
template <int KIND> __device__ __forceinline__ void conv_tail(kargp_t kp_, unsigned char* ws, LAS unsigned char* lds, int G, int c, int busy, int lo, int hi, int wv) {
    if (c < busy || busy >= G) return;
    const int t_ = tid_of(wv); const int wave = wv, lane = t_ & 63;
    LAS float* scr = (LAS float*)(lds + RING_OFF + wave * 16384);
    for (int it = lo + (c - busy) * NWAVES + wave; it < hi; it += (G - busy) * NWAVES) { if (KIND == 1) conv_heavy(kp_, ws, scr, 1, it, lane); else if (KIND == 0) conv_light(kp_, ws, scr, 1, it, lane); else conv_light(kp_, ws, scr, 0, l0_early(it), lane); }
    LDS_WAIT();
}

__device__ __forceinline__ int attq_next(const Frame& F, gu32* head) {
    volatile LAS unsigned* slot = (volatile LAS unsigned*)(F.lds + att::OFF_SLOT);
    __syncthreads();
    if (F.tid == 0) slot[0] = __hip_atomic_fetch_add(head, 1u, RLX_AGENT);
    __syncthreads();
    return __builtin_amdgcn_readfirstlane((int)slot[0]);
}
__device__ __forceinline__ void attn_phase(const Frame& F, const u16* QKV, u16* OCAT, u16* OCR, const float* rel_bias  , gu32* qhead, bool with_ctx,
                                           const float* ga, const float* gb, const float* gc  , const float* misc  , kargp_t kp_, unsigned char* ws, bool conv  ) {
    char* lds = (char*)F.lds;
    int cround = 0; const int crounds = conv ? (TAIL_H - T2_H + F.G * NWAVES - 1) / (F.G * NWAVES) : 0;
#define CONV_ROUND() do { if (cround < crounds) { __syncthreads(); const int it_ = T2_H + cround * F.G * NWAVES + (int)blockIdx.x * NWAVES + F.wave; \
        if (it_ < TAIL_H) conv_heavy(kp_, ws, (LAS float*)(F.lds + RING_OFF + F.wave * 9216), 1, it_, F.lane); LDS_WAIT(); ++cround; } } while (0)
    for (;;) {
        const int idx = attq_next(F, qhead); if (idx >= (with_ctx ? 408 : 384)) break;
        att::Unit U; int h, b, qb; const bool ctxq = idx >= 384;
        if (!ctxq) { qb = idx & 15; h = (idx >> 4) % 12; b = idx / 192; } else { const int i = idx - 384; qb = 16; h = i % 12; b = i / 12; }
        const int rowq = b * TPB + qb * 256; U.r0 = 0; U.first = 0; U.base1 = 0;
        if (ctxq) { U.NT = 4; U.n0 = 4; U.base0 = b * TPB + SEQ; } else { U.NT = 68; U.n0 = 68; U.base0 = b * TPB; }
        U.Q = QKV + (size_t)rowq * QKVW + CQA + h * 128; U.K = QKV + CKA + (h / 3) * 128; U.V = QKV + CVA + (h / 3) * 128; U.O = OCAT + (size_t)rowq * DM + h * 128; U.ldo = DM;
        U.qgain = ga; U.qrope = ctxq ? nullptr : misc + MI_TA; U.t0 = ctxq ? 0 : qb * 256;
        att::attn_unit<128, 0, 2>(U, lds, F.wave);
        CONV_ROUND();
    }
    for (;;) {
        const int idx = attq_next(F, qhead + 64); if (idx >= (with_ctx ? 544 : 512)) break;
        att::Unit U; int ph, b, qb; const bool ctxq = idx >= 512;
        if (!ctxq) { qb = idx & 15; ph = (idx >> 4) & 15; b = idx >> 8; } else { const int i = idx - 512; qb = 16; ph = i & 15; b = i >> 4; }
        const int rowq = b * TPB + qb * 256, h = ph >> 1, cmap = ph & 1; U.r0 = 0; U.first = 0; U.base1 = 0;
        if (ctxq) { U.NT = 4; U.n0 = 4; U.base0 = b * TPB + SEQ; } else { U.NT = 68; U.n0 = 68; U.base0 = b * TPB; }
        U.Q = QKV + (size_t)rowq * QKVW + CQC + h * 128 + cmap * 64; U.K = QKV + CKC + h * 128 + cmap * 64; U.V = QKV + CVC + h * 128; U.O = OCR + (size_t)rowq * 2048 + ph * 128; U.ldo = 2048;
        U.qgain = gc; U.qrope = ctxq ? nullptr : misc + MI_TC; U.t0 = ctxq ? 0 : qb * 256;
        att::attn_unit<64, 0, 2>(U, lds, F.wave);
        CONV_ROUND();
    }
    for (;;) {
        const int idx = attq_next(F, qhead + 128); if (idx >= (with_ctx ? 408 : 384)) break;
        att::Unit U; int h, b, qb; const bool ctxq = idx >= 384;
        if (!ctxq) { qb = idx & 15; h = (idx >> 4) % 12; b = idx / 192; } else { const int i = idx - 384; qb = 16; h = i % 12; b = i / 12; }
        const int rowq = b * TPB + qb * 256; U.r0 = 0; U.first = 0; U.base1 = 0; U.NT = 4; U.n0 = 4; U.base0 = b * TPB + SEQ;
        if (!ctxq) {
            const int r0 = qb * 4; int first = min(max(r0 - 4, 0), 56); const int last = min(max(r0 - 1, 0), 56) + 7; int cnt = last - first + 1;
            if (cnt & 1) { if (first > 0) --first; ++cnt; }
            U.NT = 4 + cnt; U.base1 = b * TPB + first * 64; U.r0 = r0; U.first = first;
            LAS float* biasq = (LAS float*)(F.lds + att::OFF_BIAS);
            for (int e = F.tid; e < 465; e += NWAVES * 64) biasq[e] = rel_bias[h * 465 + e] * 11.313708498984761f;
        }
        U.Q = QKV + (size_t)rowq * QKVW + CQB + h * 128; U.K = QKV + CKB + h * 128; U.V = QKV + CVB + h * 128; U.O = OCAT + (size_t)rowq * DM + 1536 + h * 128; U.ldo = DM;
        U.qgain = gb; U.qrope = nullptr; U.t0 = 0;
        att::attn_unit<128, 1, 1>(U, lds, F.wave);
    }
    while (cround < crounds) CONV_ROUND();
#undef CONV_ROUND
}

__device__ __forceinline__ Frame make_frame(unsigned char* ws, LAS unsigned char* lds, int wv) {
    Frame F; F.lds = lds; F.MISC = (volatile LAS unsigned*)(lds + MISC_OFF); F.ctl = (gu32*)(ws + WS_CTL);
    F.tid = tid_of(wv); F.lane = F.tid & 63; F.wave = wv;
    F.G = gridDim.x; { const int bx = blockIdx.x; F.vcu = (F.G % 8 == 0) ? (bx % 8) * (F.G / 8) + bx / 8 : bx; }
    return F;
}
__global__ void __launch_bounds__(NWAVES * 64, 2) trunk_fwd(Args args) {
    extern __shared__ __attribute__((aligned(16))) unsigned char lds[];
    LAS unsigned char* const L = (LAS unsigned char*)lds;
    const int wv_ = __builtin_amdgcn_readfirstlane((int)threadIdx.x >> 6);
    for (int u = tid_of(wv_); u < (LDS_BYTES - LDSCTL_OFF) / 4; u += NWAVES * 64) ((LAS unsigned*)(L + LDSCTL_OFF))[u] = 0u;
    __syncthreads();
    const int lo = args.ph_lo, hi = args.ph_hi;
    if (MK_N_LAUNCHES == 1) { KARGS(); (void)xcd_barrier_post((unsigned*)((gu32*)(KWS() + WS_CTL) + CW_BAR), (volatile LAS unsigned*)(L + MISC_OFF) + 8, tid_of(wv_) == 0); }
#define GRID_BAR() do { if (MK_N_LAUNCHES == 1) { KARGS(); XcdBarrier bar_; bar_.bar = (unsigned*)((gu32*)(KWS() + WS_CTL) + CW_BAR); bar_.x = xb_xcc_id(); bar_.st = (volatile LAS unsigned*)(L + MISC_OFF) + 8; xcd_barrier(bar_, tid_of(wv_) == 0); } } while (0)
#define IN(k) (lo <= (k) && (k) < hi)
#define SEAM(k) do { if (IN((k) + 1)) GRID_BAR(); } while (0)

    if (IN(0)) {
        KARGS(); unsigned char* ws = KWS(); const Frame F = make_frame(ws, L, wv_);
        LAS float* scr = (LAS float*)(F.lds + RING_OFF + F.wave * 16384);
        const int gw = F.vcu * NWAVES + F.wave, NGW = F.G * NWAVES;
        { const float* c_in = KIN(1); const float* cctx_in = KIN(3); const float* w_ada = KIN(4); const float* b_ada = KIN(5); float* MOD = (float*)(ws + WS_MOD);
          for (int it = gw; it < DEPTH * 32 * 144; it += NGW) p0_ada_item(c_in, cctx_in, w_ada, b_ada, MOD, scr, it, F.lane); }
        if (blockIdx.x == 0) {
            float* MISCF = (float*)(ws + WS_MISC); const float* diff_lambda = KIN(16);
            for (int e = F.tid; e < 64 * 32; e += NWAVES * 64) { const int p = e >> 5, i = e & 31; const float inv = powf(10000.0f, -(float)i / 32.0f), ang = (float)p * inv; MISCF[MI_TA + 2 * e] = cosf(ang); MISCF[MI_TA + 2 * e + 1] = sinf(ang); }
            for (int e = F.tid; e < 64 * 16; e += NWAVES * 64) { const int p = e >> 4, i = e & 15; const float inv = powf(10000.0f, -(float)i / 16.0f), ang = (float)p * inv; MISCF[MI_TC + 2 * e] = cosf(ang); MISCF[MI_TC + 2 * e + 1] = sinf(ang); }
            if (F.wave < DEPTH) { const int l = F.wave; const float* dl = diff_lambda + (size_t)l * 4 * 64;
                const float s1 = wave_sum(dl[F.lane] * dl[64 + F.lane]), s2 = wave_sum(dl[128 + F.lane] * dl[192 + F.lane]);
                const float lam_init = 0.8f - 0.6f * expf(-0.3f * (float)l);
                if (F.lane == 0) MISCF[MI_LAM + l] = expf(s1) - expf(s2) + lam_init; }
        }
        LDS_WAIT();
        SEAM(0);
    }
#define PH_BEGIN0() const float* modl = (const float*)(ws + WS_MOD) + (size_t)l * 3 * MODW; float* XC = (float*)(ws + WS_XC)
    if (IN(1)) {
        KARGS(); unsigned char* ws = KWS(); const Frame F = make_frame(ws, L, wv_);
        LAS float* scr = (LAS float*)(F.lds + RING_OFF + F.wave * 16384);
        const int gw = F.vcu * NWAVES + F.wave, NGW = F.G * NWAVES;
        for (int it = gw; it < DEPTH * H_LAYER; it += NGW) {
            const int l = it / H_LAYER, r = it - l * H_LAYER; if (l == 1 && r < TAIL_H) continue;
            conv_heavy(kp_, ws, scr, l, r, F.lane); }
        if (DEPTH > 1) { for (int it = gw; it < TAIL_L1; it += NGW) conv_light(kp_, ws, scr, 0, l0_late(it), F.lane); }
        else { for (int it = gw; it < I_LAYER; it += NGW) conv_light(kp_, ws, scr, 0, it, F.lane); }
        LDS_WAIT();
        { const int l = 0; PH_BEGIN0();
          modnorm_phase(F, KIN(0), KIN(2), KIN(6), modl, 0, (u16*)(ws + WS_HN), XC, nullptr, modl, 0.5f, XC, (float*)(ws + WS_ROWSS), false, nullptr); }
        SEAM(1);
    }

    for (int l = 0; l < DEPTH; ++l) {
        const int P = 2 + l * PPL;
#define PH_BEGIN() KARGS(); unsigned char* ws = KWS(); const Frame F = make_frame(ws, L, wv_); const float* modl = (const float*)(ws + WS_MOD) + (size_t)l * 3 * MODW; \
        const u16* wl = (const u16*)(ws + WS_W + (size_t)l * W_LAYER); float* XL = KOUT(); float* XC = (float*)(ws + WS_XC); \
        float* DXL = rep ? (float*)(ws + WS_MX) : XL; float* DXC = rep ? (float*)(ws + WS_MX) + (size_t)NB * SEQ * DM : XC;     \
        (void)F; (void)modl; (void)wl; (void)XL; (void)XC; (void)DXL; (void)DXC
        if (IN(P + 0) && l != 0) { for (int rep = 0; rep <= DUP(0); ++rep) { PH_BEGIN();
            ctxnorm_phase(F, XC, KIN(6) + (size_t)(l * 3 + 0) * DM, modl, 0, (u16*)(ws + WS_HN), (const float*)(ws + WS_PART), modl - 3 * MODW + 2 * MODW + 8 * DM, 0.5f, (float*)(ws + WS_ROWSS) + (size_t)(l * 3 + 0) * MROWS, nullptr); } SEAM(P + 0); }
        if (IN(P + 1)) { for (int rep = 0; rep <= DUP(1); ++rep) { PH_BEGIN(); pg8::Gemm g{(const u16*)(ws + WS_HN), wl + WO_1IN / 2, MROWS, 2 * FFN, DM}; pg8::StaticOrder S; S.init(MROWS, 2 * FFN, DM, F.G, (int)blockIdx.x);
            pg8::EpiSwiglu E{(u16*)(ws + WS_HD), {(const float*)(ws + WS_ROWSS) + (size_t)(l * 3 + 0) * MROWS, (const float*)(ws + WS_SW) + (size_t)(l * 3 + 0) * SW_STRIDE, 2 * FFN}}; pg8::gemm_phase<pg8::EpiSwiglu, pg8::StaticOrder, true, true>(F.lds + RING_OFF, g, S, E, F.wave); } if (DEPTH > 1) { KARGS(); const int busy_ = ((MROWS / 256) * (2 * FFN / 256)) % (int)gridDim.x;
              if (l == 0) conv_tail<2>(kp_, KWS(), L, (int)gridDim.x, (int)blockIdx.x, busy_, 0, TAIL_L1, wv_); else if (l == 1) conv_tail<0>(kp_, KWS(), L, (int)gridDim.x, (int)blockIdx.x, busy_, TAIL_L1, 2 * TAIL_L1, wv_); } SEAM(P + 1); }
        if (IN(P + 2)) { for (int rep = DUP(2); rep >= 0; --rep) { PH_BEGIN(); pg8::Gemm g{(const u16*)(ws + WS_HD), wl + WO_1OUT / 2, MROWS, DM, FFN}; pg8::ResidOrder S; S.init(DM, FFN, F.G, (int)blockIdx.x, 8, 1);
            pg8::EpiResid E{l == 0 ? KIN(0) : XL, DXL, ws, KIN(6) + (size_t)(l * 3 + 1) * DM, (unsigned)(WS_MOD + ((size_t)l * 3 * MODW + 4 * DM) * 4), (unsigned)(WS_ROWSS + (size_t)(l * 3 + 1) * MROWS * 4), (unsigned)(WS_XG8 >> 20),
                            (unsigned)(WS_MOD + ((size_t)l * 3 * MODW + 2 * DM) * 4), 0.5f, FFN / 64}; pg8::gemm_phase<pg8::EpiResid, pg8::ResidOrder, true, true>(F.lds + RING_OFF, g, S, E, F.wave); } SEAM(P + 2); }
        if (IN(P + 3)) { for (int rep = 0; rep <= DUP(3); ++rep) { PH_BEGIN(); ctxnorm_phase(F, XC, KIN(6) + (size_t)(l * 3 + 1) * DM, modl, 1, (u16*)(ws + WS_HN), (const float*)(ws + WS_PART), modl + 2 * MODW + 2 * DM, 0.5f, (float*)(ws + WS_ROWSS) + (size_t)(l * 3 + 1) * MROWS, ws + WS_XG8); } SEAM(P + 3); }
        if (IN(P + 4)) { for (int rep = 0; rep <= DUP(4); ++rep) { PH_BEGIN();
            const pg8::NormFix nf{(const float*)(ws + WS_ROWSS) + (size_t)(l * 3 + 1) * MROWS, (const float*)(ws + WS_SW) + (size_t)(l * 3 + 1) * SW_STRIDE, INW};
            { pg8::Gemm g{(const u16*)(ws + WS_XG8), (const u16*)(ws + WS_W8 + (size_t)l * W8_LAYER), MROWS, INW, DM / 2}; pg8::MapOrder<1> S; S.S.init(MROWS, 88 * 256, DM / 2, F.G, (int)blockIdx.x); S.extra = 0;
              pg8::EpiInProj E{(u16*)(ws + WS_QKV), (u16*)(ws + WS_SG), nf, 0, 1.0f / 64.0f}; pg8::gemm_phase<pg8::EpiInProj, pg8::MapOrder<1>, true, true, true>(F.lds + RING_OFF, g, S, E, F.wave); }
            } SEAM(P + 4); }
        if (IN(P + 5)) { for (int rep = DUP(5); rep >= 0; --rep) { PH_BEGIN(); qkprep_phase(F, (u16*)(ws + WS_QKV), rep ? (u16*)(ws + WS_MX) : (u16*)(ws + WS_QKV), KIN(12) + (size_t)l * 256, KIN(13) + (size_t)l * 256, KIN(14) + (size_t)l * 128, (const float*)(ws + WS_MISC)); } SEAM(P + 5); }
        if (IN(P + 6)) { for (int rep = 0; rep <= DUP(6); ++rep) { PH_BEGIN(); attn_phase(F, (const u16*)(ws + WS_QKV), (u16*)(ws + WS_OCAT), (u16*)(ws + WS_OCR), KIN(15) + (size_t)l * 12 * 465, F.ctl + CW_ATTQ + 256 * l + 1024 * rep, l == 0,
                KIN(12) + (size_t)l * 256, KIN(13) + (size_t)l * 256, KIN(14) + (size_t)l * 128, (const float*)(ws + WS_MISC), kp_, ws, l == 0 && DEPTH > 1 && rep == 0); } SEAM(P + 6); }
        if (IN(P + 7)) { for (int rep = 0; rep <= DUP(7); ++rep) { PH_BEGIN(); const float lam_init = 0.8f - 0.6f * expf(-0.3f * (float)l);
            ccombine_phase(F, (const u16*)(ws + WS_OCR), (u16*)(ws + WS_OCAT), KIN(17) + (size_t)l * 128, ((const float*)(ws + WS_MISC))[MI_LAM + l], 1.0f - lam_init); } SEAM(P + 7); }
        if (IN(P + 8)) { for (int rep = 0; rep <= DUP(8); ++rep) { PH_BEGIN(); pg8::Gemm g{(const u16*)(ws + WS_OCAT), wl + WO_BR / 2, MROWS, DM, DM}; pg8::GateOrder S; S.S.init(MROWS, DM, DM, F.G, (int)blockIdx.x, l == DEPTH - 1);
            pg8::EpiGate E{(const u16*)(ws + WS_SG), (u16*)(ws + WS_MXB)}; pg8::gemm_phase<pg8::EpiGate, pg8::GateOrder, true, true>(F.lds + RING_OFF, g, S, E, F.wave); } if (l == 0 && DEPTH > 1) { KARGS(); conv_tail<1>(kp_, KWS(), L, (int)gridDim.x, (int)blockIdx.x, ((MROWS / 256) * (DM / 256)) % (int)gridDim.x, 0, T2_H, wv_); } SEAM(P + 8); }
        if (IN(P + 9)) { for (int rep = DUP(9); rep >= 0; --rep) { PH_BEGIN(); pg8::Gemm g{(const u16*)(ws + WS_MXB), wl + WO_OUT / 2, MROWS, DM, DM}; pg8::ResidOrder S; S.init(DM, DM, F.G, (int)blockIdx.x, 8, l != DEPTH - 1);
            pg8::EpiResid E{XL, DXL, ws, KIN(6) + (size_t)(l * 3 + 2) * DM, (unsigned)(WS_MOD + ((size_t)l * 3 * MODW + 7 * DM) * 4), (unsigned)(WS_ROWSS + (size_t)(l * 3 + 2) * MROWS * 4), 0u,
                            (unsigned)(WS_MOD + ((size_t)l * 3 * MODW + 5 * DM) * 4), 1.0f, DM / 64}; pg8::gemm_phase<pg8::EpiResid, pg8::ResidOrder, true, true>(F.lds + RING_OFF, g, S, E, F.wave); } SEAM(P + 9); }
        if (IN(P + 10) && l != DEPTH - 1) { for (int rep = 0; rep <= DUP(10); ++rep) { PH_BEGIN(); ctxnorm_phase(F, XC, KIN(6) + (size_t)(l * 3 + 2) * DM, modl, 2, (u16*)(ws + WS_HN), (const float*)(ws + WS_PART), modl + 2 * MODW + 5 * DM, 1.0f, (float*)(ws + WS_ROWSS) + (size_t)(l * 3 + 2) * MROWS, nullptr); } SEAM(P + 10); }
        if (IN(P + 11)) { for (int rep = 0; rep <= DUP(11); ++rep) { PH_BEGIN(); pg8::Gemm g{(const u16*)(ws + WS_HN), wl + WO_2IN / 2, MROWS, 2 * FFN, DM}; pg8::StaticOrder S; S.init(MROWS, 2 * FFN, DM, F.G, (int)blockIdx.x, l == DEPTH - 1);
            pg8::EpiSwiglu E{(u16*)(ws + WS_HD), {(const float*)(ws + WS_ROWSS) + (size_t)(l * 3 + 2) * MROWS, (const float*)(ws + WS_SW) + (size_t)(l * 3 + 2) * SW_STRIDE, 2 * FFN}}; pg8::gemm_phase<pg8::EpiSwiglu, pg8::StaticOrder, true, true>(F.lds + RING_OFF, g, S, E, F.wave); } if (l == 0 && DEPTH > 1) { KARGS(); conv_tail<0>(kp_, KWS(), L, (int)gridDim.x, (int)blockIdx.x, ((MROWS / 256) * (2 * FFN / 256)) % (int)gridDim.x, 0, TAIL_L1, wv_); } SEAM(P + 11); }
        if (IN(P + 12)) { for (int rep = DUP(12); rep >= 0; --rep) { PH_BEGIN(); pg8::Gemm g{(const u16*)(ws + WS_HD), wl + WO_2OUT / 2, MROWS, DM, FFN}; pg8::ResidOrder S; S.init(DM, FFN, F.G, (int)blockIdx.x, 8, l != DEPTH - 1);
            pg8::EpiResid E{XL, DXL, ws, l + 1 < DEPTH ? KIN(6) + (size_t)((l + 1) * 3 + 0) * DM : nullptr, (unsigned)(WS_MOD + ((size_t)(l + 1) * 3 * MODW + 1 * DM) * 4), (unsigned)(WS_ROWSS + (size_t)((l + 1) * 3 + 0) * MROWS * 4), 0u,
                            (unsigned)(WS_MOD + ((size_t)l * 3 * MODW + 8 * DM) * 4), 0.5f, FFN / 64}; pg8::gemm_phase<pg8::EpiResid, pg8::ResidOrder, true, true>(F.lds + RING_OFF, g, S, E, F.wave); } SEAM(P + 12); }
#undef PH_BEGIN
    }
#undef IN
#undef SEAM
#undef GRID_BAR
}

extern "C" void kernel_launch(void* const* d_in, const int* in_sizes, int n_in, void* d_out, int out_size, void* d_ws, size_t ws_size, hipStream_t stream) {
    static int grid = 0;
    if (grid == 0) {
        if (n_in != 22 || out_size != NB * SEQ * DM || ws_size < WS_END) { fprintf(stderr, "kernel_launch: built for 22 inputs, out %d floats, >= %zu bytes of workspace; got n_in %d, out %d, ws %zu; nothing launched\n", NB * SEQ * DM, (size_t)WS_END, n_in, out_size, ws_size); grid = -1; return; }
        int dev = 0, cus = 0, per_cu = 0;
        if (hipGetDevice(&dev) != hipSuccess || hipDeviceGetAttribute(&cus, hipDeviceAttributeMultiprocessorCount, dev) != hipSuccess) { fprintf(stderr, "kernel_launch: device query failed\n"); grid = -1; return; }
        if (hipFuncSetAttribute((const void*)trunk_fwd, hipFuncAttributeMaxDynamicSharedMemorySize, LDS_BYTES) != hipSuccess) { fprintf(stderr, "kernel_launch: hipFuncSetAttribute failed\n"); grid = -1; return; }
        if (hipOccupancyMaxActiveBlocksPerMultiprocessor(&per_cu, (const void*)trunk_fwd, NWAVES * 64, LDS_BYTES) != hipSuccess || per_cu < 1)
            fprintf(stderr, "kernel_launch: note: occupancy query reports %d workgroups per CU\n", per_cu);
        (void)hipGetLastError();
        grid = cus;
    }
    if (grid < 0) return;
    if (hipMemsetAsync((char*)d_ws + WS_CTL, 0, CTL_ZERO_BYTES, stream) != hipSuccess) { fprintf(stderr, "kernel_launch: hipMemsetAsync failed\n"); return; }
    Args a{};
    for (int i = 0; i < 22; ++i) a.in[i] = (const float*)d_in[i];
    a.out = (float*)d_out; a.ws = (unsigned char*)d_ws;
#if MK_N_LAUNCHES == 1
    a.ph_lo = 0; a.ph_hi = NPH;
    hipLaunchKernelGGL(trunk_fwd, dim3(grid), dim3(NWAVES * 64), LDS_BYTES, stream, a);
#else
    for (int p = 0; p < NPH; ++p) { a.ph_lo = p; a.ph_hi = p + 1; hipLaunchKernelGGL(trunk_fwd, dim3(grid), dim3(NWAVES * 64), LDS_BYTES, stream, a); }
#endif
    const hipError_t le = hipPeekAtLastError();
    if (le != hipSuccess) fprintf(stderr, "kernel_launch: launch failed: %s\n", hipGetErrorName(le));
}
```

```cpp
#include <hip/hip_runtime.h>
#include <cstdio>
#include <cstdint>

#ifndef DUPMASK
#define DUPMASK 0
#endif
#define DUP(k) ((DUPMASK >> (k)) & 1)
#ifndef MK_N_LAUNCHES
#define MK_N_LAUNCHES 1
#endif

constexpr int DM = 4096, NB = 2, SEQ = 4096, CTXL = 256, TPB = SEQ + CTXL  , MROWS = NB * TPB  ;
constexpr int FFN = 7168, NMOD = 9, MODW = NMOD * DM  , DEPTH = 2;
constexpr int INW = 22528, QKVW = 10240, SGW = 12288;
constexpr int PAN_PER_B = TPB / 256;
constexpr float EPS = 1e-6f;
constexpr int CQA = 0, CKA = 1536, CVA = 2048, CQB = 2560, CKB = 4096, CVB = 5632, CQC = 7168, CKC = 8192, CVC = 9216;

#define GAS __attribute__((address_space(1)))
#define LAS __attribute__((address_space(3)))
typedef unsigned short u16;
typedef unsigned v4u __attribute__((ext_vector_type(4)));
typedef unsigned v2u __attribute__((ext_vector_type(2)));
typedef float f32x4 __attribute__((ext_vector_type(4)));
typedef float f32x2 __attribute__((ext_vector_type(2)));
typedef GAS unsigned gu32;
#define RLX_AGENT __ATOMIC_RELAXED, __HIP_MEMORY_SCOPE_AGENT
#define LDS_WAIT() asm volatile("s_waitcnt lgkmcnt(0)" ::: "memory")
#define VM_WAIT() asm volatile("s_waitcnt vmcnt(0)" ::: "memory")
__device__ __forceinline__ unsigned f2bf(float f) { unsigned u = __builtin_bit_cast(unsigned, f); return (u + 0x7fffu + ((u >> 16) & 1u)) >> 16; }
__device__ __forceinline__ unsigned pk2(float lo, float hi) { return f2bf(lo) | (f2bf(hi) << 16); }
__device__ __forceinline__ float bf_lo(unsigned w) { return __builtin_bit_cast(float, w << 16); }
__device__ __forceinline__ float bf_hi(unsigned w) { return __builtin_bit_cast(float, w & 0xffff0000u); }
__device__ __forceinline__ unsigned cvt_pk_bf16(float lo, float hi) { unsigned r; asm volatile("v_cvt_pk_bf16_f32 %0, %1, %2" : "=v"(r) : "v"(lo), "v"(hi)); return r; }
__device__ __forceinline__ unsigned pk4_fp8(float a, float b, float c, float d) { unsigned w = 0; w = __builtin_amdgcn_cvt_pk_fp8_f32(a, b, w, false); w = __builtin_amdgcn_cvt_pk_fp8_f32(c, d, w, true); return w; }
__device__ __forceinline__ float fast_sigmoid(float v) { return __builtin_amdgcn_rcpf(1.0f + __builtin_amdgcn_exp2f(-1.4426950408889634f * v)); }

__device__ __forceinline__ int tid_of(int wv) { int t; asm volatile("v_mbcnt_lo_u32_b32 %0, -1, 0\n\tv_mbcnt_hi_u32_b32 %0, -1, %0\n\tv_lshl_or_b32 %0, %1, 6, %0" : "=&v"(t) : "s"(wv)); return t; }

namespace pg8 {
#define PG8_LAS __attribute__((address_space(3)))
typedef unsigned short bf16_t;
typedef short bf16x8 __attribute__((ext_vector_type(8)));
typedef float f32x4 __attribute__((ext_vector_type(4)));
typedef unsigned u32x4 __attribute__((ext_vector_type(4)));
typedef unsigned u32x2 __attribute__((ext_vector_type(2)));
typedef int i32x4 __attribute__((ext_vector_type(4)));
constexpr int BM = 256, BK = 64, HALF = 128, HTB = HALF * BK * 2  , STAGE_BYTES = 8 * HTB, NXCD = 8, WGM = 4;

__host__ __device__ __forceinline__ int lds_byte(int r, int c) { const int st = (r >> 4) * 2 + (c >> 5), rr = r & 15, cc = c & 31, ob = rr * 64 + cc * 2; return st * 1024 + (ob ^ (((ob >> 9) & 1) << 5)); }
__host__ __device__ __forceinline__ void stage_rc(int b, int& R, int& C) { const int st = b / 1024, sb = b % 1024, swz = sb ^ (((sb >> 9) & 1) << 5); R = (st >> 1) * 16 + swz / 64; C = (st & 1) * 32 + (swz % 64) / 2; }
__host__ __device__ __forceinline__ int perm32(int rho) { const int n = rho >> 4, i = rho & 15; return 8 * (i >> 2) + 4 * n + (i & 3); }

struct Unit { int pm, pn, kt0, nt; };
struct Gemm { const bf16_t* A; const bf16_t* Bt; int M, N, K; };

struct StaticOrder {
    int nM, nN, nwg, G, c, ntf, lat;
    __host__ __device__ void init(int M, int N, int K, int G_, int c_, int lat_only = 0) { lat = lat_only; nM = lat ? 32 : M / BM; nN = N / BM; nwg = nM * nN; G = G_; c = c_; ntf = K / BK; }
    __host__ __device__ __forceinline__ bool map(long L, Unit& u) const {
        if (L >= nwg) return false;
        int wgid = (int)L; { const int q = nwg / NXCD, r = nwg % NXCD, xcd = wgid % NXCD, off = wgid / NXCD; wgid = (xcd < r ? xcd * (q + 1) : r * (q + 1) + (xcd - r) * q) + off; }
        const int nig = WGM * nN, gid = wgid / nig, fm = gid * WGM, gsz = (nM - fm) < WGM ? (nM - fm) : WGM;
        u.pm = fm + ((wgid % nig) % gsz); u.pn = (wgid % nig) / gsz; if (lat) u.pm += u.pm >> 4; u.kt0 = 0; u.nt = ntf; return true;
    }
    __host__ __device__ __forceinline__ bool next(int i, Unit& u) const { return map((long)i * G + c, u); }
    __device__ __forceinline__ void a_ready(const Unit&) const {}
    __device__ __forceinline__ void done(const Unit&) const {}
};
template <int MODE> struct MapOrder { StaticOrder S; int extra;
    __host__ __device__ __forceinline__ bool next(int i, Unit& u) const { const int nl = S.G - extra, pre = extra > 0 ? 2 * nl : 0; long L;
        if (extra > 0 && S.c >= extra) L = i < 2 ? (long)i * nl + (S.c - extra) : (long)pre + (long)(i - 2) * S.G + S.c; else L = (long)pre + (long)i * S.G + S.c;
        const bool ok = S.map(L, u); const int p = u.pn;
        u.pn = p; return ok; }
    __device__ __forceinline__ void a_ready(const Unit&) const {}
    __device__ __forceinline__ void done(const Unit&) const {} };
struct ResidOrder {
    StaticOrder S; int KS, ctx;
    __host__ __device__ void init(int N, int K, int G_, int c_, int KS_, int ctx_) { S.init(MROWS, N, K, G_, c_, 1); KS = KS_; ctx = ctx_; }
    __host__ __device__ __forceinline__ bool next(int i, Unit& u) const {
        const long L = (long)i * S.G + S.c; const bool islat = L < S.nwg;
        Unit a; (void)S.map(islat ? L : 0, a);
        const long L2 = islat ? 0 : L - S.nwg; const int ks = (int)(L2 % KS), t = (int)(L2 / KS), cnt = S.ntf / KS;
        u.pn = islat ? a.pn : t % S.nN; u.pm = islat ? a.pm : (t / S.nN) * PAN_PER_B + (PAN_PER_B - 1); u.nt = islat ? a.nt : cnt; u.kt0 = islat ? 0 : ks * cnt;
        return islat || (ctx && L2 < 2 * S.nN * KS);
    }
    __device__ __forceinline__ void a_ready(const Unit&) const {}
    __device__ __forceinline__ void done(const Unit&) const {}
};


__device__ __forceinline__ size_t panel_off(int pm, bool& is_ctx, int& b) { b = pm / PAN_PER_B; const int j = pm - b * PAN_PER_B; is_ctx = (j == PAN_PER_B - 1); return is_ctx ? (size_t)(b * CTXL) * DM : (size_t)(b * SEQ + j * 256) * DM; }

struct EpiResid {
    static constexpr bool PERM = true, AFTER_DRAIN = false; static constexpr size_t WS_PART_OFF = (size_t)884 << 20, WS_HN_OFF = (size_t)17 << 20;
    __device__ static __forceinline__ bool keep(const Unit&) { return false; }
    const float* src_lat; float* dst_lat; unsigned char* wsb;
    const float* gsn; unsigned scale_off, rowss_off, xg8_off;
    unsigned gate_off; float coef; int ntf;
    __device__ __forceinline__ void operator()(const f32x4 (&acc)[2][2][4][2], const Unit& u, int wr, int wc, int fr, int fq) const {
        bool isc; int b; const size_t po = panel_off(u.pm, isc, b); const bool split = u.nt != ntf;
        const float* s = src_lat + po; float* d = dst_lat + po; const float* g = (const float*)(wsb + gate_off) + (size_t)b * MODW; float* part = (float*)(wsb + WS_PART_OFF);
        const int row0 = wr * 64 + fr, col0 = u.pn * BM + wc * 32 + 8 * fq;
        f32x4 gv[2][2];
#pragma unroll
        for (int bj = 0; bj < 2; ++bj)
#pragma unroll
            for (int n = 0; n < 2; ++n) gv[bj][n] = *(const f32x4*)(g + col0 + bj * HALF + n * 4) * coef;
        if (split) {
            float* pp = part + ((size_t)((u.kt0 * 8) / ntf) * (NB * CTXL) + (size_t)b * CTXL) * DM;
#pragma unroll
            for (int ai = 0; ai < 2; ++ai)
#pragma unroll
                for (int m = 0; m < 4; ++m) { const size_t off = (size_t)(row0 + ai * HALF + m * 16) * DM + col0;
#pragma unroll
                    for (int bj = 0; bj < 2; ++bj)
#pragma unroll
                        for (int n = 0; n < 2; ++n) *(f32x4*)(pp + off + bj * HALF + n * 4) = acc[ai][bj][m][n]; }
        } else {
            const bool mk = gsn != nullptr; float* rsp = (float*)(wsb + rowss_off) + u.pm * BM + row0; const float* scp = (const float*)(wsb + scale_off) + (size_t)b * MODW;
            bf16_t* xg = (bf16_t*)(wsb + WS_HN_OFF) + (size_t)u.pm * BM * DM; unsigned char* xg8 = wsb + ((size_t)xg8_off << 20) + (size_t)u.pm * BM * DM;
#pragma unroll
            for (int ai = 0; ai < 2; ++ai)
#pragma unroll
              for (int mp = 0; mp < 2; ++mp) {
                f32x4 sv[2][2][2];
#pragma unroll
                for (int mm = 0; mm < 2; ++mm) { const size_t off = (size_t)(row0 + ai * HALF + (mp * 2 + mm) * 16) * DM + col0;
#pragma unroll
                    for (int bj = 0; bj < 2; ++bj)
#pragma unroll
                        for (int n = 0; n < 2; ++n) sv[mm][bj][n] = *(const f32x4*)(s + off + bj * HALF + n * 4); }
#pragma unroll
                for (int mm = 0; mm < 2; ++mm) { const int m = mp * 2 + mm; const size_t off = (size_t)(row0 + ai * HALF + m * 16) * DM + col0; float q = 0.f;
#pragma unroll
                    for (int bj = 0; bj < 2; ++bj) { f32x4 xn[2];
#pragma unroll
                        for (int n = 0; n < 2; ++n) { xn[n] = sv[mm][bj][n] + gv[bj][n] * acc[ai][bj][m][n]; *(f32x4*)(d + off + bj * HALF + n * 4) = xn[n]; }
                        if (mk) { f32x4 y[2];
#pragma unroll
                            for (int n = 0; n < 2; ++n) { y[n] = xn[n] * (*(const f32x4*)(gsn + col0 + bj * HALF + n * 4) * (*(const f32x4*)(scp + col0 + bj * HALF + n * 4) + 1.0f)); q += (xn[n][0] * xn[n][0] + xn[n][1] * xn[n][1]) + (xn[n][2] * xn[n][2] + xn[n][3] * xn[n][3]); }
                            if (!xg8_off) { u32x4 w; w.x = cvt_pk_bf16(y[0][0], y[0][1]); w.y = cvt_pk_bf16(y[0][2], y[0][3]); w.z = cvt_pk_bf16(y[1][0], y[1][1]); w.w = cvt_pk_bf16(y[1][2], y[1][3]); *(u32x4*)(xg + off + bj * HALF) = w; }
                            else {   u32x2 w8; w8.x = pk4_fp8(y[0][0], y[0][1], y[0][2], y[0][3]); w8.y = pk4_fp8(y[1][0], y[1][1], y[1][2], y[1][3]); *(u32x2*)(xg8 + off + bj * HALF) = w8; } } }
                    if (mk) { q += __builtin_bit_cast(float, __builtin_amdgcn_ds_swizzle(__builtin_bit_cast(int, q), (16 << 10) | 0x1f));
                        if ((fq & 1) == 0) unsafeAtomicAdd(rsp + ai * HALF + m * 16, q); } }
                asm volatile("" ::: "memory"); }
        }
    }
};
struct NormFix {
    const float* rowss;
    const float* sw;
    int N;
    __device__ __forceinline__ void rows(const Unit& u, int wr, int fr, float (&rs)[2][4]) const {
#pragma unroll
        for (int ai = 0; ai < 2; ++ai)
#pragma unroll
            for (int m = 0; m < 4; ++m) rs[ai][m] = __builtin_amdgcn_rsqf(rowss[u.pm * BM + wr * 64 + fr + ai * HALF + m * 16] * (1.0f / DM) + EPS);
    }
    __device__ __forceinline__ const float* vecp(const Unit& u) const { const int b = u.pm / PAN_PER_B; return sw + (size_t)((u.pm - b * PAN_PER_B == PAN_PER_B - 1) ? 2 : b) * N; }
};
struct EpiSwiglu {
    static constexpr bool PERM = true, AFTER_DRAIN = false;
    __device__ static __forceinline__ bool keep(const Unit&) { return false; }
    bf16_t* H; NormFix nf;
    __device__ __forceinline__ void operator()(const f32x4 (&acc)[2][2][4][2], const Unit& u, int wr, int wc, int fr, int fq) const {
        const int row0 = u.pm * BM + wr * 64 + fr, col0 = u.pn * HALF + wc * 32 + 8 * fq;
        float rs[2][4]; nf.rows(u, wr, fr, rs);
        const float* swp = nf.vecp(u) + u.pn * BM + wc * 32 + 8 * fq; f32x4 sg[2], su[2];
#pragma unroll
        for (int n = 0; n < 2; ++n) { sg[n] = *(const f32x4*)(swp + 4 * n); su[n] = *(const f32x4*)(swp + HALF + 4 * n); }
#pragma unroll
        for (int ai = 0; ai < 2; ++ai)
#pragma unroll
            for (int m = 0; m < 4; ++m) { bf16_t* rowp = H + (size_t)(row0 + ai * HALF + m * 16) * FFN + col0;
                float h[8];
#pragma unroll
                for (int n = 0; n < 2; ++n)
#pragma unroll
                    for (int j = 0; j < 4; ++j) { const float gt = acc[ai][0][m][n][j] * rs[ai][m] + sg[n][j], up = acc[ai][1][m][n][j] * rs[ai][m] + su[n][j]; h[n * 4 + j] = gt * fast_sigmoid(gt) * up; }
                u32x4 w; w.x = cvt_pk_bf16(h[0], h[1]); w.y = cvt_pk_bf16(h[2], h[3]); w.z = cvt_pk_bf16(h[4], h[5]); w.w = cvt_pk_bf16(h[6], h[7]);
                *(u32x4*)rowp = w; }
    }
};
struct EpiInProj {
    static constexpr bool PERM = true, AFTER_DRAIN = false;
    __device__ static __forceinline__ bool keep(const Unit&) { return false; }
    bf16_t* QKV; bf16_t* SG; NormFix nf; int pn0; float ascale;
    __device__ __forceinline__ void operator()(const f32x4 (&acc)[2][2][4][2], const Unit& u, int wr, int wc, int fr, int fq) const {
        const int row0 = u.pm * BM + wr * 64 + fr, pn = u.pn + pn0; const bool isg = pn >= QKVW / BM;
        bf16_t* base = isg ? SG : QKV; const int ldc = isg ? SGW : QKVW; const int col0 = (isg ? pn - QKVW / BM : pn) * BM + wc * 32 + 8 * fq;
        float rs[2][4]; nf.rows(u, wr, fr, rs);
#pragma unroll
        for (int ai = 0; ai < 2; ++ai)
#pragma unroll
            for (int m = 0; m < 4; ++m) rs[ai][m] *= ascale;
        const float* swp = nf.vecp(u) + pn * BM + wc * 32 + 8 * fq; f32x4 sv[2][2];
#pragma unroll
        for (int bj = 0; bj < 2; ++bj)
#pragma unroll
            for (int n = 0; n < 2; ++n) sv[bj][n] = *(const f32x4*)(swp + bj * HALF + 4 * n);
#pragma unroll
        for (int ai = 0; ai < 2; ++ai)
#pragma unroll
            for (int m = 0; m < 4; ++m) { bf16_t* rowp = base + (size_t)(row0 + ai * HALF + m * 16) * ldc + col0;
#pragma unroll
                for (int bj = 0; bj < 2; ++bj) { f32x4 v0 = acc[ai][bj][m][0] * rs[ai][m] + sv[bj][0], v1 = acc[ai][bj][m][1] * rs[ai][m] + sv[bj][1];
                    if (isg) {
                        unsigned a = 0u, b = 0u;
#pragma unroll
                        for (int j = 0; j < 4; ++j) { a = __builtin_amdgcn_cvt_pk_u8_f32(fast_sigmoid(v0[j]) * 255.0f, j, a); b = __builtin_amdgcn_cvt_pk_u8_f32(fast_sigmoid(v1[j]) * 255.0f, j, b); }
                        u32x2 w8; w8.x = a; w8.y = b; *(u32x2*)((unsigned char*)SG + (size_t)(row0 + ai * HALF + m * 16) * SGW + col0 + bj * HALF) = w8;
                    } else {
                    u32x4 w; w.x = cvt_pk_bf16(v0[0], v0[1]); w.y = cvt_pk_bf16(v0[2], v0[3]); w.z = cvt_pk_bf16(v1[0], v1[1]); w.w = cvt_pk_bf16(v1[2], v1[3]);
                    *(u32x4*)(rowp + bj * HALF) = w; } } }
    }
};
struct EpiGate {
    static constexpr bool PERM = true, AFTER_DRAIN = false;
    __device__ static __forceinline__ bool keep(const Unit& u) { return u.kt0 + u.nt < DM / BK; }
    const bf16_t* SG; bf16_t* MXB;
    __device__ __forceinline__ void operator()(f32x4 (&acc)[2][2][4][2], const Unit& u, int wr, int wc, int fr, int fq) const {
        const int row0 = u.pm * BM + wr * 64 + fr, col0 = u.pn * BM + wc * 32 + 8 * fq;
        const bool lastbr = !keep(u); const int gc0 = (u.kt0 == 0 ? 0 : (u.kt0 == 24 ? DM : 2 * DM));
#pragma unroll
        for (int ai = 0; ai < 2; ++ai)
#pragma unroll
            for (int mp = 0; mp < 2; ++mp) {
                u32x2 gw[2][2], hw[2][2];
#pragma unroll
                for (int mm = 0; mm < 2; ++mm) { const unsigned char* rp = (const unsigned char*)SG + (size_t)(row0 + ai * HALF + (mp * 2 + mm) * 16) * SGW + gc0 + col0;
#pragma unroll
                    for (int bj = 0; bj < 2; ++bj) { gw[mm][bj] = *(const u32x2*)(rp + bj * HALF); if (!lastbr) hw[mm][bj] = *(const u32x2*)(rp + DM + bj * HALF); } }
#pragma unroll
                for (int mm = 0; mm < 2; ++mm) { const int m = mp * 2 + mm;
#pragma unroll
                    for (int bj = 0; bj < 2; ++bj) { const u32x2 a = gw[mm][bj]; f32x4 g[2];
#define GB(w_, j_) fmaxf((float)(((w_) >> (8 * (j_))) & 0xffu), 1e-18f)
#pragma unroll
                        for (int j = 0; j < 4; ++j) { g[0][j] = GB(a.x, j); g[1][j] = GB(a.y, j); }
                        if (!lastbr) { const u32x2 h = hw[mm][bj];
#pragma unroll
                            for (int j = 0; j < 4; ++j) { g[0][j] *= __builtin_amdgcn_rcpf(GB(h.x, j)); g[1][j] *= __builtin_amdgcn_rcpf(GB(h.y, j)); }
                            acc[ai][bj][m][0] = acc[ai][bj][m][0] * g[0]; acc[ai][bj][m][1] = acc[ai][bj][m][1] * g[1];
                        } else { const f32x4 v0 = acc[ai][bj][m][0] * (g[0] * (1.0f / 255.0f)), v1 = acc[ai][bj][m][1] * (g[1] * (1.0f / 255.0f)); u32x4 w; w.x = cvt_pk_bf16(v0[0], v0[1]); w.y = cvt_pk_bf16(v0[2], v0[3]); w.z = cvt_pk_bf16(v1[0], v1[1]); w.w = cvt_pk_bf16(v1[2], v1[3]);
                            *(u32x4*)(MXB + (size_t)(row0 + ai * HALF + m * 16) * DM + col0 + bj * HALF) = w; } } }
                asm volatile("" ::: "memory"); }
#undef GB
    }
};
struct GateOrder {
    StaticOrder S;
    __host__ __device__ __forceinline__ bool next(int i, Unit& u) const { const int ti = i / 3, br = i - 3 * ti; const bool ok = S.next(ti, u); u.kt0 = br * 24; u.nt = br == 2 ? 16 : 24; return ok; }
    __device__ __forceinline__ void a_ready(const Unit&) const {}
    __device__ __forceinline__ void done(const Unit&) const {}
};

template <class Epi, class Sched, bool ALIGN_EPI = false, bool SP2 = false, bool FP8 = false>
__device__ __forceinline__ void gemm_phase(PG8_LAS unsigned char* lds, const Gemm g, const Sched& S, const Epi& E, int wv  ) {
    int tid_ = tid_of(wv);
    const int tid = tid_, wid = wv, lane = tid & 63, wr = wid >> 2, wc = wid & 3, fr = lane & 15, fq = lane >> 4;
    const int K = g.K;
    unsigned voffA[2], voffB[2];
#pragma unroll
    for (int i = 0; i < 2; ++i) { int R, C; stage_rc(tid * 16 + i * 8192, R, C); const int Rb = Epi::PERM ? ((R & ~31) + perm32(R & 31)) : R;
        voffA[i] = (unsigned)(R * K + C) * 2u; voffB[i] = (unsigned)(Rb * K + C) * 2u; }
    const size_t kstep = (size_t)(BK * 2);
    const size_t hstep = (size_t)HALF * K * 2;
    const size_t tstep = 2 * hstep;
    const unsigned ldsw = (unsigned)wid * 1024u;
    const int aoff = lds_byte(wr * 64 + fr, fq * 8), boff = lds_byte(wc * 32 + fr, fq * 8);
#define PG8_SA(b, h) (((b) * 2 + (h)) * HTB)
#define PG8_SB(b, h) ((4 + (b) * 2 + (h)) * HTB)
#define PG8_STAGE(bufoff, gbase, voff) do { _Pragma("unroll") for (int _i = 0; _i < 2; ++_i) { unsigned vo_ = (voff)[_i]; asm volatile("" : "+v"(vo_));     \
        __builtin_amdgcn_global_load_lds((const unsigned*)((const char*)(gbase) + vo_), (PG8_LAS unsigned*)(lds + (bufoff) + ldsw + _i * 8192), 16, 0, 0); } } while (0)
#define PG8_LDA(dst, b, h) do { _Pragma("unroll") for (int m = 0; m < 4; ++m) _Pragma("unroll") for (int k = 0; k < 2; ++k) dst[m][k] = *(const PG8_LAS bf16x8*)(lds + PG8_SA(b, h) + aoff + m * 2048 + k * 1024); } while (0)
#define PG8_LDB(dst, b, h) do { _Pragma("unroll") for (int n = 0; n < 2; ++n) _Pragma("unroll") for (int k = 0; k < 2; ++k) dst[n][k] = *(const PG8_LAS bf16x8*)(lds + PG8_SB(b, h) + boff + n * 2048 + k * 1024); } while (0)
#define PG8_CAT(x, y) __builtin_shufflevector(__builtin_bit_cast(i32x4, x), __builtin_bit_cast(i32x4, y), 0, 1, 2, 3, 4, 5, 6, 7)
#define PG8_MMA(ai, bj, At, Bt) do { __builtin_amdgcn_s_setprio(1); _Pragma("unroll") for (int m = 0; m < 4; ++m) _Pragma("unroll") for (int n = 0; n < 2; ++n) { \
        if constexpr (FP8) acc[ai][bj][m][n] = __builtin_amdgcn_mfma_scale_f32_16x16x128_f8f6f4(PG8_CAT(Bt[n][0], Bt[n][1]), PG8_CAT(At[m][0], At[m][1]), acc[ai][bj][m][n], 0, 0, 0, 0x7F7F7F7F, 0, 0x7F7F7F7F); \
        else { _Pragma("unroll") for (int k = 0; k < 2; ++k) acc[ai][bj][m][n] = __builtin_amdgcn_mfma_f32_16x16x32_bf16(Bt[n][k], At[m][k], acc[ai][bj][m][n], 0, 0, 0); } } __builtin_amdgcn_s_setprio(0); } while (0)
#define PG8_WAIT_V(n) asm volatile("s_waitcnt vmcnt(" #n ")" ::: "memory")
#define PG8_WAIT_L(n) asm volatile("s_waitcnt lgkmcnt(" #n ")" ::: "memory")
#define PG8_BAR __builtin_amdgcn_s_barrier()
#define PG8_SCHED __builtin_amdgcn_sched_barrier(0)
    Unit cur, nxt; int ui = 0;
    if (!S.next(0, cur)) return;
    f32x4 acc[2][2][4][2];
#pragma unroll
    for (int a = 0; a < 2; ++a)
#pragma unroll
        for (int b = 0; b < 2; ++b)
#pragma unroll
            for (int m = 0; m < 4; ++m)
#pragma unroll
                for (int n = 0; n < 2; ++n) acc[a][b][m][n] = (f32x4){0.f, 0.f, 0.f, 0.f};
    bf16x8 At[4][2], B0[2][2], B1[2][2];
    const char* cA = (const char*)g.A + (size_t)cur.pm * tstep + (size_t)cur.kt0 * kstep; const char* cB = (const char*)g.Bt + (size_t)cur.pn * tstep + (size_t)cur.kt0 * kstep;
    S.a_ready(cur);
    if constexpr (SP2) {
        PG8_STAGE(PG8_SB(0, 0), cB, voffB); PG8_STAGE(PG8_SB(0, 1), cB + hstep, voffB); PG8_STAGE(PG8_SA(0, 0), cA, voffA); PG8_STAGE(PG8_SA(0, 1), cA + hstep, voffA);
        if (wr == 1) PG8_BAR;
        PG8_WAIT_V(2); PG8_BAR;
        PG8_STAGE(PG8_SB(1, 0), cB + kstep, voffB); PG8_STAGE(PG8_SA(1, 0), cA + kstep, voffA); PG8_STAGE(PG8_SB(1, 1), cB + hstep + kstep, voffB);
        PG8_WAIT_V(6); PG8_BAR;
    } else {
        PG8_STAGE(PG8_SB(0, 0), cB, voffB); PG8_STAGE(PG8_SA(0, 0), cA, voffA); PG8_STAGE(PG8_SB(0, 1), cB + hstep, voffB); PG8_STAGE(PG8_SA(0, 1), cA + hstep, voffA);
        if (wr == 1) PG8_BAR;
        PG8_WAIT_V(4); PG8_BAR;
        PG8_STAGE(PG8_SB(1, 0), cB + kstep, voffB); PG8_STAGE(PG8_SA(1, 0), cA + kstep, voffA); PG8_STAGE(PG8_SB(1, 1), cB + hstep + kstep, voffB);
        PG8_WAIT_V(6); PG8_BAR;
    }
    for (;;) {
        const bool has_next = S.next(ui + 1, nxt);
        const char* nA = has_next ? (const char*)g.A + (size_t)nxt.pm * tstep + (size_t)nxt.kt0 * kstep : cA; const char* nB = has_next ? (const char*)g.Bt + (size_t)nxt.pn * tstep + (size_t)nxt.kt0 * kstep : cB;
        const int nt = cur.nt;
        for (int t = 0; t < nt; t += 2) {
            const bool last = (t == nt - 2);
            const char* a1 = cA + (size_t)(t + 1) * kstep;
            const char* a2 = last ? nA : cA + (size_t)(t + 2) * kstep; const char* b2 = last ? nB : cB + (size_t)(t + 2) * kstep;
            const char* a3 = a2 + kstep; const char* b3 = b2 + kstep;
            if (last && has_next) S.a_ready(nxt);
            if constexpr (SP2) {
            PG8_LDB(B0, 0, 0); PG8_LDB(B1, 0, 1); PG8_SCHED; PG8_LDA(At, 0, 0); PG8_STAGE(PG8_SA(1, 1), a1 + hstep, voffA);
            PG8_WAIT_V(8); PG8_WAIT_L(0); PG8_BAR; PG8_MMA(0, 0, At, B0); PG8_MMA(0, 1, At, B1); PG8_BAR; PG8_SCHED;
            PG8_LDA(At, 0, 1); PG8_STAGE(PG8_SB(0, 0), b2, voffB); PG8_STAGE(PG8_SB(0, 1), b2 + hstep, voffB); PG8_STAGE(PG8_SA(0, 0), a2, voffA);
            PG8_WAIT_V(8); PG8_WAIT_L(0); PG8_BAR; PG8_MMA(1, 0, At, B0); PG8_MMA(1, 1, At, B1); PG8_BAR; PG8_SCHED;
            PG8_LDB(B0, 1, 0); PG8_LDB(B1, 1, 1); PG8_SCHED; PG8_LDA(At, 1, 0); PG8_STAGE(PG8_SA(0, 1), a2 + hstep, voffA);
            PG8_WAIT_V(8); PG8_WAIT_L(0); PG8_BAR; PG8_MMA(0, 0, At, B0); PG8_MMA(0, 1, At, B1); PG8_BAR; PG8_SCHED;
            PG8_LDA(At, 1, 1); PG8_STAGE(PG8_SB(1, 0), b3, voffB); PG8_STAGE(PG8_SB(1, 1), b3 + hstep, voffB); PG8_STAGE(PG8_SA(1, 0), a3, voffA);
            PG8_WAIT_V(8); PG8_WAIT_L(0); PG8_BAR; PG8_MMA(1, 0, At, B0); PG8_MMA(1, 1, At, B1); PG8_BAR; PG8_SCHED;
            } else {
            PG8_LDB(B0, 0, 0); PG8_SCHED; PG8_LDA(At, 0, 0); PG8_STAGE(PG8_SA(1, 1), a1 + hstep, voffA);
            PG8_WAIT_L(8); PG8_BAR; PG8_WAIT_L(0); PG8_MMA(0, 0, At, B0); PG8_BAR; PG8_SCHED;
            PG8_LDB(B1, 0, 1); PG8_STAGE(PG8_SB(0, 0), b2, voffB);
            PG8_BAR; PG8_WAIT_L(0); PG8_MMA(0, 1, At, B1); PG8_BAR;
            PG8_LDA(At, 0, 1); PG8_STAGE(PG8_SA(0, 0), a2, voffA);
            PG8_BAR; PG8_WAIT_L(0); PG8_MMA(1, 0, At, B0); PG8_BAR; PG8_SCHED;
            PG8_STAGE(PG8_SB(0, 1), b2 + hstep, voffB);
            PG8_WAIT_V(6); PG8_BAR; PG8_MMA(1, 1, At, B1); PG8_BAR;
            PG8_LDB(B0, 1, 0); PG8_SCHED; PG8_LDA(At, 1, 0); PG8_STAGE(PG8_SA(0, 1), a2 + hstep, voffA);
            PG8_WAIT_L(8); PG8_BAR; PG8_WAIT_L(0); PG8_MMA(0, 0, At, B0); PG8_BAR; PG8_SCHED;
            PG8_LDB(B1, 1, 1); PG8_STAGE(PG8_SB(1, 0), b3, voffB);
            PG8_BAR; PG8_WAIT_L(0); PG8_MMA(0, 1, At, B1); PG8_BAR;
            PG8_LDA(At, 1, 1); PG8_STAGE(PG8_SA(1, 0), a3, voffA);
            PG8_BAR; PG8_WAIT_L(0); PG8_MMA(1, 0, At, B0); PG8_BAR; PG8_SCHED;
            PG8_STAGE(PG8_SB(1, 1), b3 + hstep, voffB);
            PG8_WAIT_V(6); PG8_BAR; PG8_MMA(1, 1, At, B1); PG8_BAR;
            }
        }
        if constexpr (ALIGN_EPI) { if (wr == 0) PG8_BAR; }
        if constexpr (!Epi::AFTER_DRAIN) { const int t_e = tid_of(wv); const int fr_e = t_e & 15, fq_e = (t_e & 63) >> 4;
            E(acc, cur, wr, wc, fr_e, fq_e); S.done(cur); }
        if (!has_next) break;
        if (!Epi::keep(cur))
#pragma unroll
        for (int a = 0; a < 2; ++a)
#pragma unroll
            for (int b = 0; b < 2; ++b)
#pragma unroll
                for (int m = 0; m < 4; ++m)
#pragma unroll
                    for (int n = 0; n < 2; ++n) acc[a][b][m][n] = (f32x4){0.f, 0.f, 0.f, 0.f};
        cur = nxt; cA = nA; cB = nB; ++ui;
        if constexpr (ALIGN_EPI) { if (wr == 1) PG8_BAR; }
    }
    PG8_WAIT_V(0);
    if constexpr (!ALIGN_EPI) { if (wr == 0) PG8_BAR; }
    PG8_BAR;
#undef PG8_SA
#undef PG8_SB
#undef PG8_STAGE
#undef PG8_LDA
#undef PG8_LDB
#undef PG8_MMA
#undef PG8_CAT
#undef PG8_WAIT_V
#undef PG8_WAIT_L
#undef PG8_BAR
#undef PG8_SCHED
}
}

namespace att {
using bf16x8 = __attribute__((ext_vector_type(8))) short;
using s16x4  = __attribute__((ext_vector_type(4))) short;
using f32x16 = __attribute__((ext_vector_type(16))) float;
using u32x4  = __attribute__((ext_vector_type(4))) unsigned;
constexpr int NW = 8, QBLK = 32, KVBLK = 64;
constexpr int SHM_V = 16384, SHM_K = 16384;
constexpr int OFF_V = 0, OFF_K = 2 * SHM_V, OFF_WS = OFF_K + 2 * SHM_K, OFF_BIAS = OFF_WS + 2048, OFF_SLOT = OFF_BIAS + 2048, ATT_LDS = OFF_SLOT + 64;
constexpr float THR = 8.f;
constexpr int LD = QKVW;
#define KSWZ128(row, colB) ((row) * 256 + ((colB) ^ (((row) & 7) << 4)))
#define KSWZ64(row, colB) ((row) * 128 + ((colB) ^ ((((row) >> 1) & 7) << 4)))
#define SBAR() __builtin_amdgcn_sched_barrier(0)
__device__ __forceinline__ int crow(int r, int hi) { return (r & 3) + 8 * (r >> 2) + 4 * hi; }
__device__ __forceinline__ unsigned cvtpk(float lo, float hi) { unsigned r; asm volatile("v_cvt_pk_bf16_f32 %0, %1, %2" : "=v"(r) : "v"(lo), "v"(hi)); return r; }

struct Unit {
    const u16* Q;
    const u16* K;
    const u16* V;
    u16* O; int ldo;
    int NT, n0, base0, base1;
    int r0, first;
    const float* qgain;
    const float* qrope; int t0;
};

template <int DQK>
__device__ __forceinline__ void partialSM(f32x16& p0, f32x16& p1, float& m_reg, float& mn, float& alpha) {
  constexpr float SCALE = DQK == 128 ? 0.08838834764831845f : 0.125f;
  constexpr float C = SCALE * 1.4426950408889634f;
  float pmax = p0[0];
#pragma unroll
  for (int r = 1; r < 16; ++r) pmax = fmaxf(pmax, p0[r]);
#pragma unroll
  for (int r = 0; r < 16; ++r) pmax = fmaxf(pmax, p1[r]);
  { auto rr = __builtin_amdgcn_permlane32_swap(__float_as_uint(pmax), __float_as_uint(pmax), false, false);
    pmax = fmaxf(__uint_as_float(rr[0]), __uint_as_float(rr[1])); }
  if (__builtin_expect(__all(pmax - m_reg <= THR / SCALE), 1)) { mn = m_reg; alpha = 1.f; }
  else { mn = fmaxf(m_reg, pmax); alpha = __builtin_amdgcn_exp2f((m_reg - mn) * C); m_reg = mn; }
  float mnC = -mn * C;
#pragma unroll
  for (int r = 0; r < 16; ++r) p0[r] = fmaf(p0[r], C, mnC);
#pragma unroll
  for (int r = 0; r < 16; ++r) p1[r] = fmaf(p1[r], C, mnC);
#pragma unroll
  for (int r = 0; r < 16; ++r) p0[r] = __builtin_amdgcn_exp2f(p0[r]);
}
__device__ __forceinline__ void finishSM(f32x16& p0, f32x16& p1, float alpha, float& l_reg, bf16x8& pa0, bf16x8& pa1, bf16x8& pa2, bf16x8& pa3) {
#pragma unroll
  for (int r = 0; r < 16; ++r) p1[r] = __builtin_amdgcn_exp2f(p1[r]);
  float ps = 0;
#pragma unroll
  for (int r = 0; r < 16; ++r) ps += p0[r];
#pragma unroll
  for (int r = 0; r < 16; ++r) ps += p1[r];
  { auto rr = __builtin_amdgcn_permlane32_swap(__float_as_uint(ps), __float_as_uint(ps), false, false);
    ps = __uint_as_float(rr[0]) + __uint_as_float(rr[1]); }
  l_reg = l_reg * alpha + ps;
#define PK4(P, BASE, OUT) do { unsigned a0 = cvtpk(P[BASE + 0], P[BASE + 1]), a1 = cvtpk(P[BASE + 2], P[BASE + 3]);   \
    unsigned b0 = cvtpk(P[BASE + 4], P[BASE + 5]), b1 = cvtpk(P[BASE + 6], P[BASE + 7]);                              \
    auto r0 = __builtin_amdgcn_permlane32_swap(a0, b0, false, false); auto r1 = __builtin_amdgcn_permlane32_swap(a1, b1, false, false); \
    u32x4 w = {r0[0], r1[0], r0[1], r1[1]}; OUT = *reinterpret_cast<bf16x8*>(&w); } while (0)
  PK4(p0, 0, pa0); PK4(p0, 8, pa1); PK4(p1, 0, pa2); PK4(p1, 8, pa3);
#undef PK4
}
template <int DQK>
__device__ __forceinline__ void qkt(f32x16& p0, f32x16& p1, const char* Ks, const bf16x8* qr, int r32, int hi) {
  p0 = f32x16{}; p1 = f32x16{};
#pragma unroll
  for (int d0 = 0; d0 < DQK / 16; ++d0) { const int cb = (d0 * 16 + hi * 8) * 2;
    bf16x8 b0, b1;
    if constexpr (DQK == 128) { b0 = *reinterpret_cast<const bf16x8*>(Ks + KSWZ128(r32, cb)); b1 = *reinterpret_cast<const bf16x8*>(Ks + KSWZ128(32 + r32, cb)); }
    else                      { b0 = *reinterpret_cast<const bf16x8*>(Ks + KSWZ64(r32, cb));  b1 = *reinterpret_cast<const bf16x8*>(Ks + KSWZ64(32 + r32, cb)); }
    p0 = __builtin_amdgcn_mfma_f32_32x32x16_bf16(b0, qr[d0], p0, 0, 0, 0);
    p1 = __builtin_amdgcn_mfma_f32_32x32x16_bf16(b1, qr[d0], p1, 0, 0, 0); }
}
__device__ __forceinline__ int v_st(int k, int c) { const int kk = (k & ~0xC) | ((k & 4) << 1) | ((k & 8) >> 1); return ((kk >> 3) * 4 + (c >> 5)) * 512 + ((kk & 7) * 32 + (c & 31)) * 2; }
__device__ __forceinline__ int v_rd_base(int lane) { return ((lane & 3) << 3) | (((lane >> 2) & 3) << 6) | (((lane >> 4) & 1) << 5) | (((lane >> 5) & 1) << 8); }
constexpr int v_rd_off(int d0, int ks, int half) { return d0 * 512 + ks * 4096 + half * 2048; }
template <int OFF> __device__ __forceinline__ s16x4 tr_read(int vb) {
  s16x4 r; asm volatile("ds_read_b64_tr_b16 %0, %1 offset:%2" : "=&v"(r) : "v"(vb), "i"(OFF) : "memory"); return r;
}
template <int D0> __device__ __forceinline__ void pv_one(f32x16& od, int vb, bf16x8 pa0, bf16x8 pa1, bf16x8 pa2, bf16x8 pa3) {
  const s16x4 l0 = tr_read<v_rd_off(D0, 0, 0)>(vb), h0 = tr_read<v_rd_off(D0, 0, 1)>(vb), l1 = tr_read<v_rd_off(D0, 1, 0)>(vb), h1 = tr_read<v_rd_off(D0, 1, 1)>(vb);
  const s16x4 l2 = tr_read<v_rd_off(D0, 2, 0)>(vb), h2 = tr_read<v_rd_off(D0, 2, 1)>(vb), l3 = tr_read<v_rd_off(D0, 3, 0)>(vb), h3 = tr_read<v_rd_off(D0, 3, 1)>(vb);
  asm volatile("s_waitcnt lgkmcnt(0)" ::: "memory"); SBAR();
#define PK(L, H) (bf16x8){L[0], L[1], L[2], L[3], H[0], H[1], H[2], H[3]}
  od = __builtin_amdgcn_mfma_f32_32x32x16_bf16(pa0, PK(l0, h0), od, 0, 0, 0);
  od = __builtin_amdgcn_mfma_f32_32x32x16_bf16(pa1, PK(l1, h1), od, 0, 0, 0);
  od = __builtin_amdgcn_mfma_f32_32x32x16_bf16(pa2, PK(l2, h2), od, 0, 0, 0);
  od = __builtin_amdgcn_mfma_f32_32x32x16_bf16(pa3, PK(l3, h3), od, 0, 0, 0);
#undef PK
}
__device__ __forceinline__ void pv_d0(f32x16* o, int vb, bf16x8 pa0, bf16x8 pa1, bf16x8 pa2, bf16x8 pa3) {
  pv_one<0>(o[0], vb, pa0, pa1, pa2, pa3); pv_one<1>(o[1], vb, pa0, pa1, pa2, pa3); pv_one<2>(o[2], vb, pa0, pa1, pa2, pa3); pv_one<3>(o[3], vb, pa0, pa1, pa2, pa3);
}

template <int DQK, int MODE, int SD>
__device__ __forceinline__ void attn_unit(const Unit& U, char* lds, int wv) {
  constexpr int ND = DQK / 16;
  int tid_ = tid_of(wv);
  const int tid = tid_, wid = wv, lane = tid & 63, r32 = lane & 31, hi = lane >> 5;
  char* V_lds = lds + OFF_V; char* K_lds = lds + OFF_K;
  float* ws = (float*)(lds + OFF_WS) + wid * 64; float* li_l = ws; float* al_l = ws + 32;
  const float* biasq = (const float*)(lds + OFF_BIAS);
  float m_reg = -1e30f, l_reg = 0; f32x16 o[4] = {}; bf16x8 qr[ND];
  { const char* Qw = (const char*)U.Q + (unsigned)(((wid * QBLK + r32) * LD + hi * 8) * 2);
#pragma unroll
    for (int d0 = 0; d0 < ND; ++d0) qr[d0] = *reinterpret_cast<const bf16x8*>(Qw + d0 * 32);
    float ssq = 0.f;
#pragma unroll
    for (int d0 = 0; d0 < ND; ++d0) { const u32x4 w = *reinterpret_cast<const u32x4*>(&qr[d0]);
#pragma unroll
      for (int e = 0; e < 4; ++e) { const float a = bf_lo(w[e]), b = bf_hi(w[e]); ssq += a * a + b * b; } }
    { auto rr = __builtin_amdgcn_permlane32_swap(__float_as_uint(ssq), __float_as_uint(ssq), false, false); ssq = __uint_as_float(rr[0]) + __uint_as_float(rr[1]); }
    const float rstdq = 1.0f / sqrtf(ssq * (1.0f / DQK) + EPS);
    const int tq = U.t0 + wid * QBLK + r32, gq = (tq >> 6) & 63, cq = tq & 63; constexpr int NP = DQK / 4;
#pragma unroll
    for (int d0 = 0; d0 < ND; ++d0) { const u32x4 w = *reinterpret_cast<const u32x4*>(&qr[d0]); const int dd = d0 * 16 + hi * 8;
      const f32x4 g0 = *(const f32x4*)(U.qgain + dd), g1 = *(const f32x4*)(U.qgain + dd + 4);
      float x[8]; x[0] = bf_lo(w[0]) * rstdq * g0[0]; x[1] = bf_hi(w[0]) * rstdq * g0[1]; x[2] = bf_lo(w[1]) * rstdq * g0[2]; x[3] = bf_hi(w[1]) * rstdq * g0[3];
      x[4] = bf_lo(w[2]) * rstdq * g1[0]; x[5] = bf_hi(w[2]) * rstdq * g1[1]; x[6] = bf_lo(w[3]) * rstdq * g1[2]; x[7] = bf_hi(w[3]) * rstdq * g1[3];
      if (U.qrope != nullptr) { const int i0 = dd >> 1; const float* tp = U.qrope + 2 * ((i0 < NP) ? gq * NP + i0 : cq * NP + i0 - NP);
        const f32x4 c01 = *(const f32x4*)tp, c23 = *(const f32x4*)(tp + 4); float y;
        y = x[0] * c01[0] - x[1] * c01[1]; x[1] = x[0] * c01[1] + x[1] * c01[0]; x[0] = y;
        y = x[2] * c01[2] - x[3] * c01[3]; x[3] = x[2] * c01[3] + x[3] * c01[2]; x[2] = y;
        y = x[4] * c23[0] - x[5] * c23[1]; x[5] = x[4] * c23[1] + x[5] * c23[0]; x[4] = y;
        y = x[6] * c23[2] - x[7] * c23[3]; x[7] = x[6] * c23[3] + x[7] * c23[2]; x[6] = y; }
      u32x4 o = {cvtpk(x[0], x[1]), cvtpk(x[2], x[3]), cvtpk(x[4], x[5]), cvtpk(x[6], x[7])}; qr[d0] = *reinterpret_cast<bf16x8*>(&o); } }
  const int sr = tid >> 4, sc = (tid & 15) * 8, vst0 = v_st(sr, sc), vst1 = v_st(32 + sr, sc);
  const int kr64 = tid >> 3, kc64 = (tid & 7) * 8;
  const unsigned gofs = (unsigned)((sr * LD + sc) * 2), gofs64 = (unsigned)((kr64 * LD + kc64) * 2);
  const int vb0 = (int)(uintptr_t)V_lds + v_rd_base(lane);
  struct { bf16x8 vs0, vs1, ks0, ks1; } sr_[SD];
  const int n0 = U.n0, base0 = U.base0, base1 = U.base1;
#define TROW(j) ((j) < n0 ? base0 + 64 * (j) : base1 + 64 * ((j) - n0))
#define SLOAD(i, j) do { const size_t tb_ = (size_t)(TROW(j)) * (LD * 2); const char* vp_ = (const char*)U.V + tb_; const char* kp_ = (const char*)U.K + tb_; \
    sr_[i].vs0 = *reinterpret_cast<const bf16x8*>(vp_ + gofs); sr_[i].vs1 = *reinterpret_cast<const bf16x8*>(vp_ + 32 * LD * 2 + gofs); \
    if constexpr (DQK == 128) { sr_[i].ks0 = *reinterpret_cast<const bf16x8*>(kp_ + gofs); sr_[i].ks1 = *reinterpret_cast<const bf16x8*>(kp_ + 32 * LD * 2 + gofs); } \
    else { sr_[i].ks0 = *reinterpret_cast<const bf16x8*>(kp_ + gofs64); } } while (0)
#define SWRITE(b, i) do { *(bf16x8*)(V_lds + (b) * SHM_V + vst0) = sr_[i].vs0; *(bf16x8*)(V_lds + (b) * SHM_V + vst1) = sr_[i].vs1; \
    if constexpr (DQK == 128) { const int kc = sc * 2; *(bf16x8*)(K_lds + (b) * SHM_K + KSWZ128(sr, kc)) = sr_[i].ks0; *(bf16x8*)(K_lds + (b) * SHM_K + KSWZ128(32 + sr, kc)) = sr_[i].ks1; } \
    else { *(bf16x8*)(K_lds + (b) * SHM_K + KSWZ64(kr64, kc64 * 2)) = sr_[i].ks0; } } while (0)
#define SWAIT() do { if constexpr (SD == 1) asm volatile("s_waitcnt vmcnt(0)" ::: "memory"); else if constexpr (DQK == 128) asm volatile("s_waitcnt vmcnt(4)" ::: "memory"); else asm volatile("s_waitcnt vmcnt(3)" ::: "memory"); } while (0)
#define RESC(a) do { if (__any((a) < 1.f)) { if (hi == 0) al_l[r32] = (a); asm volatile("s_waitcnt lgkmcnt(0)" ::: "memory"); \
    _Pragma("unroll") for (int d = 0; d < 4; ++d) _Pragma("unroll") for (int r = 0; r < 16; ++r) o[d][r] *= al_l[crow(r, hi)]; } } while (0)
#define MASK(P0, P1, j) do { if constexpr (MODE == 1) { if ((j) >= n0) { const int kr_ = U.first + ((j) - n0); \
      const int qgr_ = U.r0 + (wid >> 1), qc_ = 32 * (wid & 1) + r32, rs_ = min(max(qgr_ - 4, 0), 56), cs_ = min(max(qc_ - 8, 0), 48); \
      if ((unsigned)(kr_ - rs_) < 8u) { const float* brow_ = biasq + (kr_ - qgr_ + 7) * 31 + 15 - qc_; \
        _Pragma("unroll") for (int r = 0; r < 16; ++r) { const int kc_ = crow(r, hi); \
          P0[r] = ((unsigned)(kc_ - cs_) < 16u) ? P0[r] + brow_[kc_] : -__builtin_inff(); \
          P1[r] = ((unsigned)(kc_ + 32 - cs_) < 16u) ? P1[r] + brow_[kc_ + 32] : -__builtin_inff(); } } \
      else { _Pragma("unroll") for (int r = 0; r < 16; ++r) { P0[r] = -__builtin_inff(); P1[r] = -__builtin_inff(); } } } } } while (0)
  f32x16 pA0, pA1, pB0, pB1; float mnA, mnB, alA, alB; bf16x8 pa0, pa1, pa2, pa3; const int NT = U.NT;
  constexpr int SE = 0, SO = SD - 1;
  SLOAD(SE, 0); asm volatile("s_waitcnt vmcnt(0)" ::: "memory"); SWRITE(0, SE); __syncthreads();
  qkt<DQK>(pA0, pA1, K_lds, qr, r32, hi); MASK(pA0, pA1, 0); partialSM<DQK>(pA0, pA1, m_reg, mnA, alA);
  SLOAD(SO, 1); if constexpr (SD == 2) { if (2 < NT) SLOAD(SE, 2); }
  SWAIT(); SWRITE(1, SO); __syncthreads();
  for (int j = 1; j + 1 < NT; j += 2) {
    SBAR(); qkt<DQK>(pB0, pB1, K_lds + SHM_K, qr, r32, hi);
    finishSM(pA0, pA1, alA, l_reg, pa0, pa1, pa2, pa3); SBAR();
    SLOAD(SO, j + SD); SBAR();
    pv_d0(o, vb0, pa0, pa1, pa2, pa3); MASK(pB0, pB1, j); partialSM<DQK>(pB0, pB1, m_reg, mnB, alB);
    __syncthreads(); SWAIT(); SWRITE(0, SE);
    RESC(alB); __syncthreads();
    SBAR(); qkt<DQK>(pA0, pA1, K_lds, qr, r32, hi);
    finishSM(pB0, pB1, alB, l_reg, pa0, pa1, pa2, pa3); SBAR();
    if (SD == 1 || j + 3 < NT) SLOAD(SE, j + 1 + SD); SBAR();
    pv_d0(o, vb0 + SHM_V, pa0, pa1, pa2, pa3); MASK(pA0, pA1, j + 1); partialSM<DQK>(pA0, pA1, m_reg, mnA, alA);
    __syncthreads(); SWAIT(); SWRITE(1, SO);
    RESC(alA); __syncthreads();
  }
  SBAR(); qkt<DQK>(pB0, pB1, K_lds + SHM_K, qr, r32, hi);
  finishSM(pA0, pA1, alA, l_reg, pa0, pa1, pa2, pa3); SBAR();
  pv_d0(o, vb0, pa0, pa1, pa2, pa3); MASK(pB0, pB1, NT - 1); partialSM<DQK>(pB0, pB1, m_reg, mnB, alB);
  __syncthreads(); RESC(alB);
  finishSM(pB0, pB1, alB, l_reg, pa0, pa1, pa2, pa3); SBAR();
  pv_d0(o, vb0 + SHM_V, pa0, pa1, pa2, pa3);
  if (hi == 0) li_l[r32] = l_reg; asm volatile("s_waitcnt lgkmcnt(0)" ::: "memory");
  char* Ow = (char*)U.O + (size_t)(wid * QBLK) * U.ldo * 2;
  __syncthreads();
  { char* Os = lds + wid * 8192;
#pragma unroll
    for (int r = 0; r < 16; ++r) { const int orow = crow(r, hi); const float rl = __builtin_amdgcn_rcpf(li_l[orow]);
#pragma unroll
      for (int d0 = 0; d0 < 4; ++d0) *(u16*)(Os + orow * 256 + (d0 * 32 + r32) * 2) = (u16)f2bf(o[d0][r] * rl); }
    asm volatile("s_waitcnt lgkmcnt(0)" ::: "memory");
#pragma unroll
    for (int i = 0; i < 8; ++i) { const int row = i * 4 + (lane >> 4); const v4u v = *(const v4u*)(Os + row * 256 + (lane & 15) * 16); *(v4u*)(Ow + (size_t)row * U.ldo * 2 + (lane & 15) * 16) = v; } }
#undef TROW
#undef SLOAD
#undef SWRITE
#undef SWAIT
#undef RESC
#undef MASK
}
#undef SBAR
}

constexpr size_t MiB = 1u << 20;
constexpr size_t al1(size_t x) { return (x + MiB - 1) / MiB * MiB; }
constexpr size_t WS_CTL = 0, CTL_ZERO_BYTES = 8 * MiB;
constexpr size_t WS_MOD = 1 * MiB;
constexpr size_t WS_ROWSS = 2 * MiB;
constexpr size_t WS_SW = 4 * MiB;
constexpr int SW_STRIDE = 3 * INW;
constexpr size_t WS_MISC = 8 * MiB;
constexpr size_t WS_XC = 9 * MiB;
constexpr size_t WS_HN = WS_XC + al1((size_t)NB * CTXL * DM * 4);
constexpr size_t WS_HD = WS_HN + al1((size_t)MROWS * DM * 2);
constexpr size_t WS_QKV = WS_HD + al1((size_t)MROWS * FFN * 2);
constexpr size_t WS_SG = WS_QKV + al1((size_t)MROWS * QKVW * 2);
constexpr size_t WS_OCAT = WS_SG + al1((size_t)MROWS * SGW * 2);
constexpr size_t WS_OCR = WS_OCAT + al1((size_t)MROWS * DM * 2);
constexpr size_t WS_MX = WS_OCR + al1((size_t)MROWS * 2048 * 2);
constexpr size_t WS_MXB = WS_MX + al1((size_t)MROWS * DM * 4);
constexpr size_t WS_PART = WS_MXB + al1((size_t)MROWS * DM * 2);
constexpr size_t WS_W = WS_PART + al1((size_t)8 * NB * CTXL * DM * 4);
constexpr size_t WO_1IN = 0, WO_1OUT = WO_1IN + (size_t)2 * FFN * DM * 2, WO_2IN = WO_1OUT + (size_t)DM * FFN * 2, WO_2OUT = WO_2IN + (size_t)2 * FFN * DM * 2,
                 WO_IN = WO_2OUT + (size_t)DM * FFN * 2, WO_BR = WO_IN + (size_t)INW * DM * 2  ,
                 WO_OUT = WO_BR + (size_t)DM * DM * 2, W_LAYER = WO_OUT + (size_t)DM * DM * 2;
constexpr size_t WS_W8 = WS_W + DEPTH * W_LAYER;
constexpr size_t W8_LAYER = (size_t)INW * DM;
constexpr size_t WS_XG8 = WS_W8 + DEPTH * W8_LAYER;
constexpr size_t WS_END = WS_XG8 + al1((size_t)MROWS * DM);
static_assert((WS_XG8 & (MiB - 1)) == 0 && WS_ROWSS + (size_t)DEPTH * 3 * MROWS * 4 <= WS_SW && WS_SW + (size_t)DEPTH * 3 * SW_STRIDE * 4 <= CTL_ZERO_BYTES && WS_PART == pg8::EpiResid::WS_PART_OFF && WS_HN == pg8::EpiResid::WS_HN_OFF && WS_MOD + (size_t)DEPTH * 3 * MODW * 4 < ((size_t)1 << 32), "EpiResid's workspace offsets");
constexpr int MI_TA = 0, MI_TC = 64 * 32 * 2, MI_LAM = MI_TC + 64 * 16 * 2;
constexpr int CW_TMO = 0, CW_BAR = 4096, CW_ATTQ = 16384;

constexpr int RING_OFF = 0, RING_BYTES = 131072;
constexpr int LDSCTL_OFF = RING_BYTES, MISC_OFF = LDSCTL_OFF + 320;
constexpr int LDS_BYTES = 147456;
constexpr int NWAVES = 8;

#define XB_TMO      128
#define XB_XCNT(j)  (256  + 64 * (j))
#define XB_XSUB(j)  (1280 + 64 * (j))
#define XB_XGEN(j)  (2304 + 64 * (j))
#define XB_TOP      3328
#define XB_TOPGEN   3392
#define XCD_BAR_WORDS 3456
#define XB_SPIN_CAP (1u << 18)

__device__ __forceinline__ unsigned xb_ld(unsigned* p)              { return __hip_atomic_load(p, __ATOMIC_RELAXED, __HIP_MEMORY_SCOPE_AGENT); }
__device__ __forceinline__ unsigned xb_add(unsigned* p, unsigned v) { return __hip_atomic_fetch_add(p, v, __ATOMIC_RELAXED, __HIP_MEMORY_SCOPE_AGENT); }
__device__ __forceinline__ unsigned xb_xcc_id() { return (unsigned)__builtin_amdgcn_s_getreg((3 << 11) | 20) & 0xFu; }
#define XB_SPIN(cond, bar) do { unsigned _sp = 0; while (cond) { __builtin_amdgcn_s_sleep(1); \
    if ((++_sp & 255u) == 0u) { if (xb_ld(&(bar)[XB_TMO])) break; if (_sp > XB_SPIN_CAP) { atomicAdd(&(bar)[XB_TMO], 1u); break; } } } } while (0)

struct XcdBarrier {
    unsigned* bar; unsigned x;
    volatile LAS unsigned* st;
};
__device__ __forceinline__ XcdBarrier xcd_barrier_post(unsigned* bar, volatile LAS unsigned* st, bool lead  ) {
    XcdBarrier b; b.bar = bar; b.x = xb_xcc_id(); b.st = st;
    if (lead) (void)xb_add(&bar[XB_XCNT(b.x)], 1u);
    return b;
}
__device__ __forceinline__ void xcd_barrier_complete(unsigned* bar, unsigned x, unsigned& nloc, unsigned& nx) {
    const unsigned G = gridDim.x * gridDim.y * gridDim.z;
    unsigned sum, cnt, mine, sp = 0u;
    for (;;) {
        sum = 0u; cnt = 0u; mine = 0u;
#pragma unroll
        for (unsigned j = 0; j < 16; ++j) { const unsigned c = xb_ld(&bar[XB_XCNT(j)]); sum += c; cnt += (c > 0u) ? 1u : 0u; mine = (j == x) ? c : mine; }
        if (sum == G) break;
        __builtin_amdgcn_s_sleep(1);
        if ((++sp & 255u) == 0u) { if (xb_ld(&bar[XB_TMO])) break; if (sp > XB_SPIN_CAP) { atomicAdd(&bar[XB_TMO], 1u); break; } }
    }
    nloc = mine > 0u ? mine : 1u; nx = cnt > 0u ? cnt : 1u;
}
__device__ __forceinline__ void xcd_barrier(const XcdBarrier& b, bool lead  ) {
    asm volatile("s_waitcnt vmcnt(0)" ::: "memory");
    __syncthreads();
    if (lead) {
        unsigned* bar = b.bar;
        __builtin_amdgcn_s_waitcnt(0);
        unsigned nloc = b.st[0], nx = b.st[1];
        if (nloc == 0u) { xcd_barrier_complete(bar, b.x, nloc, nx); b.st[0] = nloc; b.st[1] = nx; }
        const unsigned old = xb_add(&bar[XB_XSUB(b.x)], 1u);
        const unsigned gen = old / nloc;
        if (old + 1u == (gen + 1u) * nloc) {
            __builtin_amdgcn_fence(__ATOMIC_RELEASE, "agent");
            asm volatile("s_waitcnt vmcnt(0)" ::: "memory");
            const unsigned og = xb_add(&bar[XB_TOP], 1u);
            const unsigned tg = og / nx;
            if (og + 1u == (tg + 1u) * nx) xb_add(&bar[XB_TOPGEN], 1u);
            else XB_SPIN(xb_ld(&bar[XB_TOPGEN]) == tg, bar);
            __builtin_amdgcn_fence(__ATOMIC_ACQUIRE, "agent");
            xb_add(&bar[XB_XGEN(b.x)], 1u);
            asm volatile("s_waitcnt vmcnt(0)" ::: "memory");
        } else {
            XB_SPIN(xb_ld(&bar[XB_XGEN(b.x)]) == gen, bar);
            __builtin_amdgcn_fence(__ATOMIC_ACQUIRE, "agent");
            asm volatile("s_waitcnt vmcnt(0)" ::: "memory");
        }
    }
    __syncthreads();
}

struct Args {
    const float* in[22];
    float* out; unsigned char* ws;
    int ph_lo, ph_hi;
};
struct Frame {
    LAS unsigned char* lds;
    volatile LAS unsigned* MISC;
    gu32* ctl;
    int tid, lane, wave, vcu, G;
};
template <int X> __device__ __forceinline__ float swz_xor(float v) { return __builtin_bit_cast(float, __builtin_amdgcn_ds_swizzle(__builtin_bit_cast(int, v), (X << 10) | 0x1f)); }
__device__ __forceinline__ float sum16(float v) { v += swz_xor<1>(v); v += swz_xor<2>(v); v += swz_xor<4>(v); v += swz_xor<8>(v); return v; }
__device__ __forceinline__ float sum8(float v) { v += swz_xor<1>(v); v += swz_xor<2>(v); v += swz_xor<4>(v); return v; }
__device__ __forceinline__ float wave_sum(float v) {
    v = sum16(v); v += swz_xor<16>(v);
    const float lo = __builtin_bit_cast(float, __builtin_amdgcn_readlane(__builtin_bit_cast(int, v), 0)), hi = __builtin_bit_cast(float, __builtin_amdgcn_readlane(__builtin_bit_cast(int, v), 32));
    return lo + hi;
}
template <int NKB>
__device__ __forceinline__ void p0_transpose_item(const float* W, int K, int Nsrc, u16* WT, int Kdst, int nblk, int smap, LAS float* scr, int item, int lane, const float* shift, float* sw, int Nsw, unsigned char* W8 = nullptr) {
    const int kbg = item / nblk, nb = item - kbg * nblk, n0 = 32 * nb;
    const int s0 = smap ? (((n0 & 255) >> 7) * FFN + (n0 >> 8) * 128 + (n0 & 127)) : n0;
    float a0 = 0.f, a1 = 0.f, a2 = 0.f;
    for (int kq = 0; kq < NKB; ++kq) {
        const int k0 = 64 * (kbg * NKB + kq);
        { f32x4 v[8];
#pragma unroll
          for (int i = 0; i < 8; ++i) v[i] = __builtin_nontemporal_load((const f32x4*)(W + (size_t)(k0 + 8 * i + (lane >> 3)) * Nsrc + s0 + (lane & 7) * 4));
#pragma unroll
          for (int i = 0; i < 8; ++i) { LAS float* d = scr + (8 * i + (lane >> 3)) * 33 + (lane & 7) * 4; d[0] = v[i].x; d[1] = v[i].y; d[2] = v[i].z; d[3] = v[i].w; } }
        if (NKB > 1) { scr[2112 + lane] = shift[k0 + lane]; scr[2176 + lane] = shift[MODW + k0 + lane]; scr[2240 + lane] = shift[2 * MODW + k0 + lane]; }
        LDS_WAIT(); asm volatile("" ::: "memory");
        const int c = lane & 7;
#pragma unroll
        for (int j = 0; j < 4; ++j) { const int n = (lane >> 3) + 8 * j; const LAS float* s = scr + (8 * c) * 33 + n;
            if (W8 != nullptr) {
                v2u o; o.x = pk4_fp8(s[0 * 33] * 64.f, s[1 * 33] * 64.f, s[2 * 33] * 64.f, s[3 * 33] * 64.f); o.y = pk4_fp8(s[4 * 33] * 64.f, s[5 * 33] * 64.f, s[6 * 33] * 64.f, s[7 * 33] * 64.f);
                *(GAS v2u*)(W8 + (size_t)(n0 + n) * Kdst + k0 + 8 * c) = o;
            } else {
            v4u o; o.x = pk2(s[0 * 33], s[1 * 33]); o.y = pk2(s[2 * 33], s[3 * 33]); o.z = pk2(s[4 * 33], s[5 * 33]); o.w = pk2(s[6 * 33], s[7 * 33]);
            *(GAS v4u*)(WT + (size_t)(n0 + n) * Kdst + k0 + 8 * c) = o; } }
        if (NKB > 1) { const int n = lane & 31, kh = 32 * (lane >> 5);
#pragma unroll 8
            for (int kk = 0; kk < 32; ++kk) { const float w = scr[(kh + kk) * 33 + n]; a0 += w * scr[2112 + kh + kk]; a1 += w * scr[2176 + kh + kk]; a2 += w * scr[2240 + kh + kk]; } }
        LDS_WAIT(); asm volatile("" ::: "memory");
    }
    if (NKB > 1) { float* o = sw + n0 + (lane & 31); unsafeAtomicAdd(o, a0); unsafeAtomicAdd(o + Nsw, a1); unsafeAtomicAdd(o + 2 * Nsw, a2); }
}
__device__ __forceinline__ void p0_ada_item(const float* c, const float* c_ctx, const float* w_ada, const float* b_ada, float* MOD, LAS float* scr, int item, int lane) {
    const int l = item / (32 * 144), r = item - l * (32 * 144), kc = r / 144, cg = r - kc * 144, k0 = kc * 128, col = cg * 256 + lane * 4;
#pragma unroll
    for (int i = 0; i < 2; ++i) { const int k = k0 + i * 64 + lane;
        const float a = c[k], b = c[DM + k], d = c_ctx[k];
        scr[i * 64 + lane] = a * fast_sigmoid(a); scr[256 + i * 64 + lane] = b * fast_sigmoid(b); scr[512 + i * 64 + lane] = d * fast_sigmoid(d); }
    LDS_WAIT(); asm volatile("" ::: "memory");
    const float* wp = w_ada + (size_t)l * DM * MODW + (size_t)k0 * MODW + col;
    f32x4 a0 = {0.f, 0.f, 0.f, 0.f}, a1 = a0, a2 = a0;
#pragma unroll 8
    for (int k = 0; k < 128; ++k) { const f32x4 w = __builtin_nontemporal_load((const f32x4*)(wp + (size_t)k * MODW)); a0 += w * scr[k]; a1 += w * scr[256 + k]; a2 += w * scr[512 + k]; }
    if (kc == 0) { const f32x4 bv = *(const f32x4*)(b_ada + (size_t)l * MODW + col); a0 += bv; a1 += bv; a2 += bv; }
    float* m = MOD + (size_t)l * 3 * MODW + col;
#pragma unroll
    for (int j = 0; j < 4; ++j) { unsafeAtomicAdd(m + j, a0[j]); unsafeAtomicAdd(m + MODW + j, a1[j]); unsafeAtomicAdd(m + 2 * MODW + j, a2[j]); }
    LDS_WAIT(); asm volatile("" ::: "memory");
}

__device__ __forceinline__ void modnorm_phase(const Frame& F, const float* xl, const float* xc, const float* g, const float* modl  , int sub, u16* HN, float* xc_copy  ,
                                              const float* part  , const float* pgate, float pcoef, float* xc_out, float* rowss, bool ctx_only  , unsigned char* hn8  ) {
    const int gw = F.vcu * NWAVES + F.wave, NGW = F.G * NWAVES;
    for (int it = gw; it < (ctx_only ? NB * CTXL : MROWS); it += NGW) {
        const int row = ctx_only ? (it / CTXL) * TPB + SEQ + it % CTXL : it;
        const int b = row / TPB, t = row - b * TPB; const bool isc = t >= SEQ;
        const float* xr = isc ? xc + (size_t)(b * CTXL + t - SEQ) * DM : xl + (size_t)(b * SEQ + t) * DM;
        const float* mv = modl + (size_t)(isc ? 2 : b) * MODW + (size_t)(3 * sub) * DM;
        f32x4 v[16]; float ss = 0.f;
#pragma unroll
        for (int j = 0; j < 16; ++j) { v[j] = *(const f32x4*)(xr + j * 256 + F.lane * 4); ss += (v[j].x * v[j].x + v[j].y * v[j].y) + (v[j].z * v[j].z + v[j].w * v[j].w); }
        if (isc && part) {
            const int cr = b * CTXL + t - SEQ; ss = 0.f;
#pragma unroll
            for (int j = 0; j < 16; ++j) { const int c0 = j * 256 + F.lane * 4; f32x4 a = *(const f32x4*)(part + (size_t)cr * DM + c0);
#pragma unroll
                for (int ks = 1; ks < 8; ++ks) a += *(const f32x4*)(part + ((size_t)ks * (NB * CTXL) + cr) * DM + c0);
                v[j] += a * (*(const f32x4*)(pgate + c0) * pcoef); *(f32x4*)(xc_out + (size_t)cr * DM + c0) = v[j];
                ss += (v[j].x * v[j].x + v[j].y * v[j].y) + (v[j].z * v[j].z + v[j].w * v[j].w); }
        }
        ss = wave_sum(ss); if (F.lane == 0) rowss[row] = ss;
        if (isc && xc_copy) { float* cr = xc_copy + (size_t)(b * CTXL + t - SEQ) * DM;
#pragma unroll
            for (int j = 0; j < 16; ++j) *(f32x4*)(cr + j * 256 + F.lane * 4) = v[j]; }
        u16* orow = HN + (size_t)row * DM;
#pragma unroll
        for (int j = 0; j < 16; ++j) { const int c0 = j * 256 + F.lane * 4;
            const f32x4 gg = *(const f32x4*)(g + c0), sc = *(const f32x4*)(mv + DM + c0);
            const f32x4 y = v[j] * gg * (sc + 1.0f);
            v2u w; w.x = pk2(y.x, y.y); w.y = pk2(y.z, y.w); *(v2u*)(orow + c0) = w;
            if (hn8) *(unsigned*)(hn8 + (size_t)row * DM + c0) = pk4_fp8(y.x, y.y, y.z, y.w); }
    }
}

__device__ __forceinline__ void ctxnorm_phase(const Frame& F, float* xc, const float* g, const float* modl, int sub, u16* HN, const float* part, const float* pgate, float pcoef, float* rowss, unsigned char* hn8) {
    const int gw = F.vcu * NWAVES + F.wave, NGW = F.G * NWAVES;
    const float* mv = modl + (size_t)2 * MODW + (size_t)(3 * sub) * DM;
    for (int it = gw; it < NB * CTXL * 4; it += NGW) {
        const int cr = it >> 2, q = it & 3, b = cr / CTXL, row = b * TPB + SEQ + (cr - b * CTXL);
        float* xr = xc + (size_t)cr * DM + q * 1024 + F.lane * 4;
        f32x4 v[4]; float ss = 0.f;
#pragma unroll
        for (int j = 0; j < 4; ++j) v[j] = *(const f32x4*)(xr + j * 256);
        if (part) {
#pragma unroll
            for (int j = 0; j < 4; ++j) { const int c0 = q * 1024 + j * 256 + F.lane * 4; f32x4 a = *(const f32x4*)(part + (size_t)cr * DM + c0);
#pragma unroll
                for (int ks = 1; ks < 8; ++ks) a += *(const f32x4*)(part + ((size_t)ks * (NB * CTXL) + cr) * DM + c0);
                v[j] += a * (*(const f32x4*)(pgate + c0) * pcoef); *(f32x4*)(xr + j * 256) = v[j]; }
        }
#pragma unroll
        for (int j = 0; j < 4; ++j) ss += (v[j].x * v[j].x + v[j].y * v[j].y) + (v[j].z * v[j].z + v[j].w * v[j].w);
        ss = wave_sum(ss); if (F.lane == 0) unsafeAtomicAdd(rowss + row, ss);
#pragma unroll
        for (int j = 0; j < 4; ++j) { const int c0 = q * 1024 + j * 256 + F.lane * 4;
            const f32x4 gg = *(const f32x4*)(g + c0), sc = *(const f32x4*)(mv + DM + c0);
            const f32x4 y = v[j] * gg * (sc + 1.0f);
            if (hn8) *(unsigned*)(hn8 + (size_t)row * DM + c0) = pk4_fp8(y.x, y.y, y.z, y.w);
            else { v2u w; w.x = pk2(y.x, y.y); w.y = pk2(y.z, y.w); *(v2u*)(HN + (size_t)row * DM + c0) = w; } }
    }
}

template <int KIND  >
__device__ __forceinline__ v4u qk_one(v4u w, const float* gain, bool lat, int gr, int gcl, const f32x2* T, int sub) {
    float x[8]; x[0] = bf_lo(w.x); x[1] = bf_hi(w.x); x[2] = bf_lo(w.y); x[3] = bf_hi(w.y); x[4] = bf_lo(w.z); x[5] = bf_hi(w.z); x[6] = bf_lo(w.w); x[7] = bf_hi(w.w);
    float ss = 0.f;
#pragma unroll
    for (int e = 0; e < 8; ++e) ss += x[e] * x[e];
    ss = (KIND != 2) ? sum16(ss) : sum8(ss);
    const float rstd = 1.0f / sqrtf(ss * (KIND == 2 ? 1.0f / 64.0f : 1.0f / 128.0f) + EPS);
    const int s = KIND == 2 ? (sub & 7) : sub;
    const f32x4 g0 = *(const f32x4*)(gain + 8 * s), g1 = *(const f32x4*)(gain + 8 * s + 4);
    x[0] *= rstd * g0[0]; x[1] *= rstd * g0[1]; x[2] *= rstd * g0[2]; x[3] *= rstd * g0[3]; x[4] *= rstd * g1[0]; x[5] *= rstd * g1[1]; x[6] *= rstd * g1[2]; x[7] *= rstd * g1[3];
    if (KIND != 1 && lat) {
        constexpr int NP = KIND == 0 ? 32 : 16;
        const int i0 = 4 * s; const f32x2* tp = (i0 < NP) ? T + gr * NP + i0 : T + gcl * NP + i0 - NP;
        const f32x4 c01 = *(const f32x4*)tp, c23 = *(const f32x4*)(tp + 2);
        float y;
        y = x[0] * c01[0] - x[1] * c01[1]; x[1] = x[0] * c01[1] + x[1] * c01[0]; x[0] = y;
        y = x[2] * c01[2] - x[3] * c01[3]; x[3] = x[2] * c01[3] + x[3] * c01[2]; x[2] = y;
        y = x[4] * c23[0] - x[5] * c23[1]; x[5] = x[4] * c23[1] + x[5] * c23[0]; x[4] = y;
        y = x[6] * c23[2] - x[7] * c23[3]; x[7] = x[6] * c23[3] + x[7] * c23[2]; x[6] = y;
    }
    v4u o; o.x = pk2(x[0], x[1]); o.y = pk2(x[2], x[3]); o.z = pk2(x[4], x[5]); o.w = pk2(x[6], x[7]); return o;
}
__device__ __forceinline__ void qkprep_phase(const Frame& F, u16* QKV, u16* QOUT, const float* ga, const float* gb, const float* gc, const float* misc) {
    const int gw = F.vcu * NWAVES + F.wave, NGW = F.G * NWAVES, sub = F.lane & 15;
    const f32x2* TA = (const f32x2*)(misc + MI_TA); const f32x2* TC = (const f32x2*)(misc + MI_TC);
    for (int row = gw; row < MROWS; row += NGW) {
        const int t = row % TPB; const bool lat = t < SEQ; const int gr = (t >> 6) & 63, gcl = t & 63;
        u16* rp = QKV + (size_t)row * QKVW + F.lane * 8; u16* wp = QOUT + (size_t)row * QKVW + F.lane * 8;
        v4u v[6];
#pragma unroll
        for (int jj = 0; jj < 6; ++jj) { const int j = jj == 0 ? 3 : (jj < 4 ? 6 + jj : 8 + jj); const int col = j < 4 ? j * 512 : (j < 10 ? CQB + (j - 4) * 512 : CQC + (j - 10) * 512); v[jj] = *(const v4u*)(rp + col); }
#pragma unroll
        for (int jj = 0; jj < 6; ++jj) { const int j = jj == 0 ? 3 : (jj < 4 ? 6 + jj : 8 + jj); const int col = j < 4 ? j * 512 : (j < 10 ? CQB + (j - 4) * 512 : CQC + (j - 10) * 512);
            v4u o;
            if (j < 4)       o = qk_one<0>(v[jj], ga + 128, lat, gr, gcl, TA, sub);
            else if (j < 10) o = qk_one<1>(v[jj], gb + 128, lat, gr, gcl, TA, sub);
            else             o = qk_one<2>(v[jj], gc + 64, lat, gr, gcl, TC, sub);
            *(v4u*)(wp + col) = o; }
    }
}

__device__ __forceinline__ void ccombine_phase(const Frame& F, const u16* OCR, u16* OC, const float* subln, float lam, float one_m_li) {
    const int gw = F.vcu * NWAVES + F.wave, NGW = F.G * NWAVES, sub = F.lane & 15, grp = F.lane >> 4;
    const f32x4 s0 = *(const f32x4*)(subln + 8 * sub) * one_m_li, s1 = *(const f32x4*)(subln + 8 * sub + 4) * one_m_li;
    for (int row = gw; row < MROWS; row += NGW) {
        const u16* rp = OCR + (size_t)row * 2048 + grp * 256 + sub * 8;
        v4u a[2], b[2];
#pragma unroll
        for (int j = 0; j < 2; ++j) { a[j] = *(const v4u*)(rp + j * 1024); b[j] = *(const v4u*)(rp + j * 1024 + 128); }
#pragma unroll
        for (int j = 0; j < 2; ++j) {
            float d[8]; d[0] = bf_lo(a[j].x) - lam * bf_lo(b[j].x); d[1] = bf_hi(a[j].x) - lam * bf_hi(b[j].x); d[2] = bf_lo(a[j].y) - lam * bf_lo(b[j].y); d[3] = bf_hi(a[j].y) - lam * bf_hi(b[j].y);
            d[4] = bf_lo(a[j].z) - lam * bf_lo(b[j].z); d[5] = bf_hi(a[j].z) - lam * bf_hi(b[j].z); d[6] = bf_lo(a[j].w) - lam * bf_lo(b[j].w); d[7] = bf_hi(a[j].w) - lam * bf_hi(b[j].w);
            float ss = 0.f;
#pragma unroll
            for (int e = 0; e < 8; ++e) ss += d[e] * d[e];
            ss = sum16(ss);
            const float rstd = 1.0f / sqrtf(ss * (1.0f / 128.0f) + EPS);
            v4u o; o.x = pk2(d[0] * rstd * s0[0], d[1] * rstd * s0[1]); o.y = pk2(d[2] * rstd * s0[2], d[3] * rstd * s0[3]); o.z = pk2(d[4] * rstd * s1[0], d[5] * rstd * s1[1]); o.w = pk2(d[6] * rstd * s1[2], d[7] * rstd * s1[3]);
            *(v4u*)(OC + (size_t)row * DM + 3072 + (j * 4 + grp) * 128 + sub * 8) = o;
        }
    }
}

constexpr int PPL = 13, NPH = 2 + DEPTH * PPL;
typedef const float* __attribute__((address_space(4))) const* kargp_t;
#define KARGS() kargp_t kp_ = (kargp_t)__builtin_amdgcn_kernarg_segment_ptr(); asm volatile("" : "+s"(kp_))
#define KIN(i) ((const float*)kp_[i])
#define KOUT() ((float*)kp_[22])
#define KWS() ((unsigned char*)kp_[23])
constexpr int H_FIN = (DM / 512) * (2 * FFN / 32), H_IN = (DM / 512) * (INW / 32), H_LAYER = 2 * H_FIN + H_IN;
constexpr int I_FOUT = (FFN / 64) * (DM / 32), I_BRA = (1536 / 64) * (DM / 32), I_BRC = (1024 / 64) * (DM / 32), I_OUT = (DM / 64) * (DM / 32), I_LAYER = 2 * I_FOUT + 2 * I_BRA + I_BRC + I_OUT;
constexpr int TAIL_L1 = 22528, TAIL_H = 12800, T2_H = 7168;
__device__ __forceinline__ void conv_heavy(kargp_t kp_, unsigned char* ws, LAS float* scr, int l, int r, int lane) {
    int ai, Nsrc, smap, which, ksh; size_t wo;
    if (r < H_FIN) { ai = 7; Nsrc = 2 * FFN; wo = WO_1IN; smap = 1; which = 0; ksh = 0; }
    else if ((r -= H_FIN) < H_IN) { ai = 11; Nsrc = INW; wo = WO_IN; smap = 0; which = 1; ksh = 3; }
    else { r -= H_IN; ai = 9; Nsrc = 2 * FFN; wo = WO_2IN; smap = 1; which = 2; ksh = 6; }
    p0_transpose_item<8>(KIN(ai) + (size_t)l * DM * Nsrc, DM, Nsrc, (u16*)(ws + WS_W + (size_t)l * W_LAYER + wo), DM, Nsrc / 32, smap, scr, r, lane,
                         (const float*)(ws + WS_MOD) + (size_t)l * 3 * MODW + (size_t)ksh * DM, (float*)(ws + WS_SW) + (size_t)(l * 3 + which) * SW_STRIDE, Nsrc,
                         which == 1 ? ws + WS_W8 + (size_t)l * W8_LAYER : nullptr);
}
__device__ __forceinline__ void conv_light(kargp_t kp_, unsigned char* ws, LAS float* scr, int l, int r, int lane) {
    int ai, K, Kdst = 0; size_t wo;
    if (r < I_FOUT) { ai = 8; K = FFN; wo = WO_1OUT; }
    else if ((r -= I_FOUT) < I_FOUT) { ai = 10; K = FFN; wo = WO_2OUT; }
    else if ((r -= I_FOUT) < I_BRA) { ai = 18; K = 1536; wo = WO_BR; Kdst = DM; }
    else if ((r -= I_BRA) < I_BRA) { ai = 19; K = 1536; wo = WO_BR + 1536 * 2; Kdst = DM; }
    else if ((r -= I_BRA) < I_BRC) { ai = 20; K = 1024; wo = WO_BR + 3072 * 2; Kdst = DM; }
    else { r -= I_BRC; ai = 21; K = DM; wo = WO_OUT; }
    p0_transpose_item<1>(KIN(ai) + (size_t)l * K * DM, K, DM, (u16*)(ws + WS_W + (size_t)l * W_LAYER + wo), Kdst ? Kdst : K, DM / 32, 0, scr, r, lane, nullptr, nullptr, 0);
}
__device__ __forceinline__ int l0_early(int j) { return j < I_FOUT ? j : j + I_FOUT; }
__device__ __forceinline__ int l0_late(int j) { return j < I_FOUT ? j + I_FOUT : j + 2 * I_BRA + I_BRC + I_FOUT; }
template <int KIND> __device__ __forceinline__ void conv_tail(kargp_t kp_, unsigned char* ws, LAS unsigned char* lds, int G, int c, int busy, int lo, int hi, int wv) {
    if (c < busy || busy >= G) return;
    const int t_ = tid_of(wv); const int wave = wv, lane = t_ & 63;
    LAS float* scr = (LAS float*)(lds + RING_OFF + wave * 16384);
    for (int it = lo + (c - busy) * NWAVES + wave; it < hi; it += (G - busy) * NWAVES) { if (KIND == 1) conv_heavy(kp_, ws, scr, 1, it, lane); else if (KIND == 0) conv_light(kp_, ws, scr, 1, it, lane); else conv_light(kp_, ws, scr, 0, l0_early(it), lane); }
    LDS_WAIT();
}

__device__ __forceinline__ int attq_next(const Frame& F, gu32* head) {
    volatile LAS unsigned* slot = (volatile LAS unsigned*)(F.lds + att::OFF_SLOT);
    __syncthreads();
    if (F.tid == 0) slot[0] = __hip_atomic_fetch_add(head, 1u, RLX_AGENT);
    __syncthreads();
    return __builtin_amdgcn_readfirstlane((int)slot[0]);
}
__device__ __forceinline__ void attn_phase(const Frame& F, const u16* QKV, u16* OCAT, u16* OCR, const float* rel_bias  , gu32* qhead, bool with_ctx,
                                           const float* ga, const float* gb, const float* gc  , const float* misc  , kargp_t kp_, unsigned char* ws, bool conv  ) {
    char* lds = (char*)F.lds;
    int cround = 0; const int crounds = conv ? (TAIL_H - T2_H + F.G * NWAVES - 1) / (F.G * NWAVES) : 0;
#define CONV_ROUND() do { if (cround < crounds) { __syncthreads(); const int it_ = T2_H + cround * F.G * NWAVES + (int)blockIdx.x * NWAVES + F.wave; \
        if (it_ < TAIL_H) conv_heavy(kp_, ws, (LAS float*)(F.lds + RING_OFF + F.wave * 9216), 1, it_, tid_of(F.wave) & 63  ); LDS_WAIT(); ++cround; } } while (0)
    for (;;) {
        const int idx = attq_next(F, qhead); if (idx >= (with_ctx ? 408 : 384)) break;
        att::Unit U; int h, b, qb; const bool ctxq = idx >= 384;
        if (!ctxq) { qb = idx & 15; h = (idx >> 4) % 12; b = idx / 192; } else { const int i = idx - 384; qb = 16; h = i % 12; b = i / 12; }
        const int rowq = b * TPB + qb * 256; U.r0 = 0; U.first = 0; U.base1 = 0;
        if (ctxq) { U.NT = 4; U.n0 = 4; U.base0 = b * TPB + SEQ; } else { U.NT = 68; U.n0 = 68; U.base0 = b * TPB; }
        U.Q = QKV + (size_t)rowq * QKVW + CQA + h * 128; U.K = QKV + CKA + (h / 3) * 128; U.V = QKV + CVA + (h / 3) * 128; U.O = OCAT + (size_t)rowq * DM + h * 128; U.ldo = DM;
        U.qgain = ga; U.qrope = ctxq ? nullptr : misc + MI_TA; U.t0 = ctxq ? 0 : qb * 256;
        att::attn_unit<128, 0, 2>(U, lds, F.wave);
        CONV_ROUND();
    }
    for (;;) {
        const int idx = attq_next(F, qhead + 64); if (idx >= (with_ctx ? 544 : 512)) break;
        att::Unit U; int ph, b, qb; const bool ctxq = idx >= 512;
        if (!ctxq) { qb = idx & 15; ph = (idx >> 4) & 15; b = idx >> 8; } else { const int i = idx - 512; qb = 16; ph = i & 15; b = i >> 4; }
        const int rowq = b * TPB + qb * 256, h = ph >> 1, cmap = ph & 1; U.r0 = 0; U.first = 0; U.base1 = 0;
        if (ctxq) { U.NT = 4; U.n0 = 4; U.base0 = b * TPB + SEQ; } else { U.NT = 68; U.n0 = 68; U.base0 = b * TPB; }
        U.Q = QKV + (size_t)rowq * QKVW + CQC + h * 128 + cmap * 64; U.K = QKV + CKC + h * 128 + cmap * 64; U.V = QKV + CVC + h * 128; U.O = OCR + (size_t)rowq * 2048 + ph * 128; U.ldo = 2048;
        U.qgain = gc; U.qrope = ctxq ? nullptr : misc + MI_TC; U.t0 = ctxq ? 0 : qb * 256;
        att::attn_unit<64, 0, 2>(U, lds, F.wave);
        CONV_ROUND();
    }
    for (;;) {
        const int idx = attq_next(F, qhead + 128); if (idx >= (with_ctx ? 408 : 384)) break;
        att::Unit U; int h, b, qb; const bool ctxq = idx >= 384;
        if (!ctxq) { qb = idx & 15; h = (idx >> 4) % 12; b = idx / 192; } else { const int i = idx - 384; qb = 16; h = i % 12; b = i / 12; }
        const int rowq = b * TPB + qb * 256; U.r0 = 0; U.first = 0; U.base1 = 0; U.NT = 4; U.n0 = 4; U.base0 = b * TPB + SEQ;
        if (!ctxq) {
            const int r0 = qb * 4; int first = min(max(r0 - 4, 0), 56); const int last = min(max(r0 - 1, 0), 56) + 7; int cnt = last - first + 1;
            if (cnt & 1) { if (first > 0) --first; ++cnt; }
            U.NT = 4 + cnt; U.base1 = b * TPB + first * 64; U.r0 = r0; U.first = first;
            LAS float* biasq = (LAS float*)(F.lds + att::OFF_BIAS);
            for (int e = F.tid; e < 465; e += NWAVES * 64) biasq[e] = rel_bias[h * 465 + e] * 11.313708498984761f;
        }
        U.Q = QKV + (size_t)rowq * QKVW + CQB + h * 128; U.K = QKV + CKB + h * 128; U.V = QKV + CVB + h * 128; U.O = OCAT + (size_t)rowq * DM + 1536 + h * 128; U.ldo = DM;
        U.qgain = gb; U.qrope = nullptr; U.t0 = 0;
        att::attn_unit<128, 1, 1>(U, lds, F.wave);
    }
    while (cround < crounds) CONV_ROUND();
#undef CONV_ROUND
}

__device__ __forceinline__ Frame make_frame(unsigned char* ws, LAS unsigned char* lds, int wv) {
    Frame F; F.lds = lds; F.MISC = (volatile LAS unsigned*)(lds + MISC_OFF); F.ctl = (gu32*)(ws + WS_CTL);
    F.tid = tid_of(wv); F.lane = F.tid & 63; F.wave = wv;
    F.G = gridDim.x; { const int bx = blockIdx.x; F.vcu = (F.G % 8 == 0) ? (bx % 8) * (F.G / 8) + bx / 8 : bx; }
    return F;
}
__global__ void __launch_bounds__(NWAVES * 64, 2) trunk_fwd(Args args) {
    extern __shared__ __attribute__((aligned(16))) unsigned char lds[];
    LAS unsigned char* const L = (LAS unsigned char*)lds;
    const int wv_ = __builtin_amdgcn_readfirstlane((int)threadIdx.x >> 6);
    for (int u = tid_of(wv_); u < (LDS_BYTES - LDSCTL_OFF) / 4; u += NWAVES * 64) ((LAS unsigned*)(L + LDSCTL_OFF))[u] = 0u;
    __syncthreads();
    const int lo = args.ph_lo, hi = args.ph_hi;
    if (MK_N_LAUNCHES == 1) { KARGS(); (void)xcd_barrier_post((unsigned*)((gu32*)(KWS() + WS_CTL) + CW_BAR), (volatile LAS unsigned*)(L + MISC_OFF) + 8, tid_of(wv_) == 0); }
#define GRID_BAR() do { if (MK_N_LAUNCHES == 1) { KARGS(); XcdBarrier bar_; bar_.bar = (unsigned*)((gu32*)(KWS() + WS_CTL) + CW_BAR); bar_.x = xb_xcc_id(); bar_.st = (volatile LAS unsigned*)(L + MISC_OFF) + 8; xcd_barrier(bar_, tid_of(wv_) == 0); } } while (0)
#define IN(k) (lo <= (k) && (k) < hi)
#define SEAM(k) do { if (IN((k) + 1)) GRID_BAR(); } while (0)

    if (IN(0)) {
        KARGS(); unsigned char* ws = KWS(); const Frame F = make_frame(ws, L, wv_);
        LAS float* scr = (LAS float*)(F.lds + RING_OFF + F.wave * 16384);
        const int gw = F.vcu * NWAVES + F.wave, NGW = F.G * NWAVES;
        { const float* c_in = KIN(1); const float* cctx_in = KIN(3); const float* w_ada = KIN(4); const float* b_ada = KIN(5); float* MOD = (float*)(ws + WS_MOD);
          for (int it = gw; it < DEPTH * 32 * 144; it += NGW) p0_ada_item(c_in, cctx_in, w_ada, b_ada, MOD, scr, it, F.lane); }
        if (blockIdx.x == 0) {
            float* MISCF = (float*)(ws + WS_MISC); const float* diff_lambda = KIN(16);
            for (int e = F.tid; e < 64 * 32; e += NWAVES * 64) { const int p = e >> 5, i = e & 31; const float inv = powf(10000.0f, -(float)i / 32.0f), ang = (float)p * inv; MISCF[MI_TA + 2 * e] = cosf(ang); MISCF[MI_TA + 2 * e + 1] = sinf(ang); }
            for (int e = F.tid; e < 64 * 16; e += NWAVES * 64) { const int p = e >> 4, i = e & 15; const float inv = powf(10000.0f, -(float)i / 16.0f), ang = (float)p * inv; MISCF[MI_TC + 2 * e] = cosf(ang); MISCF[MI_TC + 2 * e + 1] = sinf(ang); }
            if (F.wave < DEPTH) { const int l = F.wave; const float* dl = diff_lambda + (size_t)l * 4 * 64;
                const float s1 = wave_sum(dl[F.lane] * dl[64 + F.lane]), s2 = wave_sum(dl[128 + F.lane] * dl[192 + F.lane]);
                const float lam_init = 0.8f - 0.6f * expf(-0.3f * (float)l);
                if (F.lane == 0) MISCF[MI_LAM + l] = expf(s1) - expf(s2) + lam_init; }
        }
        LDS_WAIT();
        SEAM(0);
    }
#define PH_BEGIN0() const float* modl = (const float*)(ws + WS_MOD) + (size_t)l * 3 * MODW; float* XC = (float*)(ws + WS_XC)
    if (IN(1)) {
        KARGS(); unsigned char* ws = KWS(); const Frame F = make_frame(ws, L, wv_);
        LAS float* scr = (LAS float*)(F.lds + RING_OFF + F.wave * 16384);
        const int gw = F.vcu * NWAVES + F.wave, NGW = F.G * NWAVES;
        for (int it = gw; it < DEPTH * H_LAYER; it += NGW) {
            const int l = it / H_LAYER, r = it - l * H_LAYER; if (l == 1 && r < TAIL_H) continue;
            conv_heavy(kp_, ws, scr, l, r, F.lane); }
        if (DEPTH > 1) { for (int it = gw; it < TAIL_L1; it += NGW) conv_light(kp_, ws, scr, 0, l0_late(it), F.lane); }
        else { for (int it = gw; it < I_LAYER; it += NGW) conv_light(kp_, ws, scr, 0, it, F.lane); }
        LDS_WAIT();
        { const int l = 0; PH_BEGIN0();
          modnorm_phase(F, KIN(0), KIN(2), KIN(6), modl, 0, (u16*)(ws + WS_HN), XC, nullptr, modl, 0.5f, XC, (float*)(ws + WS_ROWSS), false, nullptr); }
        SEAM(1);
    }

    for (int l = 0; l < DEPTH; ++l) {
        const int P = 2 + l * PPL;
#define PH_BEGIN() KARGS(); unsigned char* ws = KWS(); const Frame F = make_frame(ws, L, wv_); const float* modl = (const float*)(ws + WS_MOD) + (size_t)l * 3 * MODW; \
        const u16* wl = (const u16*)(ws + WS_W + (size_t)l * W_LAYER); float* XL = KOUT(); float* XC = (float*)(ws + WS_XC); \
        float* DXL = rep ? (float*)(ws + WS_MX) : XL; float* DXC = rep ? (float*)(ws + WS_MX) + (size_t)NB * SEQ * DM : XC;     \
        (void)F; (void)modl; (void)wl; (void)XL; (void)XC; (void)DXL; (void)DXC
        if (IN(P + 0) && l != 0) { for (int rep = 0; rep <= DUP(0); ++rep) { PH_BEGIN();
            ctxnorm_phase(F, XC, KIN(6) + (size_t)(l * 3 + 0) * DM, modl, 0, (u16*)(ws + WS_HN), (const float*)(ws + WS_PART), modl - 3 * MODW + 2 * MODW + 8 * DM, 0.5f, (float*)(ws + WS_ROWSS) + (size_t)(l * 3 + 0) * MROWS, nullptr); } SEAM(P + 0); }
        if (IN(P + 1)) { for (int rep = 0; rep <= DUP(1); ++rep) { PH_BEGIN(); pg8::Gemm g{(const u16*)(ws + WS_HN), wl + WO_1IN / 2, MROWS, 2 * FFN, DM}; pg8::StaticOrder S; S.init(MROWS, 2 * FFN, DM, F.G, (int)blockIdx.x);
            pg8::EpiSwiglu E{(u16*)(ws + WS_HD), {(const float*)(ws + WS_ROWSS) + (size_t)(l * 3 + 0) * MROWS, (const float*)(ws + WS_SW) + (size_t)(l * 3 + 0) * SW_STRIDE, 2 * FFN}}; pg8::gemm_phase<pg8::EpiSwiglu, pg8::StaticOrder, true, true>(F.lds + RING_OFF, g, S, E, F.wave); } if (DEPTH > 1) { KARGS(); const int busy_ = ((MROWS / 256) * (2 * FFN / 256)) % (int)gridDim.x;
              if (l == 0) conv_tail<2>(kp_, KWS(), L, (int)gridDim.x, (int)blockIdx.x, busy_, 0, TAIL_L1, wv_); else if (l == 1) conv_tail<0>(kp_, KWS(), L, (int)gridDim.x, (int)blockIdx.x, busy_, TAIL_L1, 2 * TAIL_L1, wv_); } SEAM(P + 1); }
        if (IN(P + 2)) { for (int rep = DUP(2); rep >= 0; --rep) { PH_BEGIN(); pg8::Gemm g{(const u16*)(ws + WS_HD), wl + WO_1OUT / 2, MROWS, DM, FFN}; pg8::ResidOrder S; S.init(DM, FFN, F.G, (int)blockIdx.x, 8, 1);
            pg8::EpiResid E{l == 0 ? KIN(0) : XL, DXL, ws, KIN(6) + (size_t)(l * 3 + 1) * DM, (unsigned)(WS_MOD + ((size_t)l * 3 * MODW + 4 * DM) * 4), (unsigned)(WS_ROWSS + (size_t)(l * 3 + 1) * MROWS * 4), (unsigned)(WS_XG8 >> 20),
                            (unsigned)(WS_MOD + ((size_t)l * 3 * MODW + 2 * DM) * 4), 0.5f, FFN / 64}; pg8::gemm_phase<pg8::EpiResid, pg8::ResidOrder, true, true>(F.lds + RING_OFF, g, S, E, F.wave); } SEAM(P + 2); }
        if (IN(P + 3)) { for (int rep = 0; rep <= DUP(3); ++rep) { PH_BEGIN(); ctxnorm_phase(F, XC, KIN(6) + (size_t)(l * 3 + 1) * DM, modl, 1, (u16*)(ws + WS_HN), (const float*)(ws + WS_PART), modl + 2 * MODW + 2 * DM, 0.5f, (float*)(ws + WS_ROWSS) + (size_t)(l * 3 + 1) * MROWS, ws + WS_XG8); } SEAM(P + 3); }
        if (IN(P + 4)) { for (int rep = 0; rep <= DUP(4); ++rep) { PH_BEGIN();
            const pg8::NormFix nf{(const float*)(ws + WS_ROWSS) + (size_t)(l * 3 + 1) * MROWS, (const float*)(ws + WS_SW) + (size_t)(l * 3 + 1) * SW_STRIDE, INW};
            { pg8::Gemm g{(const u16*)(ws + WS_XG8), (const u16*)(ws + WS_W8 + (size_t)l * W8_LAYER), MROWS, INW, DM / 2}; pg8::MapOrder<1> S; S.S.init(MROWS, 88 * 256, DM / 2, F.G, (int)blockIdx.x); S.extra = 0;
              pg8::EpiInProj E{(u16*)(ws + WS_QKV), (u16*)(ws + WS_SG), nf, 0, 1.0f / 64.0f}; pg8::gemm_phase<pg8::EpiInProj, pg8::MapOrder<1>, true, true, true>(F.lds + RING_OFF, g, S, E, F.wave); }
            } SEAM(P + 4); }
        if (IN(P + 5)) { for (int rep = DUP(5); rep >= 0; --rep) { PH_BEGIN(); qkprep_phase(F, (u16*)(ws + WS_QKV), rep ? (u16*)(ws + WS_MX) : (u16*)(ws + WS_QKV), KIN(12) + (size_t)l * 256, KIN(13) + (size_t)l * 256, KIN(14) + (size_t)l * 128, (const float*)(ws + WS_MISC)); } SEAM(P + 5); }
        if (IN(P + 6)) { for (int rep = 0; rep <= DUP(6); ++rep) { PH_BEGIN(); attn_phase(F, (const u16*)(ws + WS_QKV), (u16*)(ws + WS_OCAT), (u16*)(ws + WS_OCR), KIN(15) + (size_t)l * 12 * 465, F.ctl + CW_ATTQ + 256 * l + 1024 * rep, l == 0,
                KIN(12) + (size_t)l * 256, KIN(13) + (size_t)l * 256, KIN(14) + (size_t)l * 128, (const float*)(ws + WS_MISC), kp_, ws, l == 0 && DEPTH > 1 && rep == 0); } SEAM(P + 6); }
        if (IN(P + 7)) { for (int rep = 0; rep <= DUP(7); ++rep) { PH_BEGIN(); const float lam_init = 0.8f - 0.6f * expf(-0.3f * (float)l);
            ccombine_phase(F, (const u16*)(ws + WS_OCR), (u16*)(ws + WS_OCAT), KIN(17) + (size_t)l * 128, ((const float*)(ws + WS_MISC))[MI_LAM + l], 1.0f - lam_init); } SEAM(P + 7); }
        if (IN(P + 8)) { for (int rep = 0; rep <= DUP(8); ++rep) { PH_BEGIN(); pg8::Gemm g{(const u16*)(ws + WS_OCAT), wl + WO_BR / 2, MROWS, DM, DM}; pg8::GateOrder S; S.S.init(MROWS, DM, DM, F.G, (int)blockIdx.x, l == DEPTH - 1);
            pg8::EpiGate E{(const u16*)(ws + WS_SG), (u16*)(ws + WS_MXB)}; pg8::gemm_phase<pg8::EpiGate, pg8::GateOrder, true, true>(F.lds + RING_OFF, g, S, E, F.wave); } if (l == 0 && DEPTH > 1) { KARGS(); conv_tail<1>(kp_, KWS(), L, (int)gridDim.x, (int)blockIdx.x, ((MROWS / 256) * (DM / 256)) % (int)gridDim.x, 0, T2_H, wv_); } SEAM(P + 8); }
        if (IN(P + 9)) { for (int rep = DUP(9); rep >= 0; --rep) { PH_BEGIN(); pg8::Gemm g{(const u16*)(ws + WS_MXB), wl + WO_OUT / 2, MROWS, DM, DM}; pg8::ResidOrder S; S.init(DM, DM, F.G, (int)blockIdx.x, 8, l != DEPTH - 1);
            pg8::EpiResid E{XL, DXL, ws, KIN(6) + (size_t)(l * 3 + 2) * DM, (unsigned)(WS_MOD + ((size_t)l * 3 * MODW + 7 * DM) * 4), (unsigned)(WS_ROWSS + (size_t)(l * 3 + 2) * MROWS * 4), 0u,
                            (unsigned)(WS_MOD + ((size_t)l * 3 * MODW + 5 * DM) * 4), 1.0f, DM / 64}; pg8::gemm_phase<pg8::EpiResid, pg8::ResidOrder, true, true>(F.lds + RING_OFF, g, S, E, F.wave); } SEAM(P + 9); }
        if (IN(P + 10) && l != DEPTH - 1) { for (int rep = 0; rep <= DUP(10); ++rep) { PH_BEGIN(); ctxnorm_phase(F, XC, KIN(6) + (size_t)(l * 3 + 2) * DM, modl, 2, (u16*)(ws + WS_HN), (const float*)(ws + WS_PART), modl + 2 * MODW + 5 * DM, 1.0f, (float*)(ws + WS_ROWSS) + (size_t)(l * 3 + 2) * MROWS, nullptr); } SEAM(P + 10); }
        if (IN(P + 11)) { for (int rep = 0; rep <= DUP(11); ++rep) { PH_BEGIN(); pg8::Gemm g{(const u16*)(ws + WS_HN), wl + WO_2IN / 2, MROWS, 2 * FFN, DM}; pg8::StaticOrder S; S.init(MROWS, 2 * FFN, DM, F.G, (int)blockIdx.x, l == DEPTH - 1);
            pg8::EpiSwiglu E{(u16*)(ws + WS_HD), {(const float*)(ws + WS_ROWSS) + (size_t)(l * 3 + 2) * MROWS, (const float*)(ws + WS_SW) + (size_t)(l * 3 + 2) * SW_STRIDE, 2 * FFN}}; pg8::gemm_phase<pg8::EpiSwiglu, pg8::StaticOrder, true, true>(F.lds + RING_OFF, g, S, E, F.wave); } if (l == 0 && DEPTH > 1) { KARGS(); conv_tail<0>(kp_, KWS(), L, (int)gridDim.x, (int)blockIdx.x, ((MROWS / 256) * (2 * FFN / 256)) % (int)gridDim.x, 0, TAIL_L1, wv_); } SEAM(P + 11); }
        if (IN(P + 12)) { for (int rep = DUP(12); rep >= 0; --rep) { PH_BEGIN(); pg8::Gemm g{(const u16*)(ws + WS_HD), wl + WO_2OUT / 2, MROWS, DM, FFN}; pg8::ResidOrder S; S.init(DM, FFN, F.G, (int)blockIdx.x, 8, l != DEPTH - 1);
            pg8::EpiResid E{XL, DXL, ws, l + 1 < DEPTH ? KIN(6) + (size_t)((l + 1) * 3 + 0) * DM : nullptr, (unsigned)(WS_MOD + ((size_t)(l + 1) * 3 * MODW + 1 * DM) * 4), (unsigned)(WS_ROWSS + (size_t)((l + 1) * 3 + 0) * MROWS * 4), 0u,
                            (unsigned)(WS_MOD + ((size_t)l * 3 * MODW + 8 * DM) * 4), 0.5f, FFN / 64}; pg8::gemm_phase<pg8::EpiResid, pg8::ResidOrder, true, true>(F.lds + RING_OFF, g, S, E, F.wave); } SEAM(P + 12); }
#undef PH_BEGIN
    }
#undef IN
#undef SEAM
#undef GRID_BAR
}

extern "C" void kernel_launch(void* const* d_in, const int* in_sizes, int n_in, void* d_out, int out_size, void* d_ws, size_t ws_size, hipStream_t stream) {
    static int grid = 0;
    if (grid == 0) {
        if (n_in != 22 || out_size != NB * SEQ * DM || ws_size < WS_END) { fprintf(stderr, "kernel_launch: built for 22 inputs, out %d floats, >= %zu bytes of workspace; got n_in %d, out %d, ws %zu; nothing launched\n", NB * SEQ * DM, (size_t)WS_END, n_in, out_size, ws_size); grid = -1; return; }
        int dev = 0, cus = 0, per_cu = 0;
        if (hipGetDevice(&dev) != hipSuccess || hipDeviceGetAttribute(&cus, hipDeviceAttributeMultiprocessorCount, dev) != hipSuccess) { fprintf(stderr, "kernel_launch: device query failed\n"); grid = -1; return; }
        if (hipFuncSetAttribute((const void*)trunk_fwd, hipFuncAttributeMaxDynamicSharedMemorySize, LDS_BYTES) != hipSuccess) { fprintf(stderr, "kernel_launch: hipFuncSetAttribute failed\n"); grid = -1; return; }
        if (hipOccupancyMaxActiveBlocksPerMultiprocessor(&per_cu, (const void*)trunk_fwd, NWAVES * 64, LDS_BYTES) != hipSuccess || per_cu < 1)
            fprintf(stderr, "kernel_launch: note: occupancy query reports %d workgroups per CU\n", per_cu);
        (void)hipGetLastError();
        grid = cus;
    }
    if (grid < 0) return;
    if (hipMemsetAsync((char*)d_ws + WS_CTL, 0, CTL_ZERO_BYTES, stream) != hipSuccess) { fprintf(stderr, "kernel_launch: hipMemsetAsync failed\n"); return; }
    Args a{};
    for (int i = 0; i < 22; ++i) a.in[i] = (const float*)d_in[i];
    a.out = (float*)d_out; a.ws = (unsigned char*)d_ws;
#if MK_N_LAUNCHES == 1
    a.ph_lo = 0; a.ph_hi = NPH;
    hipLaunchKernelGGL(trunk_fwd, dim3(grid), dim3(NWAVES * 64), LDS_BYTES, stream, a);
#else
    for (int p = 0; p < NPH; ++p) { a.ph_lo = p; a.ph_hi = p + 1; hipLaunchKernelGGL(trunk_fwd, dim3(grid), dim3(NWAVES * 64), LDS_BYTES, stream, a); }
#endif
    const hipError_t le = hipPeekAtLastError();
    if (le != hipSuccess) fprintf(stderr, "kernel_launch: launch failed: %s\n", hipGetErrorName(le));
}
```

```cpp
#include <hip/hip_runtime.h>
#include <cstdio>
#include <cstdint>

#ifndef DUPMASK
#define DUPMASK 0
#endif
#define DUP(k) ((DUPMASK >> (k)) & 1)
#ifndef MK_N_LAUNCHES
#define MK_N_LAUNCHES 1
#endif

constexpr int DM = 4096, NB = 2, SEQ = 4096, CTXL = 256, TPB = SEQ + CTXL  , MROWS = NB * TPB  ;
constexpr int FFN = 7168, NMOD = 9, MODW = NMOD * DM  , DEPTH = 2;
constexpr int INW = 22528, QKVW = 10240, SGW = 12288;
constexpr int PAN_PER_B = TPB / 256;
constexpr float EPS = 1e-6f;
constexpr int CQA = 0, CKA = 1536, CVA = 2048, CQB = 2560, CKB = 4096, CVB = 5632, CQC = 7168, CKC = 8192, CVC = 9216;

#define GAS __attribute__((address_space(1)))
#define LAS __attribute__((address_space(3)))
typedef unsigned short u16;
typedef unsigned v4u __attribute__((ext_vector_type(4)));
typedef unsigned v2u __attribute__((ext_vector_type(2)));
typedef float f32x4 __attribute__((ext_vector_type(4)));
typedef float f32x2 __attribute__((ext_vector_type(2)));
typedef GAS unsigned gu32;
#define RLX_AGENT __ATOMIC_RELAXED, __HIP_MEMORY_SCOPE_AGENT
#define LDS_WAIT() asm volatile("s_waitcnt lgkmcnt(0)" ::: "memory")
#define VM_WAIT() asm volatile("s_waitcnt vmcnt(0)" ::: "memory")
__device__ __forceinline__ unsigned f2bf(float f) { unsigned u = __builtin_bit_cast(unsigned, f); return (u + 0x7fffu + ((u >> 16) & 1u)) >> 16; }
__device__ __forceinline__ unsigned pk2(float lo, float hi) { return f2bf(lo) | (f2bf(hi) << 16); }
__device__ __forceinline__ float bf_lo(unsigned w) { return __builtin_bit_cast(float, w << 16); }
__device__ __forceinline__ float bf_hi(unsigned w) { return __builtin_bit_cast(float, w & 0xffff0000u); }
__device__ __forceinline__ unsigned cvt_pk_bf16(float lo, float hi) { unsigned r; asm volatile("v_cvt_pk_bf16_f32 %0, %1, %2" : "=v"(r) : "v"(lo), "v"(hi)); return r; }
__device__ __forceinline__ unsigned pk4_fp8(float a, float b, float c, float d) { unsigned w = 0; w = __builtin_amdgcn_cvt_pk_fp8_f32(a, b, w, false); w = __builtin_amdgcn_cvt_pk_fp8_f32(c, d, w, true); return w; }
__device__ __forceinline__ float fast_sigmoid(float v) { return __builtin_amdgcn_rcpf(1.0f + __builtin_amdgcn_exp2f(-1.4426950408889634f * v)); }

__device__ __forceinline__ int tid_of(int wv) { int t; asm volatile("v_mbcnt_lo_u32_b32 %0, -1, 0\n\tv_mbcnt_hi_u32_b32 %0, -1, %0\n\tv_lshl_or_b32 %0, %1, 6, %0" : "=&v"(t) : "s"(wv)); return t; }

namespace pg8 {
#define PG8_LAS __attribute__((address_space(3)))
typedef unsigned short bf16_t;
typedef short bf16x8 __attribute__((ext_vector_type(8)));
typedef float f32x4 __attribute__((ext_vector_type(4)));
typedef unsigned u32x4 __attribute__((ext_vector_type(4)));
typedef unsigned u32x2 __attribute__((ext_vector_type(2)));
typedef int i32x4 __attribute__((ext_vector_type(4)));
constexpr int BM = 256, BK = 64, HALF = 128, HTB = HALF * BK * 2  , STAGE_BYTES = 8 * HTB, NXCD = 8, WGM = 4;

__host__ __device__ __forceinline__ int lds_byte(int r, int c) { const int st = (r >> 4) * 2 + (c >> 5), rr = r & 15, cc = c & 31, ob = rr * 64 + cc * 2; return st * 1024 + (ob ^ (((ob >> 9) & 1) << 5)); }
__host__ __device__ __forceinline__ void stage_rc(int b, int& R, int& C) { const int st = b / 1024, sb = b % 1024, swz = sb ^ (((sb >> 9) & 1) << 5); R = (st >> 1) * 16 + swz / 64; C = (st & 1) * 32 + (swz % 64) / 2; }
__host__ __device__ __forceinline__ int perm32(int rho) { const int n = rho >> 4, i = rho & 15; return 8 * (i >> 2) + 4 * n + (i & 3); }

struct Unit { int pm, pn, kt0, nt; };
struct Gemm { const bf16_t* A; const bf16_t* Bt; int M, N, K; };

struct StaticOrder {
    int nM, nN, nwg, G, c, ntf, lat;
    __host__ __device__ void init(int M, int N, int K, int G_, int c_, int lat_only = 0) { lat = lat_only; nM = lat ? 32 : M / BM; nN = N / BM; nwg = nM * nN; G = G_; c = c_; ntf = K / BK; }
    __host__ __device__ __forceinline__ bool map(long L, Unit& u) const {
        if (L >= nwg) return false;
        int wgid = (int)L; { const int q = nwg / NXCD, r = nwg % NXCD, xcd = wgid % NXCD, off = wgid / NXCD; wgid = (xcd < r ? xcd * (q + 1) : r * (q + 1) + (xcd - r) * q) + off; }
        const int nig = WGM * nN, gid = wgid / nig, fm = gid * WGM, gsz = (nM - fm) < WGM ? (nM - fm) : WGM;
        u.pm = fm + ((wgid % nig) % gsz); u.pn = (wgid % nig) / gsz; if (lat) u.pm += u.pm >> 4; u.kt0 = 0; u.nt = ntf; return true;
    }
    __host__ __device__ __forceinline__ bool next(int i, Unit& u) const { return map((long)i * G + c, u); }
    __device__ __forceinline__ void a_ready(const Unit&) const {}
    __device__ __forceinline__ void done(const Unit&) const {}
};
template <int MODE> struct MapOrder { StaticOrder S; int extra;
    __host__ __device__ __forceinline__ bool next(int i, Unit& u) const { const int nl = S.G - extra, pre = extra > 0 ? 2 * nl : 0; long L;
        if (extra > 0 && S.c >= extra) L = i < 2 ? (long)i * nl + (S.c - extra) : (long)pre + (long)(i - 2) * S.G + S.c; else L = (long)pre + (long)i * S.G + S.c;
        const bool ok = S.map(L, u); const int p = u.pn;
        u.pn = p; return ok; }
    __device__ __forceinline__ void a_ready(const Unit&) const {}
    __device__ __forceinline__ void done(const Unit&) const {} };
struct ResidOrder {
    StaticOrder S; int KS, ctx;
    __host__ __device__ void init(int N, int K, int G_, int c_, int KS_, int ctx_) { S.init(MROWS, N, K, G_, c_, 1); KS = KS_; ctx = ctx_; }
    __host__ __device__ __forceinline__ bool next(int i, Unit& u) const {
        const long L = (long)i * S.G + S.c; const bool islat = L < S.nwg;
        Unit a; (void)S.map(islat ? L : 0, a);
        const long L2 = islat ? 0 : L - S.nwg; const int ks = (int)(L2 % KS), t = (int)(L2 / KS), cnt = S.ntf / KS;
        u.pn = islat ? a.pn : t % S.nN; u.pm = islat ? a.pm : (t / S.nN) * PAN_PER_B + (PAN_PER_B - 1); u.nt = islat ? a.nt : cnt; u.kt0 = islat ? 0 : ks * cnt;
        return islat || (ctx && L2 < 2 * S.nN * KS);
    }
    __device__ __forceinline__ void a_ready(const Unit&) const {}
    __device__ __forceinline__ void done(const Unit&) const {}
};


__device__ __forceinline__ size_t panel_off(int pm, bool& is_ctx, int& b) { b = pm / PAN_PER_B; const int j = pm - b * PAN_PER_B; is_ctx = (j == PAN_PER_B - 1); return is_ctx ? (size_t)(b * CTXL) * DM : (size_t)(b * SEQ + j * 256) * DM; }

struct EpiResid {
    static constexpr bool PERM = true, AFTER_DRAIN = false; static constexpr size_t WS_PART_OFF = (size_t)884 << 20, WS_HN_OFF = (size_t)17 << 20;
    __device__ static __forceinline__ bool keep(const Unit&) { return false; }
    const float* src_lat; float* dst_lat; unsigned char* wsb;
    const float* gsn; unsigned scale_off, rowss_off, xg8_off;
    unsigned gate_off; float coef; int ntf;
    __device__ __forceinline__ void operator()(const f32x4 (&acc)[2][2][4][2], const Unit& u, int wr, int wc, int fr, int fq) const {
        bool isc; int b; const size_t po = panel_off(u.pm, isc, b); const bool split = u.nt != ntf;
        const float* s = src_lat + po; float* d = dst_lat + po; const float* g = (const float*)(wsb + gate_off) + (size_t)b * MODW; float* part = (float*)(wsb + WS_PART_OFF);
        const int row0 = wr * 64 + fr, col0 = u.pn * BM + wc * 32 + 8 * fq;
        f32x4 gv[2][2];
#pragma unroll
        for (int bj = 0; bj < 2; ++bj)
#pragma unroll
            for (int n = 0; n < 2; ++n) gv[bj][n] = *(const f32x4*)(g + col0 + bj * HALF + n * 4) * coef;
        if (split) {
            float* pp = part + ((size_t)((u.kt0 * 8) / ntf) * (NB * CTXL) + (size_t)b * CTXL) * DM;
#pragma unroll
            for (int ai = 0; ai < 2; ++ai)
#pragma unroll
                for (int m = 0; m < 4; ++m) { const size_t off = (size_t)(row0 + ai * HALF + m * 16) * DM + col0;
#pragma unroll
                    for (int bj = 0; bj < 2; ++bj)
#pragma unroll
                        for (int n = 0; n < 2; ++n) *(f32x4*)(pp + off + bj * HALF + n * 4) = acc[ai][bj][m][n]; }
        } else {
            const bool mk = gsn != nullptr; float* rsp = (float*)(wsb + rowss_off) + u.pm * BM + row0; const float* scp = (const float*)(wsb + scale_off) + (size_t)b * MODW;
            bf16_t* xg = (bf16_t*)(wsb + WS_HN_OFF) + (size_t)u.pm * BM * DM; unsigned char* xg8 = wsb + ((size_t)xg8_off << 20) + (size_t)u.pm * BM * DM;
#pragma unroll
            for (int ai = 0; ai < 2; ++ai)
#pragma unroll
              for (int mp = 0; mp < 2; ++mp) {
                f32x4 sv[2][2][2];
#pragma unroll
                for (int mm = 0; mm < 2; ++mm) { const size_t off = (size_t)(row0 + ai * HALF + (mp * 2 + mm) * 16) * DM + col0;
#pragma unroll
                    for (int bj = 0; bj < 2; ++bj)
#pragma unroll
                        for (int n = 0; n < 2; ++n) sv[mm][bj][n] = *(const f32x4*)(s + off + bj * HALF + n * 4); }
#pragma unroll
                for (int mm = 0; mm < 2; ++mm) { const int m = mp * 2 + mm; const size_t off = (size_t)(row0 + ai * HALF + m * 16) * DM + col0; float q = 0.f;
#pragma unroll
                    for (int bj = 0; bj < 2; ++bj) { f32x4 xn[2];
#pragma unroll
                        for (int n = 0; n < 2; ++n) { xn[n] = sv[mm][bj][n] + gv[bj][n] * acc[ai][bj][m][n]; *(f32x4*)(d + off + bj * HALF + n * 4) = xn[n]; }
                        if (mk) { f32x4 y[2];
#pragma unroll
                            for (int n = 0; n < 2; ++n) { y[n] = xn[n] * (*(const f32x4*)(gsn + col0 + bj * HALF + n * 4) * (*(const f32x4*)(scp + col0 + bj * HALF + n * 4) + 1.0f)); q += (xn[n][0] * xn[n][0] + xn[n][1] * xn[n][1]) + (xn[n][2] * xn[n][2] + xn[n][3] * xn[n][3]); }
                            if (!xg8_off) { u32x4 w; w.x = cvt_pk_bf16(y[0][0], y[0][1]); w.y = cvt_pk_bf16(y[0][2], y[0][3]); w.z = cvt_pk_bf16(y[1][0], y[1][1]); w.w = cvt_pk_bf16(y[1][2], y[1][3]); *(u32x4*)(xg + off + bj * HALF) = w; }
                            else {   u32x2 w8; w8.x = pk4_fp8(y[0][0], y[0][1], y[0][2], y[0][3]); w8.y = pk4_fp8(y[1][0], y[1][1], y[1][2], y[1][3]); *(u32x2*)(xg8 + off + bj * HALF) = w8; } } }
                    if (mk) { q += __builtin_bit_cast(float, __builtin_amdgcn_ds_swizzle(__builtin_bit_cast(int, q), (16 << 10) | 0x1f));
                        if ((fq & 1) == 0) unsafeAtomicAdd(rsp + ai * HALF + m * 16, q); } }
                asm volatile("" ::: "memory"); }
        }
    }
};
struct NormFix {
    const float* rowss;
    const float* sw;
    int N;
    __device__ __forceinline__ void rows(const Unit& u, int wr, int fr, float (&rs)[2][4]) const {
#pragma unroll
        for (int ai = 0; ai < 2; ++ai)
#pragma unroll
            for (int m = 0; m < 4; ++m) rs[ai][m] = __builtin_amdgcn_rsqf(rowss[u.pm * BM + wr * 64 + fr + ai * HALF + m * 16] * (1.0f / DM) + EPS);
    }
    __device__ __forceinline__ const float* vecp(const Unit& u) const { const int b = u.pm / PAN_PER_B; return sw + (size_t)((u.pm - b * PAN_PER_B == PAN_PER_B - 1) ? 2 : b) * N; }
};
struct EpiSwiglu {
    static constexpr bool PERM = true, AFTER_DRAIN = false;
    __device__ static __forceinline__ bool keep(const Unit&) { return false; }
    bf16_t* H; NormFix nf;
    __device__ __forceinline__ void operator()(const f32x4 (&acc)[2][2][4][2], const Unit& u, int wr, int wc, int fr, int fq) const {
        const int row0 = u.pm * BM + wr * 64 + fr, col0 = u.pn * HALF + wc * 32 + 8 * fq;
        float rs[2][4]; nf.rows(u, wr, fr, rs);
        const float* swp = nf.vecp(u) + u.pn * BM + wc * 32 + 8 * fq; f32x4 sg[2], su[2];
#pragma unroll
        for (int n = 0; n < 2; ++n) { sg[n] = *(const f32x4*)(swp + 4 * n); su[n] = *(const f32x4*)(swp + HALF + 4 * n); }
#pragma unroll
        for (int ai = 0; ai < 2; ++ai)
#pragma unroll
            for (int m = 0; m < 4; ++m) { bf16_t* rowp = H + (size_t)(row0 + ai * HALF + m * 16) * FFN + col0;
                float h[8];
#pragma unroll
                for (int n = 0; n < 2; ++n)
#pragma unroll
                    for (int j = 0; j < 4; ++j) { const float gt = acc[ai][0][m][n][j] * rs[ai][m] + sg[n][j], up = acc[ai][1][m][n][j] * rs[ai][m] + su[n][j]; h[n * 4 + j] = gt * fast_sigmoid(gt) * up; }
                u32x4 w; w.x = cvt_pk_bf16(h[0], h[1]); w.y = cvt_pk_bf16(h[2], h[3]); w.z = cvt_pk_bf16(h[4], h[5]); w.w = cvt_pk_bf16(h[6], h[7]);
                *(u32x4*)rowp = w; }
    }
};
struct EpiInProj {
    static constexpr bool PERM = true, AFTER_DRAIN = false;
    __device__ static __forceinline__ bool keep(const Unit&) { return false; }
    bf16_t* QKV; bf16_t* SG; NormFix nf; int pn0; float ascale;
    __device__ __forceinline__ void operator()(const f32x4 (&acc)[2][2][4][2], const Unit& u, int wr, int wc, int fr, int fq) const {
        const int row0 = u.pm * BM + wr * 64 + fr, pn = u.pn + pn0; const bool isg = pn >= QKVW / BM;
        bf16_t* base = isg ? SG : QKV; const int ldc = isg ? SGW : QKVW; const int col0 = (isg ? pn - QKVW / BM : pn) * BM + wc * 32 + 8 * fq;
        float rs[2][4]; nf.rows(u, wr, fr, rs);
#pragma unroll
        for (int ai = 0; ai < 2; ++ai)
#pragma unroll
            for (int m = 0; m < 4; ++m) rs[ai][m] *= ascale;
        const float* swp = nf.vecp(u) + pn * BM + wc * 32 + 8 * fq; f32x4 sv[2][2];
#pragma unroll
        for (int bj = 0; bj < 2; ++bj)
#pragma unroll
            for (int n = 0; n < 2; ++n) sv[bj][n] = *(const f32x4*)(swp + bj * HALF + 4 * n);
#pragma unroll
        for (int ai = 0; ai < 2; ++ai)
#pragma unroll
            for (int m = 0; m < 4; ++m) { bf16_t* rowp = base + (size_t)(row0 + ai * HALF + m * 16) * ldc + col0;
                u32x4 w16 = {0u, 0u, 0u, 0u};
#pragma unroll
                for (int bj = 0; bj < 2; ++bj) { f32x4 v0 = acc[ai][bj][m][0] * rs[ai][m] + sv[bj][0], v1 = acc[ai][bj][m][1] * rs[ai][m] + sv[bj][1];
                    if (isg) {
                        unsigned a = 0u, b = 0u;
#pragma unroll
                        for (int j = 0; j < 4; ++j) { a = __builtin_amdgcn_cvt_pk_u8_f32(fast_sigmoid(v0[j]) * 255.0f, j, a); b = __builtin_amdgcn_cvt_pk_u8_f32(fast_sigmoid(v1[j]) * 255.0f, j, b); }
                        if (bj == 0) { w16.x = a; w16.y = b; } else { w16.z = a; w16.w = b; }
                    } else {
                    u32x4 w; w.x = cvt_pk_bf16(v0[0], v0[1]); w.y = cvt_pk_bf16(v0[2], v0[3]); w.z = cvt_pk_bf16(v1[0], v1[1]); w.w = cvt_pk_bf16(v1[2], v1[3]);
                    *(u32x4*)(rowp + bj * HALF) = w; } }
                if (isg) *(u32x4*)((unsigned char*)SG + (size_t)(row0 + ai * HALF + m * 16) * SGW + (pn - QKVW / BM) * BM + wc * 64 + fq * 16) = w16; }
    }
};
struct EpiGate {
    static constexpr bool PERM = true, AFTER_DRAIN = false;
    __device__ static __forceinline__ bool keep(const Unit& u) { return u.kt0 + u.nt < DM / BK; }
    const bf16_t* SG; bf16_t* MXB;
    __device__ __forceinline__ void operator()(f32x4 (&acc)[2][2][4][2], const Unit& u, int wr, int wc, int fr, int fq) const {
        const int row0 = u.pm * BM + wr * 64 + fr, col0 = u.pn * BM + wc * 32 + 8 * fq;
        const bool lastbr = !keep(u); const int gc0 = (u.kt0 == 0 ? 0 : (u.kt0 == 24 ? DM : 2 * DM));
#pragma unroll
        for (int ai = 0; ai < 2; ++ai)
#pragma unroll
            for (int mp = 0; mp < 2; ++mp) {
                u32x4 gq[2], hq[2];
#pragma unroll
                for (int mm = 0; mm < 2; ++mm) { const unsigned char* rp = (const unsigned char*)SG + (size_t)(row0 + ai * HALF + (mp * 2 + mm) * 16) * SGW + gc0 + u.pn * BM + wc * 64 + fq * 16;
                    gq[mm] = *(const u32x4*)rp; if (!lastbr) hq[mm] = *(const u32x4*)(rp + DM); }
#pragma unroll
                for (int mm = 0; mm < 2; ++mm) { const int m = mp * 2 + mm;
#pragma unroll
                    for (int bj = 0; bj < 2; ++bj) { u32x2 a; a.x = bj ? gq[mm].z : gq[mm].x; a.y = bj ? gq[mm].w : gq[mm].y; f32x4 g[2];
#define GB(w_, j_) fmaxf((float)(((w_) >> (8 * (j_))) & 0xffu), 1e-18f)
#pragma unroll
                        for (int j = 0; j < 4; ++j) { g[0][j] = GB(a.x, j); g[1][j] = GB(a.y, j); }
                        if (!lastbr) { u32x2 h; h.x = bj ? hq[mm].z : hq[mm].x; h.y = bj ? hq[mm].w : hq[mm].y;
#pragma unroll
                            for (int j = 0; j < 4; ++j) { g[0][j] *= __builtin_amdgcn_rcpf(GB(h.x, j)); g[1][j] *= __builtin_amdgcn_rcpf(GB(h.y, j)); }
                            acc[ai][bj][m][0] = acc[ai][bj][m][0] * g[0]; acc[ai][bj][m][1] = acc[ai][bj][m][1] * g[1];
                        } else { const f32x4 v0 = acc[ai][bj][m][0] * (g[0] * (1.0f / 255.0f)), v1 = acc[ai][bj][m][1] * (g[1] * (1.0f / 255.0f)); u32x4 w; w.x = cvt_pk_bf16(v0[0], v0[1]); w.y = cvt_pk_bf16(v0[2], v0[3]); w.z = cvt_pk_bf16(v1[0], v1[1]); w.w = cvt_pk_bf16(v1[2], v1[3]);
                            *(u32x4*)(MXB + (size_t)(row0 + ai * HALF + m * 16) * DM + col0 + bj * HALF) = w; } } }
                asm volatile("" ::: "memory"); }
#undef GB
    }
};
struct GateOrder {
    StaticOrder S;
    __host__ __device__ __forceinline__ bool next(int i, Unit& u) const { const int ti = i / 3, br = i - 3 * ti; const bool ok = S.next(ti, u); u.kt0 = br * 24; u.nt = br == 2 ? 16 : 24; return ok; }
    __device__ __forceinline__ void a_ready(const Unit&) const {}
    __device__ __forceinline__ void done(const Unit&) const {}
};

template <class Epi, class Sched, bool ALIGN_EPI = false, bool SP2 = false, bool FP8 = false>
__device__ __forceinline__ void gemm_phase(PG8_LAS unsigned char* lds, const Gemm g, const Sched& S, const Epi& E, int wv  ) {
    int tid_ = tid_of(wv);
    const int tid = tid_, wid = wv, lane = tid & 63, wr = wid >> 2, wc = wid & 3, fr = lane & 15, fq = lane >> 4;
    const int K = g.K;
    unsigned voffA[2], voffB[2];
#pragma unroll
    for (int i = 0; i < 2; ++i) { int R, C; stage_rc(tid * 16 + i * 8192, R, C); const int Rb = Epi::PERM ? ((R & ~31) + perm32(R & 31)) : R;
        voffA[i] = (unsigned)(R * K + C) * 2u; voffB[i] = (unsigned)(Rb * K + C) * 2u; }
    const size_t kstep = (size_t)(BK * 2);
    const size_t hstep = (size_t)HALF * K * 2;
    const size_t tstep = 2 * hstep;
    const unsigned ldsw = (unsigned)wid * 1024u;
    const int aoff = lds_byte(wr * 64 + fr, fq * 8), boff = lds_byte(wc * 32 + fr, fq * 8);
#define PG8_SA(b, h) (((b) * 2 + (h)) * HTB)
#define PG8_SB(b, h) ((4 + (b) * 2 + (h)) * HTB)
#define PG8_STAGE(bufoff, gbase, voff) do { _Pragma("unroll") for (int _i = 0; _i < 2; ++_i) { unsigned vo_ = (voff)[_i]; asm volatile("" : "+v"(vo_));     \
        __builtin_amdgcn_global_load_lds((const unsigned*)((const char*)(gbase) + vo_), (PG8_LAS unsigned*)(lds + (bufoff) + ldsw + _i * 8192), 16, 0, 0); } } while (0)
#define PG8_LDA(dst, b, h) do { _Pragma("unroll") for (int m = 0; m < 4; ++m) _Pragma("unroll") for (int k = 0; k < 2; ++k) dst[m][k] = *(const PG8_LAS bf16x8*)(lds + PG8_SA(b, h) + aoff + m * 2048 + k * 1024); } while (0)
#define PG8_LDB(dst, b, h) do { _Pragma("unroll") for (int n = 0; n < 2; ++n) _Pragma("unroll") for (int k = 0; k < 2; ++k) dst[n][k] = *(const PG8_LAS bf16x8*)(lds + PG8_SB(b, h) + boff + n * 2048 + k * 1024); } while (0)
#define PG8_CAT(x, y) __builtin_shufflevector(__builtin_bit_cast(i32x4, x), __builtin_bit_cast(i32x4, y), 0, 1, 2, 3, 4, 5, 6, 7)
#define PG8_MMA(ai, bj, At, Bt) do { __builtin_amdgcn_s_setprio(1); _Pragma("unroll") for (int m = 0; m < 4; ++m) _Pragma("unroll") for (int n = 0; n < 2; ++n) { \
        if constexpr (FP8) acc[ai][bj][m][n] = __builtin_amdgcn_mfma_scale_f32_16x16x128_f8f6f4(PG8_CAT(Bt[n][0], Bt[n][1]), PG8_CAT(At[m][0], At[m][1]), acc[ai][bj][m][n], 0, 0, 0, 0x7F7F7F7F, 0, 0x7F7F7F7F); \
        else { _Pragma("unroll") for (int k = 0; k < 2; ++k) acc[ai][bj][m][n] = __builtin_amdgcn_mfma_f32_16x16x32_bf16(Bt[n][k], At[m][k], acc[ai][bj][m][n], 0, 0, 0); } } __builtin_amdgcn_s_setprio(0); } while (0)
#define PG8_WAIT_V(n) asm volatile("s_waitcnt vmcnt(" #n ")" ::: "memory")
#define PG8_WAIT_L(n) asm volatile("s_waitcnt lgkmcnt(" #n ")" ::: "memory")
#define PG8_BAR __builtin_amdgcn_s_barrier()
#define PG8_SCHED __builtin_amdgcn_sched_barrier(0)
    Unit cur, nxt; int ui = 0;
    if (!S.next(0, cur)) return;
    f32x4 acc[2][2][4][2];
#pragma unroll
    for (int a = 0; a < 2; ++a)
#pragma unroll
        for (int b = 0; b < 2; ++b)
#pragma unroll
            for (int m = 0; m < 4; ++m)
#pragma unroll
                for (int n = 0; n < 2; ++n) acc[a][b][m][n] = (f32x4){0.f, 0.f, 0.f, 0.f};
    bf16x8 At[4][2], B0[2][2], B1[2][2];
    const char* cA = (const char*)g.A + (size_t)cur.pm * tstep + (size_t)cur.kt0 * kstep; const char* cB = (const char*)g.Bt + (size_t)cur.pn * tstep + (size_t)cur.kt0 * kstep;
    S.a_ready(cur);
    if constexpr (SP2) {
        PG8_STAGE(PG8_SB(0, 0), cB, voffB); PG8_STAGE(PG8_SB(0, 1), cB + hstep, voffB); PG8_STAGE(PG8_SA(0, 0), cA, voffA); PG8_STAGE(PG8_SA(0, 1), cA + hstep, voffA);
        if (wr == 1) PG8_BAR;
        PG8_WAIT_V(2); PG8_BAR;
        PG8_STAGE(PG8_SB(1, 0), cB + kstep, voffB); PG8_STAGE(PG8_SA(1, 0), cA + kstep, voffA); PG8_STAGE(PG8_SB(1, 1), cB + hstep + kstep, voffB);
        PG8_WAIT_V(6); PG8_BAR;
    } else {
        PG8_STAGE(PG8_SB(0, 0), cB, voffB); PG8_STAGE(PG8_SA(0, 0), cA, voffA); PG8_STAGE(PG8_SB(0, 1), cB + hstep, voffB); PG8_STAGE(PG8_SA(0, 1), cA + hstep, voffA);
        if (wr == 1) PG8_BAR;
        PG8_WAIT_V(4); PG8_BAR;
        PG8_STAGE(PG8_SB(1, 0), cB + kstep, voffB); PG8_STAGE(PG8_SA(1, 0), cA + kstep, voffA); PG8_STAGE(PG8_SB(1, 1), cB + hstep + kstep, voffB);
        PG8_WAIT_V(6); PG8_BAR;
    }
    for (;;) {
        const bool has_next = S.next(ui + 1, nxt);
        const char* nA = has_next ? (const char*)g.A + (size_t)nxt.pm * tstep + (size_t)nxt.kt0 * kstep : cA; const char* nB = has_next ? (const char*)g.Bt + (size_t)nxt.pn * tstep + (size_t)nxt.kt0 * kstep : cB;
        const int nt = cur.nt;
        for (int t = 0; t < nt; t += 2) {
            const bool last = (t == nt - 2);
            const char* a1 = cA + (size_t)(t + 1) * kstep;
            const char* a2 = last ? nA : cA + (size_t)(t + 2) * kstep; const char* b2 = last ? nB : cB + (size_t)(t + 2) * kstep;
            const char* a3 = a2 + kstep; const char* b3 = b2 + kstep;
            if (last && has_next) S.a_ready(nxt);
            if constexpr (SP2) {
            PG8_LDB(B0, 0, 0); PG8_LDB(B1, 0, 1); PG8_SCHED; PG8_LDA(At, 0, 0); PG8_STAGE(PG8_SA(1, 1), a1 + hstep, voffA);
            PG8_WAIT_V(8); PG8_WAIT_L(0); PG8_BAR; PG8_MMA(0, 0, At, B0); PG8_MMA(0, 1, At, B1); PG8_BAR; PG8_SCHED;
            PG8_LDA(At, 0, 1); PG8_STAGE(PG8_SB(0, 0), b2, voffB); PG8_STAGE(PG8_SB(0, 1), b2 + hstep, voffB); PG8_STAGE(PG8_SA(0, 0), a2, voffA);
            PG8_WAIT_V(8); PG8_WAIT_L(0); PG8_BAR; PG8_MMA(1, 0, At, B0); PG8_MMA(1, 1, At, B1); PG8_BAR; PG8_SCHED;
            PG8_LDB(B0, 1, 0); PG8_LDB(B1, 1, 1); PG8_SCHED; PG8_LDA(At, 1, 0); PG8_STAGE(PG8_SA(0, 1), a2 + hstep, voffA);
            PG8_WAIT_V(8); PG8_WAIT_L(0); PG8_BAR; PG8_MMA(0, 0, At, B0); PG8_MMA(0, 1, At, B1); PG8_BAR; PG8_SCHED;
            PG8_LDA(At, 1, 1); PG8_STAGE(PG8_SB(1, 0), b3, voffB); PG8_STAGE(PG8_SB(1, 1), b3 + hstep, voffB); PG8_STAGE(PG8_SA(1, 0), a3, voffA);
            PG8_WAIT_V(8); PG8_WAIT_L(0); PG8_BAR; PG8_MMA(1, 0, At, B0); PG8_MMA(1, 1, At, B1); PG8_BAR; PG8_SCHED;
            } else {
            PG8_LDB(B0, 0, 0); PG8_SCHED; PG8_LDA(At, 0, 0); PG8_STAGE(PG8_SA(1, 1), a1 + hstep, voffA);
            PG8_WAIT_L(8); PG8_BAR; PG8_WAIT_L(0); PG8_MMA(0, 0, At, B0); PG8_BAR; PG8_SCHED;
            PG8_LDB(B1, 0, 1); PG8_STAGE(PG8_SB(0, 0), b2, voffB);
            PG8_BAR; PG8_WAIT_L(0); PG8_MMA(0, 1, At, B1); PG8_BAR;
            PG8_LDA(At, 0, 1); PG8_STAGE(PG8_SA(0, 0), a2, voffA);
            PG8_BAR; PG8_WAIT_L(0); PG8_MMA(1, 0, At, B0); PG8_BAR; PG8_SCHED;
            PG8_STAGE(PG8_SB(0, 1), b2 + hstep, voffB);
            PG8_WAIT_V(6); PG8_BAR; PG8_MMA(1, 1, At, B1); PG8_BAR;
            PG8_LDB(B0, 1, 0); PG8_SCHED; PG8_LDA(At, 1, 0); PG8_STAGE(PG8_SA(0, 1), a2 + hstep, voffA);
            PG8_WAIT_L(8); PG8_BAR; PG8_WAIT_L(0); PG8_MMA(0, 0, At, B0); PG8_BAR; PG8_SCHED;
            PG8_LDB(B1, 1, 1); PG8_STAGE(PG8_SB(1, 0), b3, voffB);
            PG8_BAR; PG8_WAIT_L(0); PG8_MMA(0, 1, At, B1); PG8_BAR;
            PG8_LDA(At, 1, 1); PG8_STAGE(PG8_SA(1, 0), a3, voffA);
            PG8_BAR; PG8_WAIT_L(0); PG8_MMA(1, 0, At, B0); PG8_BAR; PG8_SCHED;
            PG8_STAGE(PG8_SB(1, 1), b3 + hstep, voffB);
            PG8_WAIT_V(6); PG8_BAR; PG8_MMA(1, 1, At, B1); PG8_BAR;
            }
        }
        if constexpr (ALIGN_EPI) { if (wr == 0) PG8_BAR; }
        if constexpr (!Epi::AFTER_DRAIN) { const int t_e = tid_of(wv); const int fr_e = t_e & 15, fq_e = (t_e & 63) >> 4;
            E(acc, cur, wr, wc, fr_e, fq_e); S.done(cur); }
        if (!has_next) break;
        if (!Epi::keep(cur))
#pragma unroll
        for (int a = 0; a < 2; ++a)
#pragma unroll
            for (int b = 0; b < 2; ++b)
#pragma unroll
                for (int m = 0; m < 4; ++m)
#pragma unroll
                    for (int n = 0; n < 2; ++n) acc[a][b][m][n] = (f32x4){0.f, 0.f, 0.f, 0.f};
        cur = nxt; cA = nA; cB = nB; ++ui;
        if constexpr (ALIGN_EPI) { if (wr == 1) PG8_BAR; }
    }
    PG8_WAIT_V(0);
    if constexpr (!ALIGN_EPI) { if (wr == 0) PG8_BAR; }
    PG8_BAR;
#undef PG8_SA
#undef PG8_SB
#undef PG8_STAGE
#undef PG8_LDA
#undef PG8_LDB
#undef PG8_MMA
#undef PG8_CAT
#undef PG8_WAIT_V
#undef PG8_WAIT_L
#undef PG8_BAR
#undef PG8_SCHED
}
}

namespace att {
using bf16x8 = __attribute__((ext_vector_type(8))) short;
using s16x4  = __attribute__((ext_vector_type(4))) short;
using f32x16 = __attribute__((ext_vector_type(16))) float;
using u32x4  = __attribute__((ext_vector_type(4))) unsigned;
constexpr int NW = 8, QBLK = 32, KVBLK = 64;
constexpr int SHM_V = 16384, SHM_K = 16384;
constexpr int OFF_V = 0, OFF_K = 2 * SHM_V, OFF_WS = OFF_K + 2 * SHM_K, OFF_BIAS = OFF_WS + 2048, OFF_SLOT = OFF_BIAS + 2048, ATT_LDS = OFF_SLOT + 64;
constexpr float THR = 8.f;
constexpr int LD = QKVW;
#define KSWZ128(row, colB) ((row) * 256 + ((colB) ^ (((row) & 7) << 4)))
#define KSWZ64(row, colB) ((row) * 128 + ((colB) ^ ((((row) >> 1) & 7) << 4)))
#define SBAR() __builtin_amdgcn_sched_barrier(0)
__device__ __forceinline__ int crow(int r, int hi) { return (r & 3) + 8 * (r >> 2) + 4 * hi; }
__device__ __forceinline__ unsigned cvtpk(float lo, float hi) { unsigned r; asm volatile("v_cvt_pk_bf16_f32 %0, %1, %2" : "=v"(r) : "v"(lo), "v"(hi)); return r; }

struct Unit {
    const u16* Q;
    const u16* K;
    const u16* V;
    u16* O; int ldo;
    int NT, n0, base0, base1;
    int r0, first;
    const float* qgain;
    const float* qrope; int t0;
};

template <int DQK>
__device__ __forceinline__ void partialSM(f32x16& p0, f32x16& p1, float& m_reg, float& mn, float& alpha) {
  constexpr float SCALE = DQK == 128 ? 0.08838834764831845f : 0.125f;
  constexpr float C = SCALE * 1.4426950408889634f;
  float pmax = p0[0];
#pragma unroll
  for (int r = 1; r < 16; ++r) pmax = fmaxf(pmax, p0[r]);
#pragma unroll
  for (int r = 0; r < 16; ++r) pmax = fmaxf(pmax, p1[r]);
  { auto rr = __builtin_amdgcn_permlane32_swap(__float_as_uint(pmax), __float_as_uint(pmax), false, false);
    pmax = fmaxf(__uint_as_float(rr[0]), __uint_as_float(rr[1])); }
  if (__builtin_expect(__all(pmax - m_reg <= THR / SCALE), 1)) { mn = m_reg; alpha = 1.f; }
  else { mn = fmaxf(m_reg, pmax); alpha = __builtin_amdgcn_exp2f((m_reg - mn) * C); m_reg = mn; }
  float mnC = -mn * C;
#pragma unroll
  for (int r = 0; r < 16; ++r) p0[r] = fmaf(p0[r], C, mnC);
#pragma unroll
  for (int r = 0; r < 16; ++r) p1[r] = fmaf(p1[r], C, mnC);
#pragma unroll
  for (int r = 0; r < 16; ++r) p0[r] = __builtin_amdgcn_exp2f(p0[r]);
}
__device__ __forceinline__ void finishSM(f32x16& p0, f32x16& p1, float alpha, float& l_reg, bf16x8& pa0, bf16x8& pa1, bf16x8& pa2, bf16x8& pa3) {
#pragma unroll
  for (int r = 0; r < 16; ++r) p1[r] = __builtin_amdgcn_exp2f(p1[r]);
  float ps = 0;
#pragma unroll
  for (int r = 0; r < 16; ++r) ps += p0[r];
#pragma unroll
  for (int r = 0; r < 16; ++r) ps += p1[r];
  { auto rr = __builtin_amdgcn_permlane32_swap(__float_as_uint(ps), __float_as_uint(ps), false, false);
    ps = __uint_as_float(rr[0]) + __uint_as_float(rr[1]); }
  l_reg = l_reg * alpha + ps;
#define PK4(P, BASE, OUT) do { unsigned a0 = cvtpk(P[BASE + 0], P[BASE + 1]), a1 = cvtpk(P[BASE + 2], P[BASE + 3]);   \
    unsigned b0 = cvtpk(P[BASE + 4], P[BASE + 5]), b1 = cvtpk(P[BASE + 6], P[BASE + 7]);                              \
    auto r0 = __builtin_amdgcn_permlane32_swap(a0, b0, false, false); auto r1 = __builtin_amdgcn_permlane32_swap(a1, b1, false, false); \
    u32x4 w = {r0[0], r1[0], r0[1], r1[1]}; OUT = *reinterpret_cast<bf16x8*>(&w); } while (0)
  PK4(p0, 0, pa0); PK4(p0, 8, pa1); PK4(p1, 0, pa2); PK4(p1, 8, pa3);
#undef PK4
}
template <int DQK>
__device__ __forceinline__ void qkt(f32x16& p0, f32x16& p1, const char* Ks, const bf16x8* qr, int r32, int hi) {
  p0 = f32x16{}; p1 = f32x16{};
#pragma unroll
  for (int d0 = 0; d0 < DQK / 16; ++d0) { const int cb = (d0 * 16 + hi * 8) * 2;
    bf16x8 b0, b1;
    if constexpr (DQK == 128) { b0 = *reinterpret_cast<const bf16x8*>(Ks + KSWZ128(r32, cb)); b1 = *reinterpret_cast<const bf16x8*>(Ks + KSWZ128(32 + r32, cb)); }
    else                      { b0 = *reinterpret_cast<const bf16x8*>(Ks + KSWZ64(r32, cb));  b1 = *reinterpret_cast<const bf16x8*>(Ks + KSWZ64(32 + r32, cb)); }
    p0 = __builtin_amdgcn_mfma_f32_32x32x16_bf16(b0, qr[d0], p0, 0, 0, 0);
    p1 = __builtin_amdgcn_mfma_f32_32x32x16_bf16(b1, qr[d0], p1, 0, 0, 0); }
}
__device__ __forceinline__ int v_st(int k, int c) { const int kk = (k & ~0xC) | ((k & 4) << 1) | ((k & 8) >> 1); return ((kk >> 3) * 4 + (c >> 5)) * 512 + ((kk & 7) * 32 + (c & 31)) * 2; }
__device__ __forceinline__ int v_rd_base(int lane) { return ((lane & 3) << 3) | (((lane >> 2) & 3) << 6) | (((lane >> 4) & 1) << 5) | (((lane >> 5) & 1) << 8); }
constexpr int v_rd_off(int d0, int ks, int half) { return d0 * 512 + ks * 4096 + half * 2048; }
template <int OFF> __device__ __forceinline__ s16x4 tr_read(int vb) {
  s16x4 r; asm volatile("ds_read_b64_tr_b16 %0, %1 offset:%2" : "=&v"(r) : "v"(vb), "i"(OFF) : "memory"); return r;
}
template <int D0> __device__ __forceinline__ void pv_one(f32x16& od, int vb, bf16x8 pa0, bf16x8 pa1, bf16x8 pa2, bf16x8 pa3) {
  const s16x4 l0 = tr_read<v_rd_off(D0, 0, 0)>(vb), h0 = tr_read<v_rd_off(D0, 0, 1)>(vb), l1 = tr_read<v_rd_off(D0, 1, 0)>(vb), h1 = tr_read<v_rd_off(D0, 1, 1)>(vb);
  const s16x4 l2 = tr_read<v_rd_off(D0, 2, 0)>(vb), h2 = tr_read<v_rd_off(D0, 2, 1)>(vb), l3 = tr_read<v_rd_off(D0, 3, 0)>(vb), h3 = tr_read<v_rd_off(D0, 3, 1)>(vb);
  asm volatile("s_waitcnt lgkmcnt(0)" ::: "memory"); SBAR();
#define PK(L, H) (bf16x8){L[0], L[1], L[2], L[3], H[0], H[1], H[2], H[3]}
  od = __builtin_amdgcn_mfma_f32_32x32x16_bf16(pa0, PK(l0, h0), od, 0, 0, 0);
  od = __builtin_amdgcn_mfma_f32_32x32x16_bf16(pa1, PK(l1, h1), od, 0, 0, 0);
  od = __builtin_amdgcn_mfma_f32_32x32x16_bf16(pa2, PK(l2, h2), od, 0, 0, 0);
  od = __builtin_amdgcn_mfma_f32_32x32x16_bf16(pa3, PK(l3, h3), od, 0, 0, 0);
#undef PK
}
__device__ __forceinline__ void pv_d0(f32x16* o, int vb, bf16x8 pa0, bf16x8 pa1, bf16x8 pa2, bf16x8 pa3) {
  pv_one<0>(o[0], vb, pa0, pa1, pa2, pa3); pv_one<1>(o[1], vb, pa0, pa1, pa2, pa3); pv_one<2>(o[2], vb, pa0, pa1, pa2, pa3); pv_one<3>(o[3], vb, pa0, pa1, pa2, pa3);
}

template <int DQK, int MODE, int SD>
__device__ __forceinline__ void attn_unit(const Unit& U, char* lds, int wv) {
  constexpr int ND = DQK / 16;
  int tid_ = tid_of(wv);
  const int tid = tid_, wid = wv, lane = tid & 63, r32 = lane & 31, hi = lane >> 5;
  char* V_lds = lds + OFF_V; char* K_lds = lds + OFF_K;
  float* ws = (float*)(lds + OFF_WS) + wid * 64; float* li_l = ws; float* al_l = ws + 32;
  const float* biasq = (const float*)(lds + OFF_BIAS);
  float m_reg = -1e30f, l_reg = 0; f32x16 o[4] = {}; bf16x8 qr[ND];
  { const char* Qw = (const char*)U.Q + (unsigned)(((wid * QBLK + r32) * LD + hi * 8) * 2);
#pragma unroll
    for (int d0 = 0; d0 < ND; ++d0) qr[d0] = *reinterpret_cast<const bf16x8*>(Qw + d0 * 32);
    float ssq = 0.f;
#pragma unroll
    for (int d0 = 0; d0 < ND; ++d0) { const u32x4 w = *reinterpret_cast<const u32x4*>(&qr[d0]);
#pragma unroll
      for (int e = 0; e < 4; ++e) { const float a = bf_lo(w[e]), b = bf_hi(w[e]); ssq += a * a + b * b; } }
    { auto rr = __builtin_amdgcn_permlane32_swap(__float_as_uint(ssq), __float_as_uint(ssq), false, false); ssq = __uint_as_float(rr[0]) + __uint_as_float(rr[1]); }
    const float rstdq = 1.0f / sqrtf(ssq * (1.0f / DQK) + EPS);
    const int tq = U.t0 + wid * QBLK + r32, gq = (tq >> 6) & 63, cq = tq & 63; constexpr int NP = DQK / 4;
#pragma unroll
    for (int d0 = 0; d0 < ND; ++d0) { const u32x4 w = *reinterpret_cast<const u32x4*>(&qr[d0]); const int dd = d0 * 16 + hi * 8;
      const f32x4 g0 = *(const f32x4*)(U.qgain + dd), g1 = *(const f32x4*)(U.qgain + dd + 4);
      float x[8]; x[0] = bf_lo(w[0]) * rstdq * g0[0]; x[1] = bf_hi(w[0]) * rstdq * g0[1]; x[2] = bf_lo(w[1]) * rstdq * g0[2]; x[3] = bf_hi(w[1]) * rstdq * g0[3];
      x[4] = bf_lo(w[2]) * rstdq * g1[0]; x[5] = bf_hi(w[2]) * rstdq * g1[1]; x[6] = bf_lo(w[3]) * rstdq * g1[2]; x[7] = bf_hi(w[3]) * rstdq * g1[3];
      if (U.qrope != nullptr) { const int i0 = dd >> 1; const float* tp = U.qrope + 2 * ((i0 < NP) ? gq * NP + i0 : cq * NP + i0 - NP);
        const f32x4 c01 = *(const f32x4*)tp, c23 = *(const f32x4*)(tp + 4); float y;
        y = x[0] * c01[0] - x[1] * c01[1]; x[1] = x[0] * c01[1] + x[1] * c01[0]; x[0] = y;
        y = x[2] * c01[2] - x[3] * c01[3]; x[3] = x[2] * c01[3] + x[3] * c01[2]; x[2] = y;
        y = x[4] * c23[0] - x[5] * c23[1]; x[5] = x[4] * c23[1] + x[5] * c23[0]; x[4] = y;
        y = x[6] * c23[2] - x[7] * c23[3]; x[7] = x[6] * c23[3] + x[7] * c23[2]; x[6] = y; }
      u32x4 o = {cvtpk(x[0], x[1]), cvtpk(x[2], x[3]), cvtpk(x[4], x[5]), cvtpk(x[6], x[7])}; qr[d0] = *reinterpret_cast<bf16x8*>(&o); } }
  const int sr = tid >> 4, sc = (tid & 15) * 8, vst0 = v_st(sr, sc), vst1 = v_st(32 + sr, sc);
  const int kr64 = tid >> 3, kc64 = (tid & 7) * 8;
  const unsigned gofs = (unsigned)((sr * LD + sc) * 2), gofs64 = (unsigned)((kr64 * LD + kc64) * 2);
  const int vb0 = (int)(uintptr_t)V_lds + v_rd_base(lane);
  struct { bf16x8 vs0, vs1, ks0, ks1; } sr_[SD];
  const int n0 = U.n0, base0 = U.base0, base1 = U.base1;
#define TROW(j) ((j) < n0 ? base0 + 64 * (j) : base1 + 64 * ((j) - n0))
#define SLOAD(i, j) do { const size_t tb_ = (size_t)(TROW(j)) * (LD * 2); const char* vp_ = (const char*)U.V + tb_; const char* kp_ = (const char*)U.K + tb_; \
    sr_[i].vs0 = *reinterpret_cast<const bf16x8*>(vp_ + gofs); sr_[i].vs1 = *reinterpret_cast<const bf16x8*>(vp_ + 32 * LD * 2 + gofs); \
    if constexpr (DQK == 128) { sr_[i].ks0 = *reinterpret_cast<const bf16x8*>(kp_ + gofs); sr_[i].ks1 = *reinterpret_cast<const bf16x8*>(kp_ + 32 * LD * 2 + gofs); } \
    else { sr_[i].ks0 = *reinterpret_cast<const bf16x8*>(kp_ + gofs64); } } while (0)
#define SWRITE(b, i) do { *(bf16x8*)(V_lds + (b) * SHM_V + vst0) = sr_[i].vs0; *(bf16x8*)(V_lds + (b) * SHM_V + vst1) = sr_[i].vs1; \
    if constexpr (DQK == 128) { const int kc = sc * 2; *(bf16x8*)(K_lds + (b) * SHM_K + KSWZ128(sr, kc)) = sr_[i].ks0; *(bf16x8*)(K_lds + (b) * SHM_K + KSWZ128(32 + sr, kc)) = sr_[i].ks1; } \
    else { *(bf16x8*)(K_lds + (b) * SHM_K + KSWZ64(kr64, kc64 * 2)) = sr_[i].ks0; } } while (0)
#define SWAIT() do { if constexpr (SD == 1) asm volatile("s_waitcnt vmcnt(0)" ::: "memory"); else if constexpr (DQK == 128) asm volatile("s_waitcnt vmcnt(4)" ::: "memory"); else asm volatile("s_waitcnt vmcnt(3)" ::: "memory"); } while (0)
#define RESC(a) do { if (__any((a) < 1.f)) { if (hi == 0) al_l[r32] = (a); asm volatile("s_waitcnt lgkmcnt(0)" ::: "memory"); \
    _Pragma("unroll") for (int d = 0; d < 4; ++d) _Pragma("unroll") for (int r = 0; r < 16; ++r) o[d][r] *= al_l[crow(r, hi)]; } } while (0)
#define MASK(P0, P1, j) do { if constexpr (MODE == 1) { if ((j) >= n0) { const int kr_ = U.first + ((j) - n0); \
      const int qgr_ = U.r0 + (wid >> 1), qc_ = 32 * (wid & 1) + r32, rs_ = min(max(qgr_ - 4, 0), 56), cs_ = min(max(qc_ - 8, 0), 48); \
      if ((unsigned)(kr_ - rs_) < 8u) { const float* brow_ = biasq + (kr_ - qgr_ + 7) * 31 + 15 - qc_; \
        _Pragma("unroll") for (int r = 0; r < 16; ++r) { const int kc_ = crow(r, hi); \
          P0[r] = ((unsigned)(kc_ - cs_) < 16u) ? P0[r] + brow_[kc_] : -__builtin_inff(); \
          P1[r] = ((unsigned)(kc_ + 32 - cs_) < 16u) ? P1[r] + brow_[kc_ + 32] : -__builtin_inff(); } } \
      else { _Pragma("unroll") for (int r = 0; r < 16; ++r) { P0[r] = -__builtin_inff(); P1[r] = -__builtin_inff(); } } } } } while (0)
  f32x16 pA0, pA1, pB0, pB1; float mnA, mnB, alA, alB; bf16x8 pa0, pa1, pa2, pa3; const int NT = U.NT;
  constexpr int SE = 0, SO = SD - 1;
  SLOAD(SE, 0); asm volatile("s_waitcnt vmcnt(0)" ::: "memory"); SWRITE(0, SE); __syncthreads();
  qkt<DQK>(pA0, pA1, K_lds, qr, r32, hi); MASK(pA0, pA1, 0); partialSM<DQK>(pA0, pA1, m_reg, mnA, alA);
  SLOAD(SO, 1); if constexpr (SD == 2) { if (2 < NT) SLOAD(SE, 2); }
  SWAIT(); SWRITE(1, SO); __syncthreads();
  for (int j = 1; j + 1 < NT; j += 2) {
    SBAR(); qkt<DQK>(pB0, pB1, K_lds + SHM_K, qr, r32, hi);
    finishSM(pA0, pA1, alA, l_reg, pa0, pa1, pa2, pa3); SBAR();
    SLOAD(SO, j + SD); SBAR();
    pv_d0(o, vb0, pa0, pa1, pa2, pa3); MASK(pB0, pB1, j); partialSM<DQK>(pB0, pB1, m_reg, mnB, alB);
    __syncthreads(); SWAIT(); SWRITE(0, SE);
    RESC(alB); __syncthreads();
    SBAR(); qkt<DQK>(pA0, pA1, K_lds, qr, r32, hi);
    finishSM(pB0, pB1, alB, l_reg, pa0, pa1, pa2, pa3); SBAR();
    if (SD == 1 || j + 3 < NT) SLOAD(SE, j + 1 + SD); SBAR();
    pv_d0(o, vb0 + SHM_V, pa0, pa1, pa2, pa3); MASK(pA0, pA1, j + 1); partialSM<DQK>(pA0, pA1, m_reg, mnA, alA);
    __syncthreads(); SWAIT(); SWRITE(1, SO);
    RESC(alA); __syncthreads();
  }
  SBAR(); qkt<DQK>(pB0, pB1, K_lds + SHM_K, qr, r32, hi);
  finishSM(pA0, pA1, alA, l_reg, pa0, pa1, pa2, pa3); SBAR();
  pv_d0(o, vb0, pa0, pa1, pa2, pa3); MASK(pB0, pB1, NT - 1); partialSM<DQK>(pB0, pB1, m_reg, mnB, alB);
  __syncthreads(); RESC(alB);
  finishSM(pB0, pB1, alB, l_reg, pa0, pa1, pa2, pa3); SBAR();
  pv_d0(o, vb0 + SHM_V, pa0, pa1, pa2, pa3);
  if (hi == 0) li_l[r32] = l_reg; asm volatile("s_waitcnt lgkmcnt(0)" ::: "memory");
  char* Ow = (char*)U.O + (size_t)(wid * QBLK) * U.ldo * 2;
  __syncthreads();
  { char* Os = lds + wid * 8192;
#pragma unroll
    for (int r = 0; r < 16; ++r) { const int orow = crow(r, hi); const float rl = __builtin_amdgcn_rcpf(li_l[orow]);
#pragma unroll
      for (int d0 = 0; d0 < 4; ++d0) *(u16*)(Os + orow * 256 + (d0 * 32 + r32) * 2) = (u16)f2bf(o[d0][r] * rl); }
    asm volatile("s_waitcnt lgkmcnt(0)" ::: "memory");
#pragma unroll
    for (int i = 0; i < 8; ++i) { const int row = i * 4 + (lane >> 4); const v4u v = *(const v4u*)(Os + row * 256 + (lane & 15) * 16); *(v4u*)(Ow + (size_t)row * U.ldo * 2 + (lane & 15) * 16) = v; } }
#undef TROW
#undef SLOAD
#undef SWRITE
#undef SWAIT
#undef RESC
#undef MASK
}
#undef SBAR
}

constexpr size_t MiB = 1u << 20;
constexpr size_t al1(size_t x) { return (x + MiB - 1) / MiB * MiB; }
constexpr size_t WS_CTL = 0, CTL_ZERO_BYTES = 8 * MiB;
constexpr size_t WS_MOD = 1 * MiB;
constexpr size_t WS_ROWSS = 2 * MiB;
constexpr size_t WS_SW = 4 * MiB;
constexpr int SW_STRIDE = 3 * INW;
constexpr size_t WS_MISC = 8 * MiB;
constexpr size_t WS_XC = 9 * MiB;
constexpr size_t WS_HN = WS_XC + al1((size_t)NB * CTXL * DM * 4);
constexpr size_t WS_HD = WS_HN + al1((size_t)MROWS * DM * 2);
constexpr size_t WS_QKV = WS_HD + al1((size_t)MROWS * FFN * 2);
constexpr size_t WS_SG = WS_QKV + al1((size_t)MROWS * QKVW * 2);
constexpr size_t WS_OCAT = WS_SG + al1((size_t)MROWS * SGW * 2);
constexpr size_t WS_OCR = WS_OCAT + al1((size_t)MROWS * DM * 2);
constexpr size_t WS_MX = WS_OCR + al1((size_t)MROWS * 2048 * 2);
constexpr size_t WS_MXB = WS_MX + al1((size_t)MROWS * DM * 4);
constexpr size_t WS_PART = WS_MXB + al1((size_t)MROWS * DM * 2);
constexpr size_t WS_W = WS_PART + al1((size_t)8 * NB * CTXL * DM * 4);
constexpr size_t WO_1IN = 0, WO_1OUT = WO_1IN + (size_t)2 * FFN * DM * 2, WO_2IN = WO_1OUT + (size_t)DM * FFN * 2, WO_2OUT = WO_2IN + (size_t)2 * FFN * DM * 2,
                 WO_IN = WO_2OUT + (size_t)DM * FFN * 2, WO_BR = WO_IN + (size_t)INW * DM * 2  ,
                 WO_OUT = WO_BR + (size_t)DM * DM * 2, W_LAYER = WO_OUT + (size_t)DM * DM * 2;
constexpr size_t WS_W8 = WS_W + DEPTH * W_LAYER;
constexpr size_t W8_LAYER = (size_t)INW * DM;
constexpr size_t WS_XG8 = WS_W8 + DEPTH * W8_LAYER;
constexpr size_t WS_END = WS_XG8 + al1((size_t)MROWS * DM);
static_assert((WS_XG8 & (MiB - 1)) == 0 && WS_ROWSS + (size_t)DEPTH * 3 * MROWS * 4 <= WS_SW && WS_SW + (size_t)DEPTH * 3 * SW_STRIDE * 4 <= CTL_ZERO_BYTES && WS_PART == pg8::EpiResid::WS_PART_OFF && WS_HN == pg8::EpiResid::WS_HN_OFF && WS_MOD + (size_t)DEPTH * 3 * MODW * 4 < ((size_t)1 << 32), "EpiResid's workspace offsets");
constexpr int MI_TA = 0, MI_TC = 64 * 32 * 2, MI_LAM = MI_TC + 64 * 16 * 2;
constexpr int CW_TMO = 0, CW_BAR = 4096, CW_ATTQ = 16384;

constexpr int RING_OFF = 0, RING_BYTES = 131072;
constexpr int LDSCTL_OFF = RING_BYTES, MISC_OFF = LDSCTL_OFF + 320;
constexpr int LDS_BYTES = 147456;
constexpr int NWAVES = 8;

#define XB_TMO      128
#define XB_XCNT(j)  (256  + 64 * (j))
#define XB_XSUB(j)  (1280 + 64 * (j))
#define XB_XGEN(j)  (2304 + 64 * (j))
#define XB_TOP      3328
#define XB_TOPGEN   3392
#define XCD_BAR_WORDS 3456
#define XB_SPIN_CAP (1u << 18)

__device__ __forceinline__ unsigned xb_ld(unsigned* p)              { return __hip_atomic_load(p, __ATOMIC_RELAXED, __HIP_MEMORY_SCOPE_AGENT); }
__device__ __forceinline__ unsigned xb_add(unsigned* p, unsigned v) { return __hip_atomic_fetch_add(p, v, __ATOMIC_RELAXED, __HIP_MEMORY_SCOPE_AGENT); }
__device__ __forceinline__ unsigned xb_xcc_id() { return (unsigned)__builtin_amdgcn_s_getreg((3 << 11) | 20) & 0xFu; }
#define XB_SPIN(cond, bar) do { unsigned _sp = 0; while (cond) { __builtin_amdgcn_s_sleep(1); \
    if ((++_sp & 255u) == 0u) { if (xb_ld(&(bar)[XB_TMO])) break; if (_sp > XB_SPIN_CAP) { atomicAdd(&(bar)[XB_TMO], 1u); break; } } } } while (0)

struct XcdBarrier {
    unsigned* bar; unsigned x;
    volatile LAS unsigned* st;
};
__device__ __forceinline__ XcdBarrier xcd_barrier_post(unsigned* bar, volatile LAS unsigned* st, bool lead  ) {
    XcdBarrier b; b.bar = bar; b.x = xb_xcc_id(); b.st = st;
    if (lead) (void)xb_add(&bar[XB_XCNT(b.x)], 1u);
    return b;
}
__device__ __forceinline__ void xcd_barrier_complete(unsigned* bar, unsigned x, unsigned& nloc, unsigned& nx) {
    const unsigned G = gridDim.x * gridDim.y * gridDim.z;
    unsigned sum, cnt, mine, sp = 0u;
    for (;;) {
        sum = 0u; cnt = 0u; mine = 0u;
#pragma unroll
        for (unsigned j = 0; j < 16; ++j) { const unsigned c = xb_ld(&bar[XB_XCNT(j)]); sum += c; cnt += (c > 0u) ? 1u : 0u; mine = (j == x) ? c : mine; }
        if (sum == G) break;
        __builtin_amdgcn_s_sleep(1);
        if ((++sp & 255u) == 0u) { if (xb_ld(&bar[XB_TMO])) break; if (sp > XB_SPIN_CAP) { atomicAdd(&bar[XB_TMO], 1u); break; } }
    }
    nloc = mine > 0u ? mine : 1u; nx = cnt > 0u ? cnt : 1u;
}
__device__ __forceinline__ void xcd_barrier(const XcdBarrier& b, bool lead  ) {
    asm volatile("s_waitcnt vmcnt(0)" ::: "memory");
    __syncthreads();
    if (lead) {
        unsigned* bar = b.bar;
        __builtin_amdgcn_s_waitcnt(0);
        unsigned nloc = b.st[0], nx = b.st[1];
        if (nloc == 0u) { xcd_barrier_complete(bar, b.x, nloc, nx); b.st[0] = nloc; b.st[1] = nx; }
        const unsigned old = xb_add(&bar[XB_XSUB(b.x)], 1u);
        const unsigned gen = old / nloc;
        if (old + 1u == (gen + 1u) * nloc) {
            __builtin_amdgcn_fence(__ATOMIC_RELEASE, "agent");
            asm volatile("s_waitcnt vmcnt(0)" ::: "memory");
            const unsigned og = xb_add(&bar[XB_TOP], 1u);
            const unsigned tg = og / nx;
            if (og + 1u == (tg + 1u) * nx) xb_add(&bar[XB_TOPGEN], 1u);
            else XB_SPIN(xb_ld(&bar[XB_TOPGEN]) == tg, bar);
            __builtin_amdgcn_fence(__ATOMIC_ACQUIRE, "agent");
            xb_add(&bar[XB_XGEN(b.x)], 1u);
            asm volatile("s_waitcnt vmcnt(0)" ::: "memory");
        } else {
            XB_SPIN(xb_ld(&bar[XB_XGEN(b.x)]) == gen, bar);
            __builtin_amdgcn_fence(__ATOMIC_ACQUIRE, "agent");
            asm volatile("s_waitcnt vmcnt(0)" ::: "memory");
        }
    }
    __syncthreads();
}

struct Args {
    const float* in[22];
    float* out; unsigned char* ws;
    int ph_lo, ph_hi;
};
struct Frame {
    LAS unsigned char* lds;
    volatile LAS unsigned* MISC;
    gu32* ctl;
    int tid, lane, wave, vcu, G;
};
template <int X> __device__ __forceinline__ float swz_xor(float v) { return __builtin_bit_cast(float, __builtin_amdgcn_ds_swizzle(__builtin_bit_cast(int, v), (X << 10) | 0x1f)); }
__device__ __forceinline__ float sum16(float v) { v += swz_xor<1>(v); v += swz_xor<2>(v); v += swz_xor<4>(v); v += swz_xor<8>(v); return v; }
__device__ __forceinline__ float sum8(float v) { v += swz_xor<1>(v); v += swz_xor<2>(v); v += swz_xor<4>(v); return v; }
__device__ __forceinline__ float wave_sum(float v) {
    v = sum16(v); v += swz_xor<16>(v);
    const float lo = __builtin_bit_cast(float, __builtin_amdgcn_readlane(__builtin_bit_cast(int, v), 0)), hi = __builtin_bit_cast(float, __builtin_amdgcn_readlane(__builtin_bit_cast(int, v), 32));
    return lo + hi;
}
template <int NKB>
__device__ __forceinline__ void p0_transpose_item(const float* W, int K, int Nsrc, u16* WT, int Kdst, int nblk, int smap, LAS float* scr, int item, int lane, const float* shift, float* sw, int Nsw, unsigned char* W8 = nullptr) {
    const int kbg = item / nblk, nb = item - kbg * nblk, n0 = 32 * nb;
    const int s0 = smap ? (((n0 & 255) >> 7) * FFN + (n0 >> 8) * 128 + (n0 & 127)) : n0;
    float a0 = 0.f, a1 = 0.f, a2 = 0.f;
    for (int kq = 0; kq < NKB; ++kq) {
        const int k0 = 64 * (kbg * NKB + kq);
        { f32x4 v[8];
#pragma unroll
          for (int i = 0; i < 8; ++i) v[i] = __builtin_nontemporal_load((const f32x4*)(W + (size_t)(k0 + 8 * i + (lane >> 3)) * Nsrc + s0 + (lane & 7) * 4));
#pragma unroll
          for (int i = 0; i < 8; ++i) { LAS float* d = scr + (8 * i + (lane >> 3)) * 33 + (lane & 7) * 4; d[0] = v[i].x; d[1] = v[i].y; d[2] = v[i].z; d[3] = v[i].w; } }
        if (NKB > 1) { scr[2112 + lane] = shift[k0 + lane]; scr[2176 + lane] = shift[MODW + k0 + lane]; scr[2240 + lane] = shift[2 * MODW + k0 + lane]; }
        LDS_WAIT(); asm volatile("" ::: "memory");
        const int c = lane & 7;
#pragma unroll
        for (int j = 0; j < 4; ++j) { const int n = (lane >> 3) + 8 * j; const LAS float* s = scr + (8 * c) * 33 + n;
            if (W8 != nullptr) {
                v2u o; o.x = pk4_fp8(s[0 * 33] * 64.f, s[1 * 33] * 64.f, s[2 * 33] * 64.f, s[3 * 33] * 64.f); o.y = pk4_fp8(s[4 * 33] * 64.f, s[5 * 33] * 64.f, s[6 * 33] * 64.f, s[7 * 33] * 64.f);
                *(GAS v2u*)(W8 + (size_t)(n0 + n) * Kdst + k0 + 8 * c) = o;
            } else {
            v4u o; o.x = pk2(s[0 * 33], s[1 * 33]); o.y = pk2(s[2 * 33], s[3 * 33]); o.z = pk2(s[4 * 33], s[5 * 33]); o.w = pk2(s[6 * 33], s[7 * 33]);
            *(GAS v4u*)(WT + (size_t)(n0 + n) * Kdst + k0 + 8 * c) = o; } }
        if (NKB > 1) { const int n = lane & 31, kh = 32 * (lane >> 5);
#pragma unroll 8
            for (int kk = 0; kk < 32; ++kk) { const float w = scr[(kh + kk) * 33 + n]; a0 += w * scr[2112 + kh + kk]; a1 += w * scr[2176 + kh + kk]; a2 += w * scr[2240 + kh + kk]; } }
        LDS_WAIT(); asm volatile("" ::: "memory");
    }
    if (NKB > 1) { float* o = sw + n0 + (lane & 31); unsafeAtomicAdd(o, a0); unsafeAtomicAdd(o + Nsw, a1); unsafeAtomicAdd(o + 2 * Nsw, a2); }
}
__device__ __forceinline__ void p0_ada_item(const float* c, const float* c_ctx, const float* w_ada, const float* b_ada, float* MOD, LAS float* scr, int item, int lane) {
    const int l = item / (32 * 144), r = item - l * (32 * 144), kc = r / 144, cg = r - kc * 144, k0 = kc * 128, col = cg * 256 + lane * 4;
#pragma unroll
    for (int i = 0; i < 2; ++i) { const int k = k0 + i * 64 + lane;
        const float a = c[k], b = c[DM + k], d = c_ctx[k];
        scr[i * 64 + lane] = a * fast_sigmoid(a); scr[256 + i * 64 + lane] = b * fast_sigmoid(b); scr[512 + i * 64 + lane] = d * fast_sigmoid(d); }
    LDS_WAIT(); asm volatile("" ::: "memory");
    const float* wp = w_ada + (size_t)l * DM * MODW + (size_t)k0 * MODW + col;
    f32x4 a0 = {0.f, 0.f, 0.f, 0.f}, a1 = a0, a2 = a0;
#pragma unroll 8
    for (int k = 0; k < 128; ++k) { const f32x4 w = __builtin_nontemporal_load((const f32x4*)(wp + (size_t)k * MODW)); a0 += w * scr[k]; a1 += w * scr[256 + k]; a2 += w * scr[512 + k]; }
    if (kc == 0) { const f32x4 bv = *(const f32x4*)(b_ada + (size_t)l * MODW + col); a0 += bv; a1 += bv; a2 += bv; }
    float* m = MOD + (size_t)l * 3 * MODW + col;
#pragma unroll
    for (int j = 0; j < 4; ++j) { unsafeAtomicAdd(m + j, a0[j]); unsafeAtomicAdd(m + MODW + j, a1[j]); unsafeAtomicAdd(m + 2 * MODW + j, a2[j]); }
    LDS_WAIT(); asm volatile("" ::: "memory");
}

__device__ __forceinline__ void modnorm_phase(const Frame& F, const float* xl, const float* xc, const float* g, const float* modl  , int sub, u16* HN, float* xc_copy  ,
                                              const float* part  , const float* pgate, float pcoef, float* xc_out, float* rowss, bool ctx_only  , unsigned char* hn8  ) {
    const int gw = F.vcu * NWAVES + F.wave, NGW = F.G * NWAVES;
    for (int it = gw; it < (ctx_only ? NB * CTXL : MROWS); it += NGW) {
        const int row = ctx_only ? (it / CTXL) * TPB + SEQ + it % CTXL : it;
        const int b = row / TPB, t = row - b * TPB; const bool isc = t >= SEQ;
        const float* xr = isc ? xc + (size_t)(b * CTXL + t - SEQ) * DM : xl + (size_t)(b * SEQ + t) * DM;
        const float* mv = modl + (size_t)(isc ? 2 : b) * MODW + (size_t)(3 * sub) * DM;
        f32x4 v[16]; float ss = 0.f;
#pragma unroll
        for (int j = 0; j < 16; ++j) { v[j] = *(const f32x4*)(xr + j * 256 + F.lane * 4); ss += (v[j].x * v[j].x + v[j].y * v[j].y) + (v[j].z * v[j].z + v[j].w * v[j].w); }
        if (isc && part) {
            const int cr = b * CTXL + t - SEQ; ss = 0.f;
#pragma unroll
            for (int j = 0; j < 16; ++j) { const int c0 = j * 256 + F.lane * 4; f32x4 a = *(const f32x4*)(part + (size_t)cr * DM + c0);
#pragma unroll
                for (int ks = 1; ks < 8; ++ks) a += *(const f32x4*)(part + ((size_t)ks * (NB * CTXL) + cr) * DM + c0);
                v[j] += a * (*(const f32x4*)(pgate + c0) * pcoef); *(f32x4*)(xc_out + (size_t)cr * DM + c0) = v[j];
                ss += (v[j].x * v[j].x + v[j].y * v[j].y) + (v[j].z * v[j].z + v[j].w * v[j].w); }
        }
        ss = wave_sum(ss); if (F.lane == 0) rowss[row] = ss;
        if (isc && xc_copy) { float* cr = xc_copy + (size_t)(b * CTXL + t - SEQ) * DM;
#pragma unroll
            for (int j = 0; j < 16; ++j) *(f32x4*)(cr + j * 256 + F.lane * 4) = v[j]; }
        u16* orow = HN + (size_t)row * DM;
#pragma unroll
        for (int j = 0; j < 16; ++j) { const int c0 = j * 256 + F.lane * 4;
            const f32x4 gg = *(const f32x4*)(g + c0), sc = *(const f32x4*)(mv + DM + c0);
            const f32x4 y = v[j] * gg * (sc + 1.0f);
            v2u w; w.x = pk2(y.x, y.y); w.y = pk2(y.z, y.w); *(v2u*)(orow + c0) = w;
            if (hn8) *(unsigned*)(hn8 + (size_t)row * DM + c0) = pk4_fp8(y.x, y.y, y.z, y.w); }
    }
}

__device__ __forceinline__ void ctxnorm_phase(const Frame& F, float* xc, const float* g, const float* modl, int sub, u16* HN, const float* part, const float* pgate, float pcoef, float* rowss, unsigned char* hn8) {
    const int gw = F.vcu * NWAVES + F.wave, NGW = F.G * NWAVES;
    const float* mv = modl + (size_t)2 * MODW + (size_t)(3 * sub) * DM;
    for (int it = gw; it < NB * CTXL * 4; it += NGW) {
        const int cr = it >> 2, q = it & 3, b = cr / CTXL, row = b * TPB + SEQ + (cr - b * CTXL);
        float* xr = xc + (size_t)cr * DM + q * 1024 + F.lane * 4;
        f32x4 v[4]; float ss = 0.f;
#pragma unroll
        for (int j = 0; j < 4; ++j) v[j] = *(const f32x4*)(xr + j * 256);
        if (part) {
#pragma unroll
            for (int j = 0; j < 4; ++j) { const int c0 = q * 1024 + j * 256 + F.lane * 4; f32x4 a = *(const f32x4*)(part + (size_t)cr * DM + c0);
#pragma unroll
                for (int ks = 1; ks < 8; ++ks) a += *(const f32x4*)(part + ((size_t)ks * (NB * CTXL) + cr) * DM + c0);
                v[j] += a * (*(const f32x4*)(pgate + c0) * pcoef); *(f32x4*)(xr + j * 256) = v[j]; }
        }
#pragma unroll
        for (int j = 0; j < 4; ++j) ss += (v[j].x * v[j].x + v[j].y * v[j].y) + (v[j].z * v[j].z + v[j].w * v[j].w);
        ss = wave_sum(ss); if (F.lane == 0) unsafeAtomicAdd(rowss + row, ss);
#pragma unroll
        for (int j = 0; j < 4; ++j) { const int c0 = q * 1024 + j * 256 + F.lane * 4;
            const f32x4 gg = *(const f32x4*)(g + c0), sc = *(const f32x4*)(mv + DM + c0);
            const f32x4 y = v[j] * gg * (sc + 1.0f);
            if (hn8) *(unsigned*)(hn8 + (size_t)row * DM + c0) = pk4_fp8(y.x, y.y, y.z, y.w);
            else { v2u w; w.x = pk2(y.x, y.y); w.y = pk2(y.z, y.w); *(v2u*)(HN + (size_t)row * DM + c0) = w; } }
    }
}

template <int KIND  >
__device__ __forceinline__ v4u qk_one(v4u w, const float* gain, bool lat, int gr, int gcl, const f32x2* T, int sub) {
    float x[8]; x[0] = bf_lo(w.x); x[1] = bf_hi(w.x); x[2] = bf_lo(w.y); x[3] = bf_hi(w.y); x[4] = bf_lo(w.z); x[5] = bf_hi(w.z); x[6] = bf_lo(w.w); x[7] = bf_hi(w.w);
    float ss = 0.f;
#pragma unroll
    for (int e = 0; e < 8; ++e) ss += x[e] * x[e];
    ss = (KIND != 2) ? sum16(ss) : sum8(ss);
    const float rstd = 1.0f / sqrtf(ss * (KIND == 2 ? 1.0f / 64.0f : 1.0f / 128.0f) + EPS);
    const int s = KIND == 2 ? (sub & 7) : sub;
    const f32x4 g0 = *(const f32x4*)(gain + 8 * s), g1 = *(const f32x4*)(gain + 8 * s + 4);
    x[0] *= rstd * g0[0]; x[1] *= rstd * g0[1]; x[2] *= rstd * g0[2]; x[3] *= rstd * g0[3]; x[4] *= rstd * g1[0]; x[5] *= rstd * g1[1]; x[6] *= rstd * g1[2]; x[7] *= rstd * g1[3];
    if (KIND != 1 && lat) {
        constexpr int NP = KIND == 0 ? 32 : 16;
        const int i0 = 4 * s; const f32x2* tp = (i0 < NP) ? T + gr * NP + i0 : T + gcl * NP + i0 - NP;
        const f32x4 c01 = *(const f32x4*)tp, c23 = *(const f32x4*)(tp + 2);
        float y;
        y = x[0] * c01[0] - x[1] * c01[1]; x[1] = x[0] * c01[1] + x[1] * c01[0]; x[0] = y;
        y = x[2] * c01[2] - x[3] * c01[3]; x[3] = x[2] * c01[3] + x[3] * c01[2]; x[2] = y;
        y = x[4] * c23[0] - x[5] * c23[1]; x[5] = x[4] * c23[1] + x[5] * c23[0]; x[4] = y;
        y = x[6] * c23[2] - x[7] * c23[3]; x[7] = x[6] * c23[3] + x[7] * c23[2]; x[6] = y;
    }
    v4u o; o.x = pk2(x[0], x[1]); o.y = pk2(x[2], x[3]); o.z = pk2(x[4], x[5]); o.w = pk2(x[6], x[7]); return o;
}
__device__ __forceinline__ void qkprep_phase(const Frame& F, u16* QKV, u16* QOUT, const float* ga, const float* gb, const float* gc, const float* misc) {
    const int gw = F.vcu * NWAVES + F.wave, NGW = F.G * NWAVES, sub = F.lane & 15;
    const f32x2* TA = (const f32x2*)(misc + MI_TA); const f32x2* TC = (const f32x2*)(misc + MI_TC);
    for (int row = gw; row < MROWS; row += NGW) {
        const int t = row % TPB; const bool lat = t < SEQ; const int gr = (t >> 6) & 63, gcl = t & 63;
        u16* rp = QKV + (size_t)row * QKVW + F.lane * 8; u16* wp = QOUT + (size_t)row * QKVW + F.lane * 8;
        v4u v[6];
#pragma unroll
        for (int jj = 0; jj < 6; ++jj) { const int j = jj == 0 ? 3 : (jj < 4 ? 6 + jj : 8 + jj); const int col = j < 4 ? j * 512 : (j < 10 ? CQB + (j - 4) * 512 : CQC + (j - 10) * 512); v[jj] = *(const v4u*)(rp + col); }
#pragma unroll
        for (int jj = 0; jj < 6; ++jj) { const int j = jj == 0 ? 3 : (jj < 4 ? 6 + jj : 8 + jj); const int col = j < 4 ? j * 512 : (j < 10 ? CQB + (j - 4) * 512 : CQC + (j - 10) * 512);
            v4u o;
            if (j < 4)       o = qk_one<0>(v[jj], ga + 128, lat, gr, gcl, TA, sub);
            else if (j < 10) o = qk_one<1>(v[jj], gb + 128, lat, gr, gcl, TA, sub);
            else             o = qk_one<2>(v[jj], gc + 64, lat, gr, gcl, TC, sub);
            *(v4u*)(wp + col) = o; }
    }
}

__device__ __forceinline__ void ccombine_phase(const Frame& F, const u16* OCR, u16* OC, const float* subln, float lam, float one_m_li) {
    const int gw = F.vcu * NWAVES + F.wave, NGW = F.G * NWAVES, sub = F.lane & 15, grp = F.lane >> 4;
    const f32x4 s0 = *(const f32x4*)(subln + 8 * sub) * one_m_li, s1 = *(const f32x4*)(subln + 8 * sub + 4) * one_m_li;
    for (int row = gw; row < MROWS; row += NGW) {
        const u16* rp = OCR + (size_t)row * 2048 + grp * 256 + sub * 8;
        v4u a[2], b[2];
#pragma unroll
        for (int j = 0; j < 2; ++j) { a[j] = *(const v4u*)(rp + j * 1024); b[j] = *(const v4u*)(rp + j * 1024 + 128); }
#pragma unroll
        for (int j = 0; j < 2; ++j) {
            float d[8]; d[0] = bf_lo(a[j].x) - lam * bf_lo(b[j].x); d[1] = bf_hi(a[j].x) - lam * bf_hi(b[j].x); d[2] = bf_lo(a[j].y) - lam * bf_lo(b[j].y); d[3] = bf_hi(a[j].y) - lam * bf_hi(b[j].y);
            d[4] = bf_lo(a[j].z) - lam * bf_lo(b[j].z); d[5] = bf_hi(a[j].z) - lam * bf_hi(b[j].z); d[6] = bf_lo(a[j].w) - lam * bf_lo(b[j].w); d[7] = bf_hi(a[j].w) - lam * bf_hi(b[j].w);
            float ss = 0.f;
#pragma unroll
            for (int e = 0; e < 8; ++e) ss += d[e] * d[e];
            ss = sum16(ss);
            const float rstd = 1.0f / sqrtf(ss * (1.0f / 128.0f) + EPS);
            v4u o; o.x = pk2(d[0] * rstd * s0[0], d[1] * rstd * s0[1]); o.y = pk2(d[2] * rstd * s0[2], d[3] * rstd * s0[3]); o.z = pk2(d[4] * rstd * s1[0], d[5] * rstd * s1[1]); o.w = pk2(d[6] * rstd * s1[2], d[7] * rstd * s1[3]);
            *(v4u*)(OC + (size_t)row * DM + 3072 + (j * 4 + grp) * 128 + sub * 8) = o;
        }
    }
}

constexpr int PPL = 13, NPH = 2 + DEPTH * PPL;
typedef const float* __attribute__((address_space(4))) const* kargp_t;
#define KARGS() kargp_t kp_ = (kargp_t)__builtin_amdgcn_kernarg_segment_ptr(); asm volatile("" : "+s"(kp_))
#define KIN(i) ((const float*)kp_[i])
#define KOUT() ((float*)kp_[22])
#define KWS() ((unsigned char*)kp_[23])
constexpr int H_FIN = (DM / 512) * (2 * FFN / 32), H_IN = (DM / 512) * (INW / 32), H_LAYER = 2 * H_FIN + H_IN;
constexpr int I_FOUT = (FFN / 64) * (DM / 32), I_BRA = (1536 / 64) * (DM / 32), I_BRC = (1024 / 64) * (DM / 32), I_OUT = (DM / 64) * (DM / 32), I_LAYER = 2 * I_FOUT + 2 * I_BRA + I_BRC + I_OUT;
constexpr int TAIL_L1 = 22528, TAIL_H = 12800, T2_H = 7168;
__device__ __forceinline__ void conv_heavy(kargp_t kp_, unsigned char* ws, LAS float* scr, int l, int r, int lane) {
    int ai, Nsrc, smap, which, ksh; size_t wo;
    if (r < H_FIN) { ai = 7; Nsrc = 2 * FFN; wo = WO_1IN; smap = 1; which = 0; ksh = 0; }
    else if ((r -= H_FIN) < H_IN) { ai = 11; Nsrc = INW; wo = WO_IN; smap = 0; which = 1; ksh = 3; }
    else { r -= H_IN; ai = 9; Nsrc = 2 * FFN; wo = WO_2IN; smap = 1; which = 2; ksh = 6; }
    p0_transpose_item<8>(KIN(ai) + (size_t)l * DM * Nsrc, DM, Nsrc, (u16*)(ws + WS_W + (size_t)l * W_LAYER + wo), DM, Nsrc / 32, smap, scr, r, lane,
                         (const float*)(ws + WS_MOD) + (size_t)l * 3 * MODW + (size_t)ksh * DM, (float*)(ws + WS_SW) + (size_t)(l * 3 + which) * SW_STRIDE, Nsrc,
                         which == 1 ? ws + WS_W8 + (size_t)l * W8_LAYER : nullptr);
}
__device__ __forceinline__ void conv_light(kargp_t kp_, unsigned char* ws, LAS float* scr, int l, int r, int lane) {
    int ai, K, Kdst = 0; size_t wo;
    if (r < I_FOUT) { ai = 8; K = FFN; wo = WO_1OUT; }
    else if ((r -= I_FOUT) < I_FOUT) { ai = 10; K = FFN; wo = WO_2OUT; }
    else if ((r -= I_FOUT) < I_BRA) { ai = 18; K = 1536; wo = WO_BR; Kdst = DM; }
    else if ((r -= I_BRA) < I_BRA) { ai = 19; K = 1536; wo = WO_BR + 1536 * 2; Kdst = DM; }
    else if ((r -= I_BRA) < I_BRC) { ai = 20; K = 1024; wo = WO_BR + 3072 * 2; Kdst = DM; }
    else { r -= I_BRC; ai = 21; K = DM; wo = WO_OUT; }
    p0_transpose_item<1>(KIN(ai) + (size_t)l * K * DM, K, DM, (u16*)(ws + WS_W + (size_t)l * W_LAYER + wo), Kdst ? Kdst : K, DM / 32, 0, scr, r, lane, nullptr, nullptr, 0);
}
__device__ __forceinline__ int l0_early(int j) { return j < I_FOUT ? j : j + I_FOUT; }
__device__ __forceinline__ int l0_late(int j) { return j < I_FOUT ? j + I_FOUT : j + 2 * I_BRA + I_BRC + I_FOUT; }
template <int KIND> __device__ __forceinline__ void conv_tail(kargp_t kp_, unsigned char* ws, LAS unsigned char* lds, int G, int c, int busy, int lo, int hi, int wv) {
    if (c < busy || busy >= G) return;
    const int t_ = tid_of(wv); const int wave = wv, lane = t_ & 63;
    LAS float* scr = (LAS float*)(lds + RING_OFF + wave * 16384);
    for (int it = lo + (c - busy) * NWAVES + wave; it < hi; it += (G - busy) * NWAVES) { if (KIND == 1) conv_heavy(kp_, ws, scr, 1, it, lane); else if (KIND == 0) conv_light(kp_, ws, scr, 1, it, lane); else conv_light(kp_, ws, scr, 0, l0_early(it), lane); }
    LDS_WAIT();
}

__device__ __forceinline__ int attq_next(const Frame& F, gu32* head) {
    volatile LAS unsigned* slot = (volatile LAS unsigned*)(F.lds + att::OFF_SLOT);
    __syncthreads();
    if (F.tid == 0) slot[0] = __hip_atomic_fetch_add(head, 1u, RLX_AGENT);
    __syncthreads();
    return __builtin_amdgcn_readfirstlane((int)slot[0]);
}
__device__ __forceinline__ void attn_phase(const Frame& F, const u16* QKV, u16* OCAT, u16* OCR, const float* rel_bias  , gu32* qhead, bool with_ctx,
                                           const float* ga, const float* gb, const float* gc  , const float* misc  , kargp_t kp_, unsigned char* ws, bool conv  ) {
    char* lds = (char*)F.lds;
    int cround = 0; const int crounds = conv ? (TAIL_H - T2_H + F.G * NWAVES - 1) / (F.G * NWAVES) : 0;
#define CONV_ROUND() do { if (cround < crounds) { __syncthreads(); const int it_ = T2_H + cround * F.G * NWAVES + (int)blockIdx.x * NWAVES + F.wave; \
        if (it_ < TAIL_H) conv_heavy(kp_, ws, (LAS float*)(F.lds + RING_OFF + F.wave * 9216), 1, it_, tid_of(F.wave) & 63  ); LDS_WAIT(); ++cround; } } while (0)
    for (;;) {
        const int idx = attq_next(F, qhead); if (idx >= (with_ctx ? 408 : 384)) break;
        att::Unit U; int h, b, qb; const bool ctxq = idx >= 384;
        if (!ctxq) { qb = idx & 15; h = (idx >> 4) % 12; b = idx / 192; } else { const int i = idx - 384; qb = 16; h = i % 12; b = i / 12; }
        const int rowq = b * TPB + qb * 256; U.r0 = 0; U.first = 0; U.base1 = 0;
        if (ctxq) { U.NT = 4; U.n0 = 4; U.base0 = b * TPB + SEQ; } else { U.NT = 68; U.n0 = 68; U.base0 = b * TPB; }
        U.Q = QKV + (size_t)rowq * QKVW + CQA + h * 128; U.K = QKV + CKA + (h / 3) * 128; U.V = QKV + CVA + (h / 3) * 128; U.O = OCAT + (size_t)rowq * DM + h * 128; U.ldo = DM;
        U.qgain = ga; U.qrope = ctxq ? nullptr : misc + MI_TA; U.t0 = ctxq ? 0 : qb * 256;
        att::attn_unit<128, 0, 2>(U, lds, F.wave);
        CONV_ROUND();
    }
    for (;;) {
        const int idx = attq_next(F, qhead + 64); if (idx >= (with_ctx ? 544 : 512)) break;
        att::Unit U; int ph, b, qb; const bool ctxq = idx >= 512;
        if (!ctxq) { qb = idx & 15; ph = (idx >> 4) & 15; b = idx >> 8; } else { const int i = idx - 512; qb = 16; ph = i & 15; b = i >> 4; }
        const int rowq = b * TPB + qb * 256, h = ph >> 1, cmap = ph & 1; U.r0 = 0; U.first = 0; U.base1 = 0;
        if (ctxq) { U.NT = 4; U.n0 = 4; U.base0 = b * TPB + SEQ; } else { U.NT = 68; U.n0 = 68; U.base0 = b * TPB; }
        U.Q = QKV + (size_t)rowq * QKVW + CQC + h * 128 + cmap * 64; U.K = QKV + CKC + h * 128 + cmap * 64; U.V = QKV + CVC + h * 128; U.O = OCR + (size_t)rowq * 2048 + ph * 128; U.ldo = 2048;
        U.qgain = gc; U.qrope = ctxq ? nullptr : misc + MI_TC; U.t0 = ctxq ? 0 : qb * 256;
        att::attn_unit<64, 0, 2>(U, lds, F.wave);
        CONV_ROUND();
    }
    for (;;) {
        const int idx = attq_next(F, qhead + 128); if (idx >= (with_ctx ? 408 : 384)) break;
        att::Unit U; int h, b, qb; const bool ctxq = idx >= 384;
        if (!ctxq) { qb = idx & 15; h = (idx >> 4) % 12; b = idx / 192; } else { const int i = idx - 384; qb = 16; h = i % 12; b = i / 12; }
        const int rowq = b * TPB + qb * 256; U.r0 = 0; U.first = 0; U.base1 = 0; U.NT = 4; U.n0 = 4; U.base0 = b * TPB + SEQ;
        if (!ctxq) {
            const int r0 = qb * 4; int first = min(max(r0 - 4, 0), 56); const int last = min(max(r0 - 1, 0), 56) + 7; int cnt = last - first + 1;
            if (cnt & 1) { if (first > 0) --first; ++cnt; }
            U.NT = 4 + cnt; U.base1 = b * TPB + first * 64; U.r0 = r0; U.first = first;
            LAS float* biasq = (LAS float*)(F.lds + att::OFF_BIAS);
            for (int e = F.tid; e < 465; e += NWAVES * 64) biasq[e] = rel_bias[h * 465 + e] * 11.313708498984761f;
        }
        U.Q = QKV + (size_t)rowq * QKVW + CQB + h * 128; U.K = QKV + CKB + h * 128; U.V = QKV + CVB + h * 128; U.O = OCAT + (size_t)rowq * DM + 1536 + h * 128; U.ldo = DM;
        U.qgain = gb; U.qrope = nullptr; U.t0 = 0;
        att::attn_unit<128, 1, 1>(U, lds, F.wave);
    }
    while (cround < crounds) CONV_ROUND();
#undef CONV_ROUND
}

__device__ __forceinline__ Frame make_frame(unsigned char* ws, LAS unsigned char* lds, int wv) {
    Frame F; F.lds = lds; F.MISC = (volatile LAS unsigned*)(lds + MISC_OFF); F.ctl = (gu32*)(ws + WS_CTL);
    F.tid = tid_of(wv); F.lane = F.tid & 63; F.wave = wv;
    F.G = gridDim.x; { const int bx = blockIdx.x; F.vcu = (F.G % 8 == 0) ? (bx % 8) * (F.G / 8) + bx / 8 : bx; }
    return F;
}
__global__ void __launch_bounds__(NWAVES * 64, 2) trunk_fwd(Args args) {
    extern __shared__ __attribute__((aligned(16))) unsigned char lds[];
    LAS unsigned char* const L = (LAS unsigned char*)lds;
    const int wv_ = __builtin_amdgcn_readfirstlane((int)threadIdx.x >> 6);
    for (int u = tid_of(wv_); u < (LDS_BYTES - LDSCTL_OFF) / 4; u += NWAVES * 64) ((LAS unsigned*)(L + LDSCTL_OFF))[u] = 0u;
    __syncthreads();
    const int lo = args.ph_lo, hi = args.ph_hi;
    if (MK_N_LAUNCHES == 1) { KARGS(); (void)xcd_barrier_post((unsigned*)((gu32*)(KWS() + WS_CTL) + CW_BAR), (volatile LAS unsigned*)(L + MISC_OFF) + 8, tid_of(wv_) == 0); }
#define GRID_BAR() do { if (MK_N_LAUNCHES == 1) { KARGS(); XcdBarrier bar_; bar_.bar = (unsigned*)((gu32*)(KWS() + WS_CTL) + CW_BAR); bar_.x = xb_xcc_id(); bar_.st = (volatile LAS unsigned*)(L + MISC_OFF) + 8; xcd_barrier(bar_, tid_of(wv_) == 0); } } while (0)
#define IN(k) (lo <= (k) && (k) < hi)
#define SEAM(k) do { if (IN((k) + 1)) GRID_BAR(); } while (0)

    if (IN(0)) {
        KARGS(); unsigned char* ws = KWS(); const Frame F = make_frame(ws, L, wv_);
        LAS float* scr = (LAS float*)(F.lds + RING_OFF + F.wave * 16384);
        const int gw = F.vcu * NWAVES + F.wave, NGW = F.G * NWAVES;
        { const float* c_in = KIN(1); const float* cctx_in = KIN(3); const float* w_ada = KIN(4); const float* b_ada = KIN(5); float* MOD = (float*)(ws + WS_MOD);
          for (int it = gw; it < DEPTH * 32 * 144; it += NGW) p0_ada_item(c_in, cctx_in, w_ada, b_ada, MOD, scr, it, F.lane); }
        if (blockIdx.x == 0) {
            float* MISCF = (float*)(ws + WS_MISC); const float* diff_lambda = KIN(16);
            for (int e = F.tid; e < 64 * 32; e += NWAVES * 64) { const int p = e >> 5, i = e & 31; const float inv = powf(10000.0f, -(float)i / 32.0f), ang = (float)p * inv; MISCF[MI_TA + 2 * e] = cosf(ang); MISCF[MI_TA + 2 * e + 1] = sinf(ang); }
            for (int e = F.tid; e < 64 * 16; e += NWAVES * 64) { const int p = e >> 4, i = e & 15; const float inv = powf(10000.0f, -(float)i / 16.0f), ang = (float)p * inv; MISCF[MI_TC + 2 * e] = cosf(ang); MISCF[MI_TC + 2 * e + 1] = sinf(ang); }
            if (F.wave < DEPTH) { const int l = F.wave; const float* dl = diff_lambda + (size_t)l * 4 * 64;
                const float s1 = wave_sum(dl[F.lane] * dl[64 + F.lane]), s2 = wave_sum(dl[128 + F.lane] * dl[192 + F.lane]);
                const float lam_init = 0.8f - 0.6f * expf(-0.3f * (float)l);
                if (F.lane == 0) MISCF[MI_LAM + l] = expf(s1) - expf(s2) + lam_init; }
        }
        LDS_WAIT();
        SEAM(0);
    }
#define PH_BEGIN0() const float* modl = (const float*)(ws + WS_MOD) + (size_t)l * 3 * MODW; float* XC = (float*)(ws + WS_XC)
    if (IN(1)) {
        KARGS(); unsigned char* ws = KWS(); const Frame F = make_frame(ws, L, wv_);
        LAS float* scr = (LAS float*)(F.lds + RING_OFF + F.wave * 16384);
        const int gw = F.vcu * NWAVES + F.wave, NGW = F.G * NWAVES;
        for (int it = gw; it < DEPTH * H_LAYER; it += NGW) {
            const int l = it / H_LAYER, r = it - l * H_LAYER; if (l == 1 && r < TAIL_H) continue;
            conv_heavy(kp_, ws, scr, l, r, F.lane); }
        if (DEPTH > 1) { for (int it = gw; it < TAIL_L1; it += NGW) conv_light(kp_, ws, scr, 0, l0_late(it), F.lane); }
        else { for (int it = gw; it < I_LAYER; it += NGW) conv_light(kp_, ws, scr, 0, it, F.lane); }
        LDS_WAIT();
        { const int l = 0; PH_BEGIN0();
          modnorm_phase(F, KIN(0), KIN(2), KIN(6), modl, 0, (u16*)(ws + WS_HN), XC, nullptr, modl, 0.5f, XC, (float*)(ws + WS_ROWSS), false, nullptr); }
        SEAM(1);
    }

    for (int l = 0; l < DEPTH; ++l) {
        const int P = 2 + l * PPL;
#define PH_BEGIN() KARGS(); unsigned char* ws = KWS(); const Frame F = make_frame(ws, L, wv_); const float* modl = (const float*)(ws + WS_MOD) + (size_t)l * 3 * MODW; \
        const u16* wl = (const u16*)(ws + WS_W + (size_t)l * W_LAYER); float* XL = KOUT(); float* XC = (float*)(ws + WS_XC); \
        float* DXL = rep ? (float*)(ws + WS_MX) : XL; float* DXC = rep ? (float*)(ws + WS_MX) + (size_t)NB * SEQ * DM : XC;     \
        (void)F; (void)modl; (void)wl; (void)XL; (void)XC; (void)DXL; (void)DXC
        if (IN(P + 0) && l != 0) { for (int rep = 0; rep <= DUP(0); ++rep) { PH_BEGIN();
            ctxnorm_phase(F, XC, KIN(6) + (size_t)(l * 3 + 0) * DM, modl, 0, (u16*)(ws + WS_HN), (const float*)(ws + WS_PART), modl - 3 * MODW + 2 * MODW + 8 * DM, 0.5f, (float*)(ws + WS_ROWSS) + (size_t)(l * 3 + 0) * MROWS, nullptr); } SEAM(P + 0); }
        if (IN(P + 1)) { for (int rep = 0; rep <= DUP(1); ++rep) { PH_BEGIN(); pg8::Gemm g{(const u16*)(ws + WS_HN), wl + WO_1IN / 2, MROWS, 2 * FFN, DM}; pg8::StaticOrder S; S.init(MROWS, 2 * FFN, DM, F.G, (int)blockIdx.x);
            pg8::EpiSwiglu E{(u16*)(ws + WS_HD), {(const float*)(ws + WS_ROWSS) + (size_t)(l * 3 + 0) * MROWS, (const float*)(ws + WS_SW) + (size_t)(l * 3 + 0) * SW_STRIDE, 2 * FFN}}; pg8::gemm_phase<pg8::EpiSwiglu, pg8::StaticOrder, true, true>(F.lds + RING_OFF, g, S, E, F.wave); } if (DEPTH > 1) { KARGS(); const int busy_ = ((MROWS / 256) * (2 * FFN / 256)) % (int)gridDim.x;
              if (l == 0) conv_tail<2>(kp_, KWS(), L, (int)gridDim.x, (int)blockIdx.x, busy_, 0, TAIL_L1, wv_); else if (l == 1) conv_tail<0>(kp_, KWS(), L, (int)gridDim.x, (int)blockIdx.x, busy_, TAIL_L1, 2 * TAIL_L1, wv_); } SEAM(P + 1); }
        if (IN(P + 2)) { for (int rep = DUP(2); rep >= 0; --rep) { PH_BEGIN(); pg8::Gemm g{(const u16*)(ws + WS_HD), wl + WO_1OUT / 2, MROWS, DM, FFN}; pg8::ResidOrder S; S.init(DM, FFN, F.G, (int)blockIdx.x, 8, 1);
            pg8::EpiResid E{l == 0 ? KIN(0) : XL, DXL, ws, KIN(6) + (size_t)(l * 3 + 1) * DM, (unsigned)(WS_MOD + ((size_t)l * 3 * MODW + 4 * DM) * 4), (unsigned)(WS_ROWSS + (size_t)(l * 3 + 1) * MROWS * 4), (unsigned)(WS_XG8 >> 20),
                            (unsigned)(WS_MOD + ((size_t)l * 3 * MODW + 2 * DM) * 4), 0.5f, FFN / 64}; pg8::gemm_phase<pg8::EpiResid, pg8::ResidOrder, true, true>(F.lds + RING_OFF, g, S, E, F.wave); } SEAM(P + 2); }
        if (IN(P + 3)) { for (int rep = 0; rep <= DUP(3); ++rep) { PH_BEGIN(); ctxnorm_phase(F, XC, KIN(6) + (size_t)(l * 3 + 1) * DM, modl, 1, (u16*)(ws + WS_HN), (const float*)(ws + WS_PART), modl + 2 * MODW + 2 * DM, 0.5f, (float*)(ws + WS_ROWSS) + (size_t)(l * 3 + 1) * MROWS, ws + WS_XG8); } SEAM(P + 3); }
        if (IN(P + 4)) { for (int rep = 0; rep <= DUP(4); ++rep) { PH_BEGIN();
            const pg8::NormFix nf{(const float*)(ws + WS_ROWSS) + (size_t)(l * 3 + 1) * MROWS, (const float*)(ws + WS_SW) + (size_t)(l * 3 + 1) * SW_STRIDE, INW};
            { pg8::Gemm g{(const u16*)(ws + WS_XG8), (const u16*)(ws + WS_W8 + (size_t)l * W8_LAYER), MROWS, INW, DM / 2}; pg8::MapOrder<1> S; S.S.init(MROWS, 88 * 256, DM / 2, F.G, (int)blockIdx.x); S.extra = 0;
              pg8::EpiInProj E{(u16*)(ws + WS_QKV), (u16*)(ws + WS_SG), nf, 0, 1.0f / 64.0f}; pg8::gemm_phase<pg8::EpiInProj, pg8::MapOrder<1>, true, true, true>(F.lds + RING_OFF, g, S, E, F.wave); }
            } SEAM(P + 4); }
        if (IN(P + 5)) { for (int rep = DUP(5); rep >= 0; --rep) { PH_BEGIN(); qkprep_phase(F, (u16*)(ws + WS_QKV), rep ? (u16*)(ws + WS_MX) : (u16*)(ws + WS_QKV), KIN(12) + (size_t)l * 256, KIN(13) + (size_t)l * 256, KIN(14) + (size_t)l * 128, (const float*)(ws + WS_MISC)); } SEAM(P + 5); }
        if (IN(P + 6)) { for (int rep = 0; rep <= DUP(6); ++rep) { PH_BEGIN(); attn_phase(F, (const u16*)(ws + WS_QKV), (u16*)(ws + WS_OCAT), (u16*)(ws + WS_OCR), KIN(15) + (size_t)l * 12 * 465, F.ctl + CW_ATTQ + 256 * l + 1024 * rep, l == 0,
                KIN(12) + (size_t)l * 256, KIN(13) + (size_t)l * 256, KIN(14) + (size_t)l * 128, (const float*)(ws + WS_MISC), kp_, ws, l == 0 && DEPTH > 1 && rep == 0); } SEAM(P + 6); }
        if (IN(P + 7)) { for (int rep = 0; rep <= DUP(7); ++rep) { PH_BEGIN(); const float lam_init = 0.8f - 0.6f * expf(-0.3f * (float)l);
            ccombine_phase(F, (const u16*)(ws + WS_OCR), (u16*)(ws + WS_OCAT), KIN(17) + (size_t)l * 128, ((const float*)(ws + WS_MISC))[MI_LAM + l], 1.0f - lam_init); } SEAM(P + 7); }
        if (IN(P + 8)) { for (int rep = 0; rep <= DUP(8); ++rep) { PH_BEGIN(); pg8::Gemm g{(const u16*)(ws + WS_OCAT), wl + WO_BR / 2, MROWS, DM, DM}; pg8::GateOrder S; S.S.init(MROWS, DM, DM, F.G, (int)blockIdx.x, l == DEPTH - 1);
            pg8::EpiGate E{(const u16*)(ws + WS_SG), (u16*)(ws + WS_MXB)}; pg8::gemm_phase<pg8::EpiGate, pg8::GateOrder, true, true>(F.lds + RING_OFF, g, S, E, F.wave); } if (l == 0 && DEPTH > 1) { KARGS(); conv_tail<1>(kp_, KWS(), L, (int)gridDim.x, (int)blockIdx.x, ((MROWS / 256) * (DM / 256)) % (int)gridDim.x, 0, T2_H, wv_); } SEAM(P + 8); }
        if (IN(P + 9)) { for (int rep = DUP(9); rep >= 0; --rep) { PH_BEGIN(); pg8::Gemm g{(const u16*)(ws + WS_MXB), wl + WO_OUT / 2, MROWS, DM, DM}; pg8::ResidOrder S; S.init(DM, DM, F.G, (int)blockIdx.x, 8, l != DEPTH - 1);
            pg8::EpiResid E{XL, DXL, ws, KIN(6) + (size_t)(l * 3 + 2) * DM, (unsigned)(WS_MOD + ((size_t)l * 3 * MODW + 7 * DM) * 4), (unsigned)(WS_ROWSS + (size_t)(l * 3 + 2) * MROWS * 4), 0u,
                            (unsigned)(WS_MOD + ((size_t)l * 3 * MODW + 5 * DM) * 4), 1.0f, DM / 64}; pg8::gemm_phase<pg8::EpiResid, pg8::ResidOrder, true, true>(F.lds + RING_OFF, g, S, E, F.wave); } SEAM(P + 9); }
        if (IN(P + 10) && l != DEPTH - 1) { for (int rep = 0; rep <= DUP(10); ++rep) { PH_BEGIN(); ctxnorm_phase(F, XC, KIN(6) + (size_t)(l * 3 + 2) * DM, modl, 2, (u16*)(ws + WS_HN), (const float*)(ws + WS_PART), modl + 2 * MODW + 5 * DM, 1.0f, (float*)(ws + WS_ROWSS) + (size_t)(l * 3 + 2) * MROWS, nullptr); } SEAM(P + 10); }
        if (IN(P + 11)) { for (int rep = 0; rep <= DUP(11); ++rep) { PH_BEGIN(); pg8::Gemm g{(const u16*)(ws + WS_HN), wl + WO_2IN / 2, MROWS, 2 * FFN, DM}; pg8::StaticOrder S; S.init(MROWS, 2 * FFN, DM, F.G, (int)blockIdx.x, l == DEPTH - 1);
            pg8::EpiSwiglu E{(u16*)(ws + WS_HD), {(const float*)(ws + WS_ROWSS) + (size_t)(l * 3 + 2) * MROWS, (const float*)(ws + WS_SW) + (size_t)(l * 3 + 2) * SW_STRIDE, 2 * FFN}}; pg8::gemm_phase<pg8::EpiSwiglu, pg8::StaticOrder, true, true>(F.lds + RING_OFF, g, S, E, F.wave); } if (l == 0 && DEPTH > 1) { KARGS(); conv_tail<0>(kp_, KWS(), L, (int)gridDim.x, (int)blockIdx.x, ((MROWS / 256) * (2 * FFN / 256)) % (int)gridDim.x, 0, TAIL_L1, wv_); } SEAM(P + 11); }
        if (IN(P + 12)) { for (int rep = DUP(12); rep >= 0; --rep) { PH_BEGIN(); pg8::Gemm g{(const u16*)(ws + WS_HD), wl + WO_2OUT / 2, MROWS, DM, FFN}; pg8::ResidOrder S; S.init(DM, FFN, F.G, (int)blockIdx.x, 8, l != DEPTH - 1);
            pg8::EpiResid E{XL, DXL, ws, l + 1 < DEPTH ? KIN(6) + (size_t)((l + 1) * 3 + 0) * DM : nullptr, (unsigned)(WS_MOD + ((size_t)(l + 1) * 3 * MODW + 1 * DM) * 4), (unsigned)(WS_ROWSS + (size_t)((l + 1) * 3 + 0) * MROWS * 4), 0u,
                            (unsigned)(WS_MOD + ((size_t)l * 3 * MODW + 8 * DM) * 4), 0.5f, FFN / 64}; pg8::gemm_phase<pg8::EpiResid, pg8::ResidOrder, true, true>(F.lds + RING_OFF, g, S, E, F.wave); } SEAM(P + 12); }
#undef PH_BEGIN
    }
#undef IN
#undef SEAM
#undef GRID_BAR
}

extern "C" void kernel_launch(void* const* d_in, const int* in_sizes, int n_in, void* d_out, int out_size, void* d_ws, size_t ws_size, hipStream_t stream) {
    static int grid = 0;
    if (grid == 0) {
        if (n_in != 22 || out_size != NB * SEQ * DM || ws_size < WS_END) { fprintf(stderr, "kernel_launch: built for 22 inputs, out %d floats, >= %zu bytes of workspace; got n_in %d, out %d, ws %zu; nothing launched\n", NB * SEQ * DM, (size_t)WS_END, n_in, out_size, ws_size); grid = -1; return; }
        int dev = 0, cus = 0, per_cu = 0;
        if (hipGetDevice(&dev) != hipSuccess || hipDeviceGetAttribute(&cus, hipDeviceAttributeMultiprocessorCount, dev) != hipSuccess) { fprintf(stderr, "kernel_launch: device query failed\n"); grid = -1; return; }
        if (hipFuncSetAttribute((const void*)trunk_fwd, hipFuncAttributeMaxDynamicSharedMemorySize, LDS_BYTES) != hipSuccess) { fprintf(stderr, "kernel_launch: hipFuncSetAttribute failed\n"); grid = -1; return; }
        if (hipOccupancyMaxActiveBlocksPerMultiprocessor(&per_cu, (const void*)trunk_fwd, NWAVES * 64, LDS_BYTES) != hipSuccess || per_cu < 1)
            fprintf(stderr, "kernel_launch: note: occupancy query reports %d workgroups per CU\n", per_cu);
        (void)hipGetLastError();
        grid = cus;
    }
    if (grid < 0) return;
    if (hipMemsetAsync((char*)d_ws + WS_CTL, 0, CTL_ZERO_BYTES, stream) != hipSuccess) { fprintf(stderr, "kernel_launch: hipMemsetAsync failed\n"); return; }
    Args a{};
    for (int i = 0; i < 22; ++i) a.in[i] = (const float*)d_in[i];
    a.out = (float*)d_out; a.ws = (unsigned char*)d_ws;
#if MK_N_LAUNCHES == 1
    a.ph_lo = 0; a.ph_hi = NPH;
    hipLaunchKernelGGL(trunk_fwd, dim3(grid), dim3(NWAVES * 64), LDS_BYTES, stream, a);
#else
    for (int p = 0; p < NPH; ++p) { a.ph_lo = p; a.ph_hi = p + 1; hipLaunchKernelGGL(trunk_fwd, dim3(grid), dim3(NWAVES * 64), LDS_BYTES, stream, a); }
#endif
    const hipError_t le = hipPeekAtLastError();
    if (le != hipSuccess) fprintf(stderr, "kernel_launch: launch failed: %s\n", hipGetErrorName(le));
}
```

```cpp
#include <hip/hip_runtime.h>
#include <cstdio>
#include <cstdint>

#ifndef DUPMASK
#define DUPMASK 0
#endif
#define DUP(k) ((DUPMASK >> (k)) & 1)
#ifndef MK_N_LAUNCHES
#define MK_N_LAUNCHES 1
#endif

constexpr int DM = 4096, NB = 2, SEQ = 4096, CTXL = 256, TPB = SEQ + CTXL  , MROWS = NB * TPB  ;
constexpr int FFN = 7168, NMOD = 9, MODW = NMOD * DM  , DEPTH = 2;
constexpr int INW = 22528, QKVW = 10240, SGW = 12288;
constexpr int PAN_PER_B = TPB / 256;
constexpr float EPS = 1e-6f;
constexpr int CQA = 0, CKA = 1536, CVA = 2048, CQB = 2560, CKB = 4096, CVB = 5632, CQC = 7168, CKC = 8192, CVC = 9216;

#define GAS __attribute__((address_space(1)))
#define LAS __attribute__((address_space(3)))
typedef unsigned short u16;
typedef unsigned v4u __attribute__((ext_vector_type(4)));
typedef unsigned v2u __attribute__((ext_vector_type(2)));
typedef float f32x4 __attribute__((ext_vector_type(4)));
typedef float f32x2 __attribute__((ext_vector_type(2)));
typedef GAS unsigned gu32;
#define RLX_AGENT __ATOMIC_RELAXED, __HIP_MEMORY_SCOPE_AGENT
#define LDS_WAIT() asm volatile("s_waitcnt lgkmcnt(0)" ::: "memory")
#define VM_WAIT() asm volatile("s_waitcnt vmcnt(0)" ::: "memory")
__device__ __forceinline__ unsigned f2bf(float f) { unsigned u = __builtin_bit_cast(unsigned, f); return (u + 0x7fffu + ((u >> 16) & 1u)) >> 16; }
__device__ __forceinline__ unsigned pk2(float lo, float hi) { return f2bf(lo) | (f2bf(hi) << 16); }
__device__ __forceinline__ float bf_lo(unsigned w) { return __builtin_bit_cast(float, w << 16); }
__device__ __forceinline__ float bf_hi(unsigned w) { return __builtin_bit_cast(float, w & 0xffff0000u); }
__device__ __forceinline__ unsigned cvt_pk_bf16(float lo, float hi) { unsigned r; asm volatile("v_cvt_pk_bf16_f32 %0, %1, %2" : "=v"(r) : "v"(lo), "v"(hi)); return r; }
__device__ __forceinline__ unsigned pk4_fp8(float a, float b, float c, float d) { unsigned w = 0; w = __builtin_amdgcn_cvt_pk_fp8_f32(a, b, w, false); w = __builtin_amdgcn_cvt_pk_fp8_f32(c, d, w, true); return w; }
__device__ __forceinline__ float fast_sigmoid(float v) { return __builtin_amdgcn_rcpf(1.0f + __builtin_amdgcn_exp2f(-1.4426950408889634f * v)); }

__device__ __forceinline__ int tid_of(int wv) { int t; asm volatile("v_mbcnt_lo_u32_b32 %0, -1, 0\n\tv_mbcnt_hi_u32_b32 %0, -1, %0\n\tv_lshl_or_b32 %0, %1, 6, %0" : "=&v"(t) : "s"(wv)); return t; }

namespace pg8 {
#define PG8_LAS __attribute__((address_space(3)))
typedef unsigned short bf16_t;
typedef short bf16x8 __attribute__((ext_vector_type(8)));
typedef float f32x4 __attribute__((ext_vector_type(4)));
typedef unsigned u32x4 __attribute__((ext_vector_type(4)));
typedef unsigned u32x2 __attribute__((ext_vector_type(2)));
typedef int i32x4 __attribute__((ext_vector_type(4)));
constexpr int BM = 256, BK = 64, HALF = 128, HTB = HALF * BK * 2  , STAGE_BYTES = 8 * HTB, NXCD = 8, WGM = 4;

__host__ __device__ __forceinline__ int lds_byte(int r, int c) { const int st = (r >> 4) * 2 + (c >> 5), rr = r & 15, cc = c & 31, ob = rr * 64 + cc * 2; return st * 1024 + (ob ^ (((ob >> 9) & 1) << 5)); }
__host__ __device__ __forceinline__ void stage_rc(int b, int& R, int& C) { const int st = b / 1024, sb = b % 1024, swz = sb ^ (((sb >> 9) & 1) << 5); R = (st >> 1) * 16 + swz / 64; C = (st & 1) * 32 + (swz % 64) / 2; }
__host__ __device__ __forceinline__ int perm32(int rho) { const int n = rho >> 4, i = rho & 15; return 8 * (i >> 2) + 4 * n + (i & 3); }

struct Unit { int pm, pn, kt0, nt; };
struct Gemm { const bf16_t* A; const bf16_t* Bt; int M, N, K; };

struct StaticOrder {
    int nM, nN, nwg, G, c, ntf, lat;
    __host__ __device__ void init(int M, int N, int K, int G_, int c_, int lat_only = 0) { lat = lat_only; nM = lat ? 32 : M / BM; nN = N / BM; nwg = nM * nN; G = G_; c = c_; ntf = K / BK; }
    __host__ __device__ __forceinline__ bool map(long L, Unit& u) const {
        if (L >= nwg) return false;
        int wgid = (int)L; { const int q = nwg / NXCD, r = nwg % NXCD, xcd = wgid % NXCD, off = wgid / NXCD; wgid = (xcd < r ? xcd * (q + 1) : r * (q + 1) + (xcd - r) * q) + off; }
        const int nig = WGM * nN, gid = wgid / nig, fm = gid * WGM, gsz = (nM - fm) < WGM ? (nM - fm) : WGM;
        u.pm = fm + ((wgid % nig) % gsz); u.pn = (wgid % nig) / gsz; if (lat) u.pm += u.pm >> 4; u.kt0 = 0; u.nt = ntf; return true;
    }
    __host__ __device__ __forceinline__ bool next(int i, Unit& u) const { return map((long)i * G + c, u); }
    __device__ __forceinline__ void a_ready(const Unit&) const {}
    __device__ __forceinline__ void done(const Unit&) const {}
};
template <int MODE> struct MapOrder { StaticOrder S; int extra;
    __host__ __device__ __forceinline__ bool next(int i, Unit& u) const { const int nl = S.G - extra, pre = extra > 0 ? 2 * nl : 0; long L;
        if (extra > 0 && S.c >= extra) L = i < 2 ? (long)i * nl + (S.c - extra) : (long)pre + (long)(i - 2) * S.G + S.c; else L = (long)pre + (long)i * S.G + S.c;
        const bool ok = S.map(L, u); const int p = u.pn;
        u.pn = p; return ok; }
    __device__ __forceinline__ void a_ready(const Unit&) const {}
    __device__ __forceinline__ void done(const Unit&) const {} };
struct ResidOrder {
    StaticOrder S; int KS, ctx;
    __host__ __device__ void init(int N, int K, int G_, int c_, int KS_, int ctx_) { S.init(MROWS, N, K, G_, c_, 1); KS = KS_; ctx = ctx_; }
    __host__ __device__ __forceinline__ bool next(int i, Unit& u) const {
        const long L = (long)i * S.G + S.c; const bool islat = L < S.nwg;
        Unit a; (void)S.map(islat ? L : 0, a);
        const long L2 = islat ? 0 : L - S.nwg; const int ks = (int)(L2 % KS), t = (int)(L2 / KS), cnt = S.ntf / KS;
        u.pn = islat ? a.pn : t % S.nN; u.pm = islat ? a.pm : (t / S.nN) * PAN_PER_B + (PAN_PER_B - 1); u.nt = islat ? a.nt : cnt; u.kt0 = islat ? 0 : ks * cnt;
        return islat || (ctx && L2 < 2 * S.nN * KS);
    }
    __device__ __forceinline__ void a_ready(const Unit&) const {}
    __device__ __forceinline__ void done(const Unit&) const {}
};


__device__ __forceinline__ size_t panel_off(int pm, bool& is_ctx, int& b) { b = pm / PAN_PER_B; const int j = pm - b * PAN_PER_B; is_ctx = (j == PAN_PER_B - 1); return is_ctx ? (size_t)(b * CTXL) * DM : (size_t)(b * SEQ + j * 256) * DM; }

struct EpiResid {
    static constexpr bool PERM = true, AFTER_DRAIN = false; static constexpr size_t WS_PART_OFF = (size_t)884 << 20, WS_HN_OFF = (size_t)17 << 20, WS_XP_OFF = (size_t)680 << 20;
    __device__ static __forceinline__ bool keep(const Unit&) { return false; }
    const float* src_lat; float* dst_lat; unsigned char* wsb;
    const float* gsn; unsigned scale_off, rowss_off, xg8_off;
    unsigned gate_off; float coef; int ntf; int lay;
    __device__ __forceinline__ void operator()(const f32x4 (&acc)[2][2][4][2], const Unit& u, int wr, int wc, int fr, int fq) const {
        bool isc; int b; const size_t po = panel_off(u.pm, isc, b); const bool split = u.nt != ntf;
        const float* s = src_lat + po; float* d = dst_lat + po; const float* g = (const float*)(wsb + gate_off) + (size_t)b * MODW; float* part = (float*)(wsb + WS_PART_OFF);
        const int row0 = wr * 64 + fr, col0 = u.pn * BM + wc * 32 + 8 * fq;
        float* xp = (float*)(wsb + WS_XP_OFF) + ((size_t)((u.pm - b) * 16 + u.pn) * (32 * 512) + (wr * 4 + wc) * 64 + fq * 16 + fr) * 4;
        f32x4 gv[2][2];
#pragma unroll
        for (int bj = 0; bj < 2; ++bj)
#pragma unroll
            for (int n = 0; n < 2; ++n) gv[bj][n] = *(const f32x4*)(g + col0 + bj * HALF + n * 4) * coef;
        if (split) {
            float* pp = part + ((size_t)((u.kt0 * 8) / ntf) * (NB * CTXL) + (size_t)b * CTXL) * DM;
#pragma unroll
            for (int ai = 0; ai < 2; ++ai)
#pragma unroll
                for (int m = 0; m < 4; ++m) { const size_t off = (size_t)(row0 + ai * HALF + m * 16) * DM + col0;
#pragma unroll
                    for (int bj = 0; bj < 2; ++bj)
#pragma unroll
                        for (int n = 0; n < 2; ++n) *(f32x4*)(pp + off + bj * HALF + n * 4) = acc[ai][bj][m][n]; }
        } else {
            const bool mk = gsn != nullptr; float* rsp = (float*)(wsb + rowss_off) + u.pm * BM + row0; const float* scp = (const float*)(wsb + scale_off) + (size_t)b * MODW;
            bf16_t* xg = (bf16_t*)(wsb + WS_HN_OFF) + (size_t)u.pm * BM * DM; unsigned char* xg8 = wsb + ((size_t)xg8_off << 20) + (size_t)u.pm * BM * DM;
#pragma unroll
            for (int ai = 0; ai < 2; ++ai)
#pragma unroll
              for (int mp = 0; mp < 2; ++mp) {
                f32x4 sv[2][2][2];
#pragma unroll
                for (int mm = 0; mm < 2; ++mm) { const size_t off = (size_t)(row0 + ai * HALF + (mp * 2 + mm) * 16) * DM + col0;
#pragma unroll
                    for (int bj = 0; bj < 2; ++bj)
#pragma unroll
                        for (int n = 0; n < 2; ++n) sv[mm][bj][n] = *(const f32x4*)((lay & 1) ? xp + (size_t)((((ai * 2 + bj) * 4 + mp * 2 + mm) * 2 + n) * 2048) : s + off + bj * HALF + n * 4); }
#pragma unroll
                for (int mm = 0; mm < 2; ++mm) { const int m = mp * 2 + mm; const size_t off = (size_t)(row0 + ai * HALF + m * 16) * DM + col0; float q = 0.f;
#pragma unroll
                    for (int bj = 0; bj < 2; ++bj) { f32x4 xn[2];
#pragma unroll
                        for (int n = 0; n < 2; ++n) { xn[n] = sv[mm][bj][n] + gv[bj][n] * acc[ai][bj][m][n]; *(f32x4*)((lay & 2) ? xp + (size_t)((((ai * 2 + bj) * 4 + m) * 2 + n) * 2048) : d + off + bj * HALF + n * 4) = xn[n]; }
                        if (mk) { f32x4 y[2];
#pragma unroll
                            for (int n = 0; n < 2; ++n) { y[n] = xn[n] * (*(const f32x4*)(gsn + col0 + bj * HALF + n * 4) * (*(const f32x4*)(scp + col0 + bj * HALF + n * 4) + 1.0f)); q += (xn[n][0] * xn[n][0] + xn[n][1] * xn[n][1]) + (xn[n][2] * xn[n][2] + xn[n][3] * xn[n][3]); }
                            if (!xg8_off) { u32x4 w; w.x = cvt_pk_bf16(y[0][0], y[0][1]); w.y = cvt_pk_bf16(y[0][2], y[0][3]); w.z = cvt_pk_bf16(y[1][0], y[1][1]); w.w = cvt_pk_bf16(y[1][2], y[1][3]); *(u32x4*)(xg + off + bj * HALF) = w; }
                            else {   u32x2 w8; w8.x = pk4_fp8(y[0][0], y[0][1], y[0][2], y[0][3]); w8.y = pk4_fp8(y[1][0], y[1][1], y[1][2], y[1][3]); *(u32x2*)(xg8 + off + bj * HALF) = w8; } } }
                    if (mk) { q += __builtin_bit_cast(float, __builtin_amdgcn_ds_swizzle(__builtin_bit_cast(int, q), (16 << 10) | 0x1f));
                        if ((fq & 1) == 0) unsafeAtomicAdd(rsp + ai * HALF + m * 16, q); } }
                asm volatile("" ::: "memory"); }
        }
    }
};
struct NormFix {
    const float* rowss;
    const float* sw;
    int N;
    __device__ __forceinline__ void rows(const Unit& u, int wr, int fr, float (&rs)[2][4]) const {
#pragma unroll
        for (int ai = 0; ai < 2; ++ai)
#pragma unroll
            for (int m = 0; m < 4; ++m) rs[ai][m] = __builtin_amdgcn_rsqf(rowss[u.pm * BM + wr * 64 + fr + ai * HALF + m * 16] * (1.0f / DM) + EPS);
    }
    __device__ __forceinline__ const float* vecp(const Unit& u) const { const int b = u.pm / PAN_PER_B; return sw + (size_t)((u.pm - b * PAN_PER_B == PAN_PER_B - 1) ? 2 : b) * N; }
};
struct EpiSwiglu {
    static constexpr bool PERM = true, AFTER_DRAIN = false;
    __device__ static __forceinline__ bool keep(const Unit&) { return false; }
    bf16_t* H; NormFix nf;
    __device__ __forceinline__ void operator()(const f32x4 (&acc)[2][2][4][2], const Unit& u, int wr, int wc, int fr, int fq) const {
        const int row0 = u.pm * BM + wr * 64 + fr, col0 = u.pn * HALF + wc * 32 + 8 * fq;
        float rs[2][4]; nf.rows(u, wr, fr, rs);
        const float* swp = nf.vecp(u) + u.pn * BM + wc * 32 + 8 * fq; f32x4 sg[2], su[2];
#pragma unroll
        for (int n = 0; n < 2; ++n) { sg[n] = *(const f32x4*)(swp + 4 * n); su[n] = *(const f32x4*)(swp + HALF + 4 * n); }
#pragma unroll
        for (int ai = 0; ai < 2; ++ai)
#pragma unroll
            for (int m = 0; m < 4; ++m) { bf16_t* rowp = H + (size_t)(row0 + ai * HALF + m * 16) * FFN + col0;
                float h[8];
#pragma unroll
                for (int n = 0; n < 2; ++n)
#pragma unroll
                    for (int j = 0; j < 4; ++j) { const float gt = acc[ai][0][m][n][j] * rs[ai][m] + sg[n][j], up = acc[ai][1][m][n][j] * rs[ai][m] + su[n][j]; h[n * 4 + j] = gt * fast_sigmoid(gt) * up; }
                u32x4 w; w.x = cvt_pk_bf16(h[0], h[1]); w.y = cvt_pk_bf16(h[2], h[3]); w.z = cvt_pk_bf16(h[4], h[5]); w.w = cvt_pk_bf16(h[6], h[7]);
                *(u32x4*)rowp = w; }
    }
};
struct EpiInProj {
    static constexpr bool PERM = true, AFTER_DRAIN = false;
    __device__ static __forceinline__ bool keep(const Unit&) { return false; }
    bf16_t* QKV; bf16_t* SG; NormFix nf; int pn0; float ascale;
    __device__ __forceinline__ void operator()(const f32x4 (&acc)[2][2][4][2], const Unit& u, int wr, int wc, int fr, int fq) const {
        const int row0 = u.pm * BM + wr * 64 + fr, pn = u.pn + pn0; const bool isg = pn >= QKVW / BM;
        bf16_t* base = isg ? SG : QKV; const int ldc = isg ? SGW : QKVW; const int col0 = (isg ? pn - QKVW / BM : pn) * BM + wc * 32 + 8 * fq;
        float rs[2][4]; nf.rows(u, wr, fr, rs);
#pragma unroll
        for (int ai = 0; ai < 2; ++ai)
#pragma unroll
            for (int m = 0; m < 4; ++m) rs[ai][m] *= ascale;
        const float* swp = nf.vecp(u) + pn * BM + wc * 32 + 8 * fq; f32x4 sv[2][2];
#pragma unroll
        for (int bj = 0; bj < 2; ++bj)
#pragma unroll
            for (int n = 0; n < 2; ++n) sv[bj][n] = *(const f32x4*)(swp + bj * HALF + 4 * n);
#pragma unroll
        for (int ai = 0; ai < 2; ++ai)
#pragma unroll
            for (int m = 0; m < 4; ++m) { bf16_t* rowp = base + (size_t)(row0 + ai * HALF + m * 16) * ldc + col0;
                u32x4 w16 = {0u, 0u, 0u, 0u};
#pragma unroll
                for (int bj = 0; bj < 2; ++bj) { f32x4 v0 = acc[ai][bj][m][0] * rs[ai][m] + sv[bj][0], v1 = acc[ai][bj][m][1] * rs[ai][m] + sv[bj][1];
                    if (isg) {
                        unsigned a = 0u, b = 0u;
#pragma unroll
                        for (int j = 0; j < 4; ++j) { a = __builtin_amdgcn_cvt_pk_u8_f32(fast_sigmoid(v0[j]) * 255.0f, j, a); b = __builtin_amdgcn_cvt_pk_u8_f32(fast_sigmoid(v1[j]) * 255.0f, j, b); }
                        if (bj == 0) { w16.x = a; w16.y = b; } else { w16.z = a; w16.w = b; }
                    } else {
                    u32x4 w; w.x = cvt_pk_bf16(v0[0], v0[1]); w.y = cvt_pk_bf16(v0[2], v0[3]); w.z = cvt_pk_bf16(v1[0], v1[1]); w.w = cvt_pk_bf16(v1[2], v1[3]);
                    *(u32x4*)(rowp + bj * HALF) = w; } }
                if (isg) *(u32x4*)((unsigned char*)SG + (size_t)(row0 + ai * HALF + m * 16) * SGW + (pn - QKVW / BM) * BM + wc * 64 + fq * 16) = w16; }
    }
};
struct EpiGate {
    static constexpr bool PERM = true, AFTER_DRAIN = false;
    __device__ static __forceinline__ bool keep(const Unit& u) { return u.kt0 + u.nt < DM / BK; }
    const bf16_t* SG; bf16_t* MXB;
    __device__ __forceinline__ void operator()(f32x4 (&acc)[2][2][4][2], const Unit& u, int wr, int wc, int fr, int fq) const {
        const int row0 = u.pm * BM + wr * 64 + fr, col0 = u.pn * BM + wc * 32 + 8 * fq;
        const bool lastbr = !keep(u); const int gc0 = (u.kt0 == 0 ? 0 : (u.kt0 == 24 ? DM : 2 * DM));
#pragma unroll
        for (int ai = 0; ai < 2; ++ai)
#pragma unroll
            for (int mp = 0; mp < 2; ++mp) {
                u32x4 gq[2], hq[2];
#pragma unroll
                for (int mm = 0; mm < 2; ++mm) { const unsigned char* rp = (const unsigned char*)SG + (size_t)(row0 + ai * HALF + (mp * 2 + mm) * 16) * SGW + gc0 + u.pn * BM + wc * 64 + fq * 16;
                    gq[mm] = *(const u32x4*)rp; if (!lastbr) hq[mm] = *(const u32x4*)(rp + DM); }
#pragma unroll
                for (int mm = 0; mm < 2; ++mm) { const int m = mp * 2 + mm;
#pragma unroll
                    for (int bj = 0; bj < 2; ++bj) { u32x2 a; a.x = bj ? gq[mm].z : gq[mm].x; a.y = bj ? gq[mm].w : gq[mm].y; f32x4 g[2];
#define GB(w_, j_) fmaxf((float)(((w_) >> (8 * (j_))) & 0xffu), 1e-18f)
#pragma unroll
                        for (int j = 0; j < 4; ++j) { g[0][j] = GB(a.x, j); g[1][j] = GB(a.y, j); }
                        if (!lastbr) { u32x2 h; h.x = bj ? hq[mm].z : hq[mm].x; h.y = bj ? hq[mm].w : hq[mm].y;
#pragma unroll
                            for (int j = 0; j < 4; ++j) { g[0][j] *= __builtin_amdgcn_rcpf(GB(h.x, j)); g[1][j] *= __builtin_amdgcn_rcpf(GB(h.y, j)); }
                            acc[ai][bj][m][0] = acc[ai][bj][m][0] * g[0]; acc[ai][bj][m][1] = acc[ai][bj][m][1] * g[1];
                        } else { const f32x4 v0 = acc[ai][bj][m][0] * (g[0] * (1.0f / 255.0f)), v1 = acc[ai][bj][m][1] * (g[1] * (1.0f / 255.0f)); u32x4 w; w.x = cvt_pk_bf16(v0[0], v0[1]); w.y = cvt_pk_bf16(v0[2], v0[3]); w.z = cvt_pk_bf16(v1[0], v1[1]); w.w = cvt_pk_bf16(v1[2], v1[3]);
                            *(u32x4*)(MXB + (size_t)(row0 + ai * HALF + m * 16) * DM + col0 + bj * HALF) = w; } } }
                asm volatile("" ::: "memory"); }
#undef GB
    }
};
struct GateOrder {
    StaticOrder S;
    __host__ __device__ __forceinline__ bool next(int i, Unit& u) const { const int ti = i / 3, br = i - 3 * ti; const bool ok = S.next(ti, u); u.kt0 = br * 24; u.nt = br == 2 ? 16 : 24; return ok; }
    __device__ __forceinline__ void a_ready(const Unit&) const {}
    __device__ __forceinline__ void done(const Unit&) const {}
};

template <class Epi, class Sched, bool ALIGN_EPI = false, bool SP2 = false, bool FP8 = false>
__device__ __forceinline__ void gemm_phase(PG8_LAS unsigned char* lds, const Gemm g, const Sched& S, const Epi& E, int wv  ) {
    int tid_ = tid_of(wv);
    const int tid = tid_, wid = wv, lane = tid & 63, wr = wid >> 2, wc = wid & 3, fr = lane & 15, fq = lane >> 4;
    const int K = g.K;
    unsigned voffA[2], voffB[2];
#pragma unroll
    for (int i = 0; i < 2; ++i) { int R, C; stage_rc(tid * 16 + i * 8192, R, C); const int Rb = Epi::PERM ? ((R & ~31) + perm32(R & 31)) : R;
        voffA[i] = (unsigned)(R * K + C) * 2u; voffB[i] = (unsigned)(Rb * K + C) * 2u; }
    const size_t kstep = (size_t)(BK * 2);
    const size_t hstep = (size_t)HALF * K * 2;
    const size_t tstep = 2 * hstep;
    const unsigned ldsw = (unsigned)wid * 1024u;
    const int aoff = lds_byte(wr * 64 + fr, fq * 8), boff = lds_byte(wc * 32 + fr, fq * 8);
#define PG8_SA(b, h) (((b) * 2 + (h)) * HTB)
#define PG8_SB(b, h) ((4 + (b) * 2 + (h)) * HTB)
#define PG8_STAGE(bufoff, gbase, voff) do { _Pragma("unroll") for (int _i = 0; _i < 2; ++_i) { unsigned vo_ = (voff)[_i]; asm volatile("" : "+v"(vo_));     \
        __builtin_amdgcn_global_load_lds((const unsigned*)((const char*)(gbase) + vo_), (PG8_LAS unsigned*)(lds + (bufoff) + ldsw + _i * 8192), 16, 0, 0); } } while (0)
#define PG8_LDA(dst, b, h) do { _Pragma("unroll") for (int m = 0; m < 4; ++m) _Pragma("unroll") for (int k = 0; k < 2; ++k) dst[m][k] = *(const PG8_LAS bf16x8*)(lds + PG8_SA(b, h) + aoff + m * 2048 + k * 1024); } while (0)
#define PG8_LDB(dst, b, h) do { _Pragma("unroll") for (int n = 0; n < 2; ++n) _Pragma("unroll") for (int k = 0; k < 2; ++k) dst[n][k] = *(const PG8_LAS bf16x8*)(lds + PG8_SB(b, h) + boff + n * 2048 + k * 1024); } while (0)
#define PG8_CAT(x, y) __builtin_shufflevector(__builtin_bit_cast(i32x4, x), __builtin_bit_cast(i32x4, y), 0, 1, 2, 3, 4, 5, 6, 7)
#define PG8_MMA(ai, bj, At, Bt) do { __builtin_amdgcn_s_setprio(1); _Pragma("unroll") for (int m = 0; m < 4; ++m) _Pragma("unroll") for (int n = 0; n < 2; ++n) { \
        if constexpr (FP8) acc[ai][bj][m][n] = __builtin_amdgcn_mfma_scale_f32_16x16x128_f8f6f4(PG8_CAT(Bt[n][0], Bt[n][1]), PG8_CAT(At[m][0], At[m][1]), acc[ai][bj][m][n], 0, 0, 0, 0x7F7F7F7F, 0, 0x7F7F7F7F); \
        else { _Pragma("unroll") for (int k = 0; k < 2; ++k) acc[ai][bj][m][n] = __builtin_amdgcn_mfma_f32_16x16x32_bf16(Bt[n][k], At[m][k], acc[ai][bj][m][n], 0, 0, 0); } } __builtin_amdgcn_s_setprio(0); } while (0)
#define PG8_WAIT_V(n) asm volatile("s_waitcnt vmcnt(" #n ")" ::: "memory")
#define PG8_WAIT_L(n) asm volatile("s_waitcnt lgkmcnt(" #n ")" ::: "memory")
#define PG8_BAR __builtin_amdgcn_s_barrier()
#define PG8_SCHED __builtin_amdgcn_sched_barrier(0)
    Unit cur, nxt; int ui = 0;
    if (!S.next(0, cur)) return;
    f32x4 acc[2][2][4][2];
#pragma unroll
    for (int a = 0; a < 2; ++a)
#pragma unroll
        for (int b = 0; b < 2; ++b)
#pragma unroll
            for (int m = 0; m < 4; ++m)
#pragma unroll
                for (int n = 0; n < 2; ++n) acc[a][b][m][n] = (f32x4){0.f, 0.f, 0.f, 0.f};
    bf16x8 At[4][2], B0[2][2], B1[2][2];
    const char* cA = (const char*)g.A + (size_t)cur.pm * tstep + (size_t)cur.kt0 * kstep; const char* cB = (const char*)g.Bt + (size_t)cur.pn * tstep + (size_t)cur.kt0 * kstep;
    S.a_ready(cur);
    if constexpr (SP2) {
        PG8_STAGE(PG8_SB(0, 0), cB, voffB); PG8_STAGE(PG8_SB(0, 1), cB + hstep, voffB); PG8_STAGE(PG8_SA(0, 0), cA, voffA); PG8_STAGE(PG8_SA(0, 1), cA + hstep, voffA);
        if (wr == 1) PG8_BAR;
        PG8_WAIT_V(2); PG8_BAR;
        PG8_STAGE(PG8_SB(1, 0), cB + kstep, voffB); PG8_STAGE(PG8_SA(1, 0), cA + kstep, voffA); PG8_STAGE(PG8_SB(1, 1), cB + hstep + kstep, voffB);
        PG8_WAIT_V(6); PG8_BAR;
    } else {
        PG8_STAGE(PG8_SB(0, 0), cB, voffB); PG8_STAGE(PG8_SA(0, 0), cA, voffA); PG8_STAGE(PG8_SB(0, 1), cB + hstep, voffB); PG8_STAGE(PG8_SA(0, 1), cA + hstep, voffA);
        if (wr == 1) PG8_BAR;
        PG8_WAIT_V(4); PG8_BAR;
        PG8_STAGE(PG8_SB(1, 0), cB + kstep, voffB); PG8_STAGE(PG8_SA(1, 0), cA + kstep, voffA); PG8_STAGE(PG8_SB(1, 1), cB + hstep + kstep, voffB);
        PG8_WAIT_V(6); PG8_BAR;
    }
    for (;;) {
        const bool has_next = S.next(ui + 1, nxt);
        const char* nA = has_next ? (const char*)g.A + (size_t)nxt.pm * tstep + (size_t)nxt.kt0 * kstep : cA; const char* nB = has_next ? (const char*)g.Bt + (size_t)nxt.pn * tstep + (size_t)nxt.kt0 * kstep : cB;
        const int nt = cur.nt;
        for (int t = 0; t < nt; t += 2) {
            const bool last = (t == nt - 2);
            const char* a1 = cA + (size_t)(t + 1) * kstep;
            const char* a2 = last ? nA : cA + (size_t)(t + 2) * kstep; const char* b2 = last ? nB : cB + (size_t)(t + 2) * kstep;
            const char* a3 = a2 + kstep; const char* b3 = b2 + kstep;
            if (last && has_next) S.a_ready(nxt);
            if constexpr (SP2) {
            PG8_LDB(B0, 0, 0); PG8_LDB(B1, 0, 1); PG8_SCHED; PG8_LDA(At, 0, 0); PG8_STAGE(PG8_SA(1, 1), a1 + hstep, voffA);
            PG8_WAIT_V(8); PG8_WAIT_L(0); PG8_BAR; PG8_MMA(0, 0, At, B0); PG8_MMA(0, 1, At, B1); PG8_BAR; PG8_SCHED;
            PG8_LDA(At, 0, 1); PG8_STAGE(PG8_SB(0, 0), b2, voffB); PG8_STAGE(PG8_SB(0, 1), b2 + hstep, voffB); PG8_STAGE(PG8_SA(0, 0), a2, voffA);
            PG8_WAIT_V(8); PG8_WAIT_L(0); PG8_BAR; PG8_MMA(1, 0, At, B0); PG8_MMA(1, 1, At, B1); PG8_BAR; PG8_SCHED;
            PG8_LDB(B0, 1, 0); PG8_LDB(B1, 1, 1); PG8_SCHED; PG8_LDA(At, 1, 0); PG8_STAGE(PG8_SA(0, 1), a2 + hstep, voffA);
            PG8_WAIT_V(8); PG8_WAIT_L(0); PG8_BAR; PG8_MMA(0, 0, At, B0); PG8_MMA(0, 1, At, B1); PG8_BAR; PG8_SCHED;
            PG8_LDA(At, 1, 1); PG8_STAGE(PG8_SB(1, 0), b3, voffB); PG8_STAGE(PG8_SB(1, 1), b3 + hstep, voffB); PG8_STAGE(PG8_SA(1, 0), a3, voffA);
            PG8_WAIT_V(8); PG8_WAIT_L(0); PG8_BAR; PG8_MMA(1, 0, At, B0); PG8_MMA(1, 1, At, B1); PG8_BAR; PG8_SCHED;
            } else {
            PG8_LDB(B0, 0, 0); PG8_SCHED; PG8_LDA(At, 0, 0); PG8_STAGE(PG8_SA(1, 1), a1 + hstep, voffA);
            PG8_WAIT_L(8); PG8_BAR; PG8_WAIT_L(0); PG8_MMA(0, 0, At, B0); PG8_BAR; PG8_SCHED;
            PG8_LDB(B1, 0, 1); PG8_STAGE(PG8_SB(0, 0), b2, voffB);
            PG8_BAR; PG8_WAIT_L(0); PG8_MMA(0, 1, At, B1); PG8_BAR;
            PG8_LDA(At, 0, 1); PG8_STAGE(PG8_SA(0, 0), a2, voffA);
            PG8_BAR; PG8_WAIT_L(0); PG8_MMA(1, 0, At, B0); PG8_BAR; PG8_SCHED;
            PG8_STAGE(PG8_SB(0, 1), b2 + hstep, voffB);
            PG8_WAIT_V(6); PG8_BAR; PG8_MMA(1, 1, At, B1); PG8_BAR;
            PG8_LDB(B0, 1, 0); PG8_SCHED; PG8_LDA(At, 1, 0); PG8_STAGE(PG8_SA(0, 1), a2 + hstep, voffA);
            PG8_WAIT_L(8); PG8_BAR; PG8_WAIT_L(0); PG8_MMA(0, 0, At, B0); PG8_BAR; PG8_SCHED;
            PG8_LDB(B1, 1, 1); PG8_STAGE(PG8_SB(1, 0), b3, voffB);
            PG8_BAR; PG8_WAIT_L(0); PG8_MMA(0, 1, At, B1); PG8_BAR;
            PG8_LDA(At, 1, 1); PG8_STAGE(PG8_SA(1, 0), a3, voffA);
            PG8_BAR; PG8_WAIT_L(0); PG8_MMA(1, 0, At, B0); PG8_BAR; PG8_SCHED;
            PG8_STAGE(PG8_SB(1, 1), b3 + hstep, voffB);
            PG8_WAIT_V(6); PG8_BAR; PG8_MMA(1, 1, At, B1); PG8_BAR;
            }
        }
        if constexpr (ALIGN_EPI) { if (wr == 0) PG8_BAR; }
        if constexpr (!Epi::AFTER_DRAIN) { const int t_e = tid_of(wv); const int fr_e = t_e & 15, fq_e = (t_e & 63) >> 4;
            E(acc, cur, wr, wc, fr_e, fq_e); S.done(cur); }
        if (!has_next) break;
        if (!Epi::keep(cur))
#pragma unroll
        for (int a = 0; a < 2; ++a)
#pragma unroll
            for (int b = 0; b < 2; ++b)
#pragma unroll
                for (int m = 0; m < 4; ++m)
#pragma unroll
                    for (int n = 0; n < 2; ++n) acc[a][b][m][n] = (f32x4){0.f, 0.f, 0.f, 0.f};
        cur = nxt; cA = nA; cB = nB; ++ui;
        if constexpr (ALIGN_EPI) { if (wr == 1) PG8_BAR; }
    }
    PG8_WAIT_V(0);
    if constexpr (!ALIGN_EPI) { if (wr == 0) PG8_BAR; }
    PG8_BAR;
#undef PG8_SA
#undef PG8_SB
#undef PG8_STAGE
#undef PG8_LDA
#undef PG8_LDB
#undef PG8_MMA
#undef PG8_CAT
#undef PG8_WAIT_V
#undef PG8_WAIT_L
#undef PG8_BAR
#undef PG8_SCHED
}
}

namespace att {
using bf16x8 = __attribute__((ext_vector_type(8))) short;
using s16x4  = __attribute__((ext_vector_type(4))) short;
using f32x16 = __attribute__((ext_vector_type(16))) float;
using u32x4  = __attribute__((ext_vector_type(4))) unsigned;
constexpr int NW = 8, QBLK = 32, KVBLK = 64;
constexpr int SHM_V = 16384, SHM_K = 16384;
constexpr int OFF_V = 0, OFF_K = 2 * SHM_V, OFF_WS = OFF_K + 2 * SHM_K, OFF_BIAS = OFF_WS + 2048, OFF_SLOT = OFF_BIAS + 2048, ATT_LDS = OFF_SLOT + 64;
constexpr float THR = 8.f;
constexpr int LD = QKVW;
#define KSWZ128(row, colB) ((row) * 256 + ((colB) ^ (((row) & 7) << 4)))
#define KSWZ64(row, colB) ((row) * 128 + ((colB) ^ ((((row) >> 1) & 7) << 4)))
#define SBAR() __builtin_amdgcn_sched_barrier(0)
__device__ __forceinline__ int crow(int r, int hi) { return (r & 3) + 8 * (r >> 2) + 4 * hi; }
__device__ __forceinline__ unsigned cvtpk(float lo, float hi) { unsigned r; asm volatile("v_cvt_pk_bf16_f32 %0, %1, %2" : "=v"(r) : "v"(lo), "v"(hi)); return r; }

struct Unit {
    const u16* Q;
    const u16* K;
    const u16* V;
    u16* O; int ldo;
    int NT, n0, base0, base1;
    int r0, first;
    const float* qgain;
    const float* qrope; int t0;
};

template <int DQK>
__device__ __forceinline__ void partialSM(f32x16& p0, f32x16& p1, float& m_reg, float& mn, float& alpha) {
  constexpr float SCALE = DQK == 128 ? 0.08838834764831845f : 0.125f;
  constexpr float C = SCALE * 1.4426950408889634f;
  float pmax = p0[0];
#pragma unroll
  for (int r = 1; r < 16; ++r) pmax = fmaxf(pmax, p0[r]);
#pragma unroll
  for (int r = 0; r < 16; ++r) pmax = fmaxf(pmax, p1[r]);
  { auto rr = __builtin_amdgcn_permlane32_swap(__float_as_uint(pmax), __float_as_uint(pmax), false, false);
    pmax = fmaxf(__uint_as_float(rr[0]), __uint_as_float(rr[1])); }
  if (__builtin_expect(__all(pmax - m_reg <= THR / SCALE), 1)) { mn = m_reg; alpha = 1.f; }
  else { mn = fmaxf(m_reg, pmax); alpha = __builtin_amdgcn_exp2f((m_reg - mn) * C); m_reg = mn; }
  float mnC = -mn * C;
#pragma unroll
  for (int r = 0; r < 16; ++r) p0[r] = fmaf(p0[r], C, mnC);
#pragma unroll
  for (int r = 0; r < 16; ++r) p1[r] = fmaf(p1[r], C, mnC);
#pragma unroll
  for (int r = 0; r < 16; ++r) p0[r] = __builtin_amdgcn_exp2f(p0[r]);
}
__device__ __forceinline__ void finishSM(f32x16& p0, f32x16& p1, float alpha, float& l_reg, bf16x8& pa0, bf16x8& pa1, bf16x8& pa2, bf16x8& pa3) {
#pragma unroll
  for (int r = 0; r < 16; ++r) p1[r] = __builtin_amdgcn_exp2f(p1[r]);
  float ps = 0;
#pragma unroll
  for (int r = 0; r < 16; ++r) ps += p0[r];
#pragma unroll
  for (int r = 0; r < 16; ++r) ps += p1[r];
  { auto rr = __builtin_amdgcn_permlane32_swap(__float_as_uint(ps), __float_as_uint(ps), false, false);
    ps = __uint_as_float(rr[0]) + __uint_as_float(rr[1]); }
  l_reg = l_reg * alpha + ps;
#define PK4(P, BASE, OUT) do { unsigned a0 = cvtpk(P[BASE + 0], P[BASE + 1]), a1 = cvtpk(P[BASE + 2], P[BASE + 3]);   \
    unsigned b0 = cvtpk(P[BASE + 4], P[BASE + 5]), b1 = cvtpk(P[BASE + 6], P[BASE + 7]);                              \
    auto r0 = __builtin_amdgcn_permlane32_swap(a0, b0, false, false); auto r1 = __builtin_amdgcn_permlane32_swap(a1, b1, false, false); \
    u32x4 w = {r0[0], r1[0], r0[1], r1[1]}; OUT = *reinterpret_cast<bf16x8*>(&w); } while (0)
  PK4(p0, 0, pa0); PK4(p0, 8, pa1); PK4(p1, 0, pa2); PK4(p1, 8, pa3);
#undef PK4
}
template <int DQK>
__device__ __forceinline__ void qkt(f32x16& p0, f32x16& p1, const char* Ks, const bf16x8* qr, int r32, int hi) {
  p0 = f32x16{}; p1 = f32x16{};
#pragma unroll
  for (int d0 = 0; d0 < DQK / 16; ++d0) { const int cb = (d0 * 16 + hi * 8) * 2;
    bf16x8 b0, b1;
    if constexpr (DQK == 128) { b0 = *reinterpret_cast<const bf16x8*>(Ks + KSWZ128(r32, cb)); b1 = *reinterpret_cast<const bf16x8*>(Ks + KSWZ128(32 + r32, cb)); }
    else                      { b0 = *reinterpret_cast<const bf16x8*>(Ks + KSWZ64(r32, cb));  b1 = *reinterpret_cast<const bf16x8*>(Ks + KSWZ64(32 + r32, cb)); }
    p0 = __builtin_amdgcn_mfma_f32_32x32x16_bf16(b0, qr[d0], p0, 0, 0, 0);
    p1 = __builtin_amdgcn_mfma_f32_32x32x16_bf16(b1, qr[d0], p1, 0, 0, 0); }
}
__device__ __forceinline__ int v_st(int k, int c) { const int kk = (k & ~0xC) | ((k & 4) << 1) | ((k & 8) >> 1); return ((kk >> 3) * 4 + (c >> 5)) * 512 + ((kk & 7) * 32 + (c & 31)) * 2; }
__device__ __forceinline__ int v_rd_base(int lane) { return ((lane & 3) << 3) | (((lane >> 2) & 3) << 6) | (((lane >> 4) & 1) << 5) | (((lane >> 5) & 1) << 8); }
constexpr int v_rd_off(int d0, int ks, int half) { return d0 * 512 + ks * 4096 + half * 2048; }
template <int OFF> __device__ __forceinline__ s16x4 tr_read(int vb) {
  s16x4 r; asm volatile("ds_read_b64_tr_b16 %0, %1 offset:%2" : "=&v"(r) : "v"(vb), "i"(OFF) : "memory"); return r;
}
template <int D0> __device__ __forceinline__ void pv_one(f32x16& od, int vb, bf16x8 pa0, bf16x8 pa1, bf16x8 pa2, bf16x8 pa3) {
  const s16x4 l0 = tr_read<v_rd_off(D0, 0, 0)>(vb), h0 = tr_read<v_rd_off(D0, 0, 1)>(vb), l1 = tr_read<v_rd_off(D0, 1, 0)>(vb), h1 = tr_read<v_rd_off(D0, 1, 1)>(vb);
  const s16x4 l2 = tr_read<v_rd_off(D0, 2, 0)>(vb), h2 = tr_read<v_rd_off(D0, 2, 1)>(vb), l3 = tr_read<v_rd_off(D0, 3, 0)>(vb), h3 = tr_read<v_rd_off(D0, 3, 1)>(vb);
  asm volatile("s_waitcnt lgkmcnt(0)" ::: "memory"); SBAR();
#define PK(L, H) (bf16x8){L[0], L[1], L[2], L[3], H[0], H[1], H[2], H[3]}
  od = __builtin_amdgcn_mfma_f32_32x32x16_bf16(pa0, PK(l0, h0), od, 0, 0, 0);
  od = __builtin_amdgcn_mfma_f32_32x32x16_bf16(pa1, PK(l1, h1), od, 0, 0, 0);
  od = __builtin_amdgcn_mfma_f32_32x32x16_bf16(pa2, PK(l2, h2), od, 0, 0, 0);
  od = __builtin_amdgcn_mfma_f32_32x32x16_bf16(pa3, PK(l3, h3), od, 0, 0, 0);
#undef PK
}
__device__ __forceinline__ void pv_d0(f32x16* o, int vb, bf16x8 pa0, bf16x8 pa1, bf16x8 pa2, bf16x8 pa3) {
  pv_one<0>(o[0], vb, pa0, pa1, pa2, pa3); pv_one<1>(o[1], vb, pa0, pa1, pa2, pa3); pv_one<2>(o[2], vb, pa0, pa1, pa2, pa3); pv_one<3>(o[3], vb, pa0, pa1, pa2, pa3);
}

template <int DQK, int MODE, int SD>
__device__ __forceinline__ void attn_unit(const Unit& U, char* lds, int wv) {
  constexpr int ND = DQK / 16;
  int tid_ = tid_of(wv);
  const int tid = tid_, wid = wv, lane = tid & 63, r32 = lane & 31, hi = lane >> 5;
  char* V_lds = lds + OFF_V; char* K_lds = lds + OFF_K;
  float* ws = (float*)(lds + OFF_WS) + wid * 64; float* li_l = ws; float* al_l = ws + 32;
  const float* biasq = (const float*)(lds + OFF_BIAS);
  float m_reg = -1e30f, l_reg = 0; f32x16 o[4] = {}; bf16x8 qr[ND];
  { const char* Qw = (const char*)U.Q + (unsigned)(((wid * QBLK + r32) * LD + hi * 8) * 2);
#pragma unroll
    for (int d0 = 0; d0 < ND; ++d0) qr[d0] = *reinterpret_cast<const bf16x8*>(Qw + d0 * 32);
    float ssq = 0.f;
#pragma unroll
    for (int d0 = 0; d0 < ND; ++d0) { const u32x4 w = *reinterpret_cast<const u32x4*>(&qr[d0]);
#pragma unroll
      for (int e = 0; e < 4; ++e) { const float a = bf_lo(w[e]), b = bf_hi(w[e]); ssq += a * a + b * b; } }
    { auto rr = __builtin_amdgcn_permlane32_swap(__float_as_uint(ssq), __float_as_uint(ssq), false, false); ssq = __uint_as_float(rr[0]) + __uint_as_float(rr[1]); }
    const float rstdq = 1.0f / sqrtf(ssq * (1.0f / DQK) + EPS);
    const int tq = U.t0 + wid * QBLK + r32, gq = (tq >> 6) & 63, cq = tq & 63; constexpr int NP = DQK / 4;
#pragma unroll
    for (int d0 = 0; d0 < ND; ++d0) { const u32x4 w = *reinterpret_cast<const u32x4*>(&qr[d0]); const int dd = d0 * 16 + hi * 8;
      const f32x4 g0 = *(const f32x4*)(U.qgain + dd), g1 = *(const f32x4*)(U.qgain + dd + 4);
      float x[8]; x[0] = bf_lo(w[0]) * rstdq * g0[0]; x[1] = bf_hi(w[0]) * rstdq * g0[1]; x[2] = bf_lo(w[1]) * rstdq * g0[2]; x[3] = bf_hi(w[1]) * rstdq * g0[3];
      x[4] = bf_lo(w[2]) * rstdq * g1[0]; x[5] = bf_hi(w[2]) * rstdq * g1[1]; x[6] = bf_lo(w[3]) * rstdq * g1[2]; x[7] = bf_hi(w[3]) * rstdq * g1[3];
      if (U.qrope != nullptr) { const int i0 = dd >> 1; const float* tp = U.qrope + 2 * ((i0 < NP) ? gq * NP + i0 : cq * NP + i0 - NP);
        const f32x4 c01 = *(const f32x4*)tp, c23 = *(const f32x4*)(tp + 4); float y;
        y = x[0] * c01[0] - x[1] * c01[1]; x[1] = x[0] * c01[1] + x[1] * c01[0]; x[0] = y;
        y = x[2] * c01[2] - x[3] * c01[3]; x[3] = x[2] * c01[3] + x[3] * c01[2]; x[2] = y;
        y = x[4] * c23[0] - x[5] * c23[1]; x[5] = x[4] * c23[1] + x[5] * c23[0]; x[4] = y;
        y = x[6] * c23[2] - x[7] * c23[3]; x[7] = x[6] * c23[3] + x[7] * c23[2]; x[6] = y; }
      u32x4 o = {cvtpk(x[0], x[1]), cvtpk(x[2], x[3]), cvtpk(x[4], x[5]), cvtpk(x[6], x[7])}; qr[d0] = *reinterpret_cast<bf16x8*>(&o); } }
  const int sr = tid >> 4, sc = (tid & 15) * 8, vst0 = v_st(sr, sc), vst1 = v_st(32 + sr, sc);
  const int kr64 = tid >> 3, kc64 = (tid & 7) * 8;
  const unsigned gofs = (unsigned)((sr * LD + sc) * 2), gofs64 = (unsigned)((kr64 * LD + kc64) * 2);
  const int vb0 = (int)(uintptr_t)V_lds + v_rd_base(lane);
  struct { bf16x8 vs0, vs1, ks0, ks1; } sr_[SD];
  const int n0 = U.n0, base0 = U.base0, base1 = U.base1;
#define TROW(j) ((j) < n0 ? base0 + 64 * (j) : base1 + 64 * ((j) - n0))
#define SLOAD(i, j) do { const size_t tb_ = (size_t)(TROW(j)) * (LD * 2); const char* vp_ = (const char*)U.V + tb_; const char* kp_ = (const char*)U.K + tb_; \
    sr_[i].vs0 = *reinterpret_cast<const bf16x8*>(vp_ + gofs); sr_[i].vs1 = *reinterpret_cast<const bf16x8*>(vp_ + 32 * LD * 2 + gofs); \
    if constexpr (DQK == 128) { sr_[i].ks0 = *reinterpret_cast<const bf16x8*>(kp_ + gofs); sr_[i].ks1 = *reinterpret_cast<const bf16x8*>(kp_ + 32 * LD * 2 + gofs); } \
    else { sr_[i].ks0 = *reinterpret_cast<const bf16x8*>(kp_ + gofs64); } } while (0)
#define SWRITE(b, i) do { *(bf16x8*)(V_lds + (b) * SHM_V + vst0) = sr_[i].vs0; *(bf16x8*)(V_lds + (b) * SHM_V + vst1) = sr_[i].vs1; \
    if constexpr (DQK == 128) { const int kc = sc * 2; *(bf16x8*)(K_lds + (b) * SHM_K + KSWZ128(sr, kc)) = sr_[i].ks0; *(bf16x8*)(K_lds + (b) * SHM_K + KSWZ128(32 + sr, kc)) = sr_[i].ks1; } \
    else { *(bf16x8*)(K_lds + (b) * SHM_K + KSWZ64(kr64, kc64 * 2)) = sr_[i].ks0; } } while (0)
#define SWAIT() do { if constexpr (SD == 1) asm volatile("s_waitcnt vmcnt(0)" ::: "memory"); else if constexpr (DQK == 128) asm volatile("s_waitcnt vmcnt(4)" ::: "memory"); else asm volatile("s_waitcnt vmcnt(3)" ::: "memory"); } while (0)
#define RESC(a) do { if (__any((a) < 1.f)) { if (hi == 0) al_l[r32] = (a); asm volatile("s_waitcnt lgkmcnt(0)" ::: "memory"); \
    _Pragma("unroll") for (int d = 0; d < 4; ++d) _Pragma("unroll") for (int r = 0; r < 16; ++r) o[d][r] *= al_l[crow(r, hi)]; } } while (0)
#define MASK(P0, P1, j) do { if constexpr (MODE == 1) { if ((j) >= n0) { const int kr_ = U.first + ((j) - n0); \
      const int qgr_ = U.r0 + (wid >> 1), qc_ = 32 * (wid & 1) + r32, rs_ = min(max(qgr_ - 4, 0), 56), cs_ = min(max(qc_ - 8, 0), 48); \
      if ((unsigned)(kr_ - rs_) < 8u) { const float* brow_ = biasq + (kr_ - qgr_ + 7) * 31 + 15 - qc_; \
        _Pragma("unroll") for (int r = 0; r < 16; ++r) { const int kc_ = crow(r, hi); \
          P0[r] = ((unsigned)(kc_ - cs_) < 16u) ? P0[r] + brow_[kc_] : -__builtin_inff(); \
          P1[r] = ((unsigned)(kc_ + 32 - cs_) < 16u) ? P1[r] + brow_[kc_ + 32] : -__builtin_inff(); } } \
      else { _Pragma("unroll") for (int r = 0; r < 16; ++r) { P0[r] = -__builtin_inff(); P1[r] = -__builtin_inff(); } } } } } while (0)
  f32x16 pA0, pA1, pB0, pB1; float mnA, mnB, alA, alB; bf16x8 pa0, pa1, pa2, pa3; const int NT = U.NT;
  constexpr int SE = 0, SO = SD - 1;
  SLOAD(SE, 0); asm volatile("s_waitcnt vmcnt(0)" ::: "memory"); SWRITE(0, SE); __syncthreads();
  qkt<DQK>(pA0, pA1, K_lds, qr, r32, hi); MASK(pA0, pA1, 0); partialSM<DQK>(pA0, pA1, m_reg, mnA, alA);
  SLOAD(SO, 1); if constexpr (SD == 2) { if (2 < NT) SLOAD(SE, 2); }
  SWAIT(); SWRITE(1, SO); __syncthreads();
  for (int j = 1; j + 1 < NT; j += 2) {
    SBAR(); qkt<DQK>(pB0, pB1, K_lds + SHM_K, qr, r32, hi);
    finishSM(pA0, pA1, alA, l_reg, pa0, pa1, pa2, pa3); SBAR();
    SLOAD(SO, j + SD); SBAR();
    pv_d0(o, vb0, pa0, pa1, pa2, pa3); MASK(pB0, pB1, j); partialSM<DQK>(pB0, pB1, m_reg, mnB, alB);
    __syncthreads(); SWAIT(); SWRITE(0, SE);
    RESC(alB); __syncthreads();
    SBAR(); qkt<DQK>(pA0, pA1, K_lds, qr, r32, hi);
    finishSM(pB0, pB1, alB, l_reg, pa0, pa1, pa2, pa3); SBAR();
    if (SD == 1 || j + 3 < NT) SLOAD(SE, j + 1 + SD); SBAR();
    pv_d0(o, vb0 + SHM_V, pa0, pa1, pa2, pa3); MASK(pA0, pA1, j + 1); partialSM<DQK>(pA0, pA1, m_reg, mnA, alA);
    __syncthreads(); SWAIT(); SWRITE(1, SO);
    RESC(alA); __syncthreads();
  }
  SBAR(); qkt<DQK>(pB0, pB1, K_lds + SHM_K, qr, r32, hi);
  finishSM(pA0, pA1, alA, l_reg, pa0, pa1, pa2, pa3); SBAR();
  pv_d0(o, vb0, pa0, pa1, pa2, pa3); MASK(pB0, pB1, NT - 1); partialSM<DQK>(pB0, pB1, m_reg, mnB, alB);
  __syncthreads(); RESC(alB);
  finishSM(pB0, pB1, alB, l_reg, pa0, pa1, pa2, pa3); SBAR();
  pv_d0(o, vb0 + SHM_V, pa0, pa1, pa2, pa3);
  if (hi == 0) li_l[r32] = l_reg; asm volatile("s_waitcnt lgkmcnt(0)" ::: "memory");
  char* Ow = (char*)U.O + (size_t)(wid * QBLK) * U.ldo * 2;
  __syncthreads();
  { char* Os = lds + wid * 8192;
#pragma unroll
    for (int r = 0; r < 16; ++r) { const int orow = crow(r, hi); const float rl = __builtin_amdgcn_rcpf(li_l[orow]);
#pragma unroll
      for (int d0 = 0; d0 < 4; ++d0) *(u16*)(Os + orow * 256 + (d0 * 32 + r32) * 2) = (u16)f2bf(o[d0][r] * rl); }
    asm volatile("s_waitcnt lgkmcnt(0)" ::: "memory");
#pragma unroll
    for (int i = 0; i < 8; ++i) { const int row = i * 4 + (lane >> 4); const v4u v = *(const v4u*)(Os + row * 256 + (lane & 15) * 16); *(v4u*)(Ow + (size_t)row * U.ldo * 2 + (lane & 15) * 16) = v; } }
#undef TROW
#undef SLOAD
#undef SWRITE
#undef SWAIT
#undef RESC
#undef MASK
}
#undef SBAR
}

constexpr size_t MiB = 1u << 20;
constexpr size_t al1(size_t x) { return (x + MiB - 1) / MiB * MiB; }
constexpr size_t WS_CTL = 0, CTL_ZERO_BYTES = 8 * MiB;
constexpr size_t WS_MOD = 1 * MiB;
constexpr size_t WS_ROWSS = 2 * MiB;
constexpr size_t WS_SW = 4 * MiB;
constexpr int SW_STRIDE = 3 * INW;
constexpr size_t WS_MISC = 8 * MiB;
constexpr size_t WS_XC = 9 * MiB;
constexpr size_t WS_HN = WS_XC + al1((size_t)NB * CTXL * DM * 4);
constexpr size_t WS_HD = WS_HN + al1((size_t)MROWS * DM * 2);
constexpr size_t WS_QKV = WS_HD + al1((size_t)MROWS * FFN * 2);
constexpr size_t WS_SG = WS_QKV + al1((size_t)MROWS * QKVW * 2);
constexpr size_t WS_OCAT = WS_SG + al1((size_t)MROWS * SGW * 2);
constexpr size_t WS_OCR = WS_OCAT + al1((size_t)MROWS * DM * 2);
constexpr size_t WS_MX = WS_OCR + al1((size_t)MROWS * 2048 * 2);
constexpr size_t WS_MXB = WS_MX + al1((size_t)MROWS * DM * 4);
constexpr size_t WS_PART = WS_MXB + al1((size_t)MROWS * DM * 2);
constexpr size_t WS_W = WS_PART + al1((size_t)8 * NB * CTXL * DM * 4);
constexpr size_t WO_1IN = 0, WO_1OUT = WO_1IN + (size_t)2 * FFN * DM * 2, WO_2IN = WO_1OUT + (size_t)DM * FFN * 2, WO_2OUT = WO_2IN + (size_t)2 * FFN * DM * 2,
                 WO_IN = WO_2OUT + (size_t)DM * FFN * 2, WO_BR = WO_IN + (size_t)INW * DM * 2  ,
                 WO_OUT = WO_BR + (size_t)DM * DM * 2, W_LAYER = WO_OUT + (size_t)DM * DM * 2;
constexpr size_t WS_W8 = WS_W + DEPTH * W_LAYER;
constexpr size_t W8_LAYER = (size_t)INW * DM;
constexpr size_t WS_XG8 = WS_W8 + DEPTH * W8_LAYER;
constexpr size_t WS_END = WS_XG8 + al1((size_t)MROWS * DM);
static_assert((WS_XG8 & (MiB - 1)) == 0 && WS_ROWSS + (size_t)DEPTH * 3 * MROWS * 4 <= WS_SW && WS_SW + (size_t)DEPTH * 3 * SW_STRIDE * 4 <= CTL_ZERO_BYTES && WS_MX == pg8::EpiResid::WS_XP_OFF && WS_PART == pg8::EpiResid::WS_PART_OFF && WS_HN == pg8::EpiResid::WS_HN_OFF && WS_MOD + (size_t)DEPTH * 3 * MODW * 4 < ((size_t)1 << 32), "EpiResid's workspace offsets");
constexpr int MI_TA = 0, MI_TC = 64 * 32 * 2, MI_LAM = MI_TC + 64 * 16 * 2;
constexpr int CW_TMO = 0, CW_BAR = 4096, CW_ATTQ = 16384;

constexpr int RING_OFF = 0, RING_BYTES = 131072;
constexpr int LDSCTL_OFF = RING_BYTES, MISC_OFF = LDSCTL_OFF + 320;
constexpr int LDS_BYTES = 147456;
constexpr int NWAVES = 8;

#define XB_TMO      128
#define XB_XCNT(j)  (256  + 64 * (j))
#define XB_XSUB(j)  (1280 + 64 * (j))
#define XB_XGEN(j)  (2304 + 64 * (j))
#define XB_TOP      3328
#define XB_TOPGEN   3392
#define XCD_BAR_WORDS 3456
#define XB_SPIN_CAP (1u << 18)

__device__ __forceinline__ unsigned xb_ld(unsigned* p)              { return __hip_atomic_load(p, __ATOMIC_RELAXED, __HIP_MEMORY_SCOPE_AGENT); }
__device__ __forceinline__ unsigned xb_add(unsigned* p, unsigned v) { return __hip_atomic_fetch_add(p, v, __ATOMIC_RELAXED, __HIP_MEMORY_SCOPE_AGENT); }
__device__ __forceinline__ unsigned xb_xcc_id() { return (unsigned)__builtin_amdgcn_s_getreg((3 << 11) | 20) & 0xFu; }
#define XB_SPIN(cond, bar) do { unsigned _sp = 0; while (cond) { __builtin_amdgcn_s_sleep(1); \
    if ((++_sp & 255u) == 0u) { if (xb_ld(&(bar)[XB_TMO])) break; if (_sp > XB_SPIN_CAP) { atomicAdd(&(bar)[XB_TMO], 1u); break; } } } } while (0)

struct XcdBarrier {
    unsigned* bar; unsigned x;
    volatile LAS unsigned* st;
};
__device__ __forceinline__ XcdBarrier xcd_barrier_post(unsigned* bar, volatile LAS unsigned* st, bool lead  ) {
    XcdBarrier b; b.bar = bar; b.x = xb_xcc_id(); b.st = st;
    if (lead) (void)xb_add(&bar[XB_XCNT(b.x)], 1u);
    return b;
}
__device__ __forceinline__ void xcd_barrier_complete(unsigned* bar, unsigned x, unsigned& nloc, unsigned& nx) {
    const unsigned G = gridDim.x * gridDim.y * gridDim.z;
    unsigned sum, cnt, mine, sp = 0u;
    for (;;) {
        sum = 0u; cnt = 0u; mine = 0u;
#pragma unroll
        for (unsigned j = 0; j < 16; ++j) { const unsigned c = xb_ld(&bar[XB_XCNT(j)]); sum += c; cnt += (c > 0u) ? 1u : 0u; mine = (j == x) ? c : mine; }
        if (sum == G) break;
        __builtin_amdgcn_s_sleep(1);
        if ((++sp & 255u) == 0u) { if (xb_ld(&bar[XB_TMO])) break; if (sp > XB_SPIN_CAP) { atomicAdd(&bar[XB_TMO], 1u); break; } }
    }
    nloc = mine > 0u ? mine : 1u; nx = cnt > 0u ? cnt : 1u;
}
__device__ __forceinline__ void xcd_barrier(const XcdBarrier& b, bool lead  ) {
    asm volatile("s_waitcnt vmcnt(0)" ::: "memory");
    __syncthreads();
    if (lead) {
        unsigned* bar = b.bar;
        __builtin_amdgcn_s_waitcnt(0);
        unsigned nloc = b.st[0], nx = b.st[1];
        if (nloc == 0u) { xcd_barrier_complete(bar, b.x, nloc, nx); b.st[0] = nloc; b.st[1] = nx; }
        const unsigned old = xb_add(&bar[XB_XSUB(b.x)], 1u);
        const unsigned gen = old / nloc;
        if (old + 1u == (gen + 1u) * nloc) {
            __builtin_amdgcn_fence(__ATOMIC_RELEASE, "agent");
            asm volatile("s_waitcnt vmcnt(0)" ::: "memory");
            const unsigned og = xb_add(&bar[XB_TOP], 1u);
            const unsigned tg = og / nx;
            if (og + 1u == (tg + 1u) * nx) xb_add(&bar[XB_TOPGEN], 1u);
            else XB_SPIN(xb_ld(&bar[XB_TOPGEN]) == tg, bar);
            __builtin_amdgcn_fence(__ATOMIC_ACQUIRE, "agent");
            xb_add(&bar[XB_XGEN(b.x)], 1u);
            asm volatile("s_waitcnt vmcnt(0)" ::: "memory");
        } else {
            XB_SPIN(xb_ld(&bar[XB_XGEN(b.x)]) == gen, bar);
            __builtin_amdgcn_fence(__ATOMIC_ACQUIRE, "agent");
            asm volatile("s_waitcnt vmcnt(0)" ::: "memory");
        }
    }
    __syncthreads();
}

struct Args {
    const float* in[22];
    float* out; unsigned char* ws;
    int ph_lo, ph_hi;
};
struct Frame {
    LAS unsigned char* lds;
    volatile LAS unsigned* MISC;
    gu32* ctl;
    int tid, lane, wave, vcu, G;
};
template <int X> __device__ __forceinline__ float swz_xor(float v) { return __builtin_bit_cast(float, __builtin_amdgcn_ds_swizzle(__builtin_bit_cast(int, v), (X << 10) | 0x1f)); }
__device__ __forceinline__ float sum16(float v) { v += swz_xor<1>(v); v += swz_xor<2>(v); v += swz_xor<4>(v); v += swz_xor<8>(v); return v; }
__device__ __forceinline__ float sum8(float v) { v += swz_xor<1>(v); v += swz_xor<2>(v); v += swz_xor<4>(v); return v; }
__device__ __forceinline__ float wave_sum(float v) {
    v = sum16(v); v += swz_xor<16>(v);
    const float lo = __builtin_bit_cast(float, __builtin_amdgcn_readlane(__builtin_bit_cast(int, v), 0)), hi = __builtin_bit_cast(float, __builtin_amdgcn_readlane(__builtin_bit_cast(int, v), 32));
    return lo + hi;
}
template <int NKB>
__device__ __forceinline__ void p0_transpose_item(const float* W, int K, int Nsrc, u16* WT, int Kdst, int nblk, int smap, LAS float* scr, int item, int lane, const float* shift, float* sw, int Nsw, unsigned char* W8 = nullptr) {
    const int kbg = item / nblk, nb = item - kbg * nblk, n0 = 32 * nb;
    const int s0 = smap ? (((n0 & 255) >> 7) * FFN + (n0 >> 8) * 128 + (n0 & 127)) : n0;
    float a0 = 0.f, a1 = 0.f, a2 = 0.f;
    for (int kq = 0; kq < NKB; ++kq) {
        const int k0 = 64 * (kbg * NKB + kq);
        { f32x4 v[8];
#pragma unroll
          for (int i = 0; i < 8; ++i) v[i] = __builtin_nontemporal_load((const f32x4*)(W + (size_t)(k0 + 8 * i + (lane >> 3)) * Nsrc + s0 + (lane & 7) * 4));
#pragma unroll
          for (int i = 0; i < 8; ++i) { LAS float* d = scr + (8 * i + (lane >> 3)) * 33 + (lane & 7) * 4; d[0] = v[i].x; d[1] = v[i].y; d[2] = v[i].z; d[3] = v[i].w; } }
        if (NKB > 1) { scr[2112 + lane] = shift[k0 + lane]; scr[2176 + lane] = shift[MODW + k0 + lane]; scr[2240 + lane] = shift[2 * MODW + k0 + lane]; }
        LDS_WAIT(); asm volatile("" ::: "memory");
        const int c = lane & 7;
#pragma unroll
        for (int j = 0; j < 4; ++j) { const int n = (lane >> 3) + 8 * j; const LAS float* s = scr + (8 * c) * 33 + n;
            if (W8 != nullptr) {
                v2u o; o.x = pk4_fp8(s[0 * 33] * 64.f, s[1 * 33] * 64.f, s[2 * 33] * 64.f, s[3 * 33] * 64.f); o.y = pk4_fp8(s[4 * 33] * 64.f, s[5 * 33] * 64.f, s[6 * 33] * 64.f, s[7 * 33] * 64.f);
                *(GAS v2u*)(W8 + (size_t)(n0 + n) * Kdst + k0 + 8 * c) = o;
            } else {
            v4u o; o.x = pk2(s[0 * 33], s[1 * 33]); o.y = pk2(s[2 * 33], s[3 * 33]); o.z = pk2(s[4 * 33], s[5 * 33]); o.w = pk2(s[6 * 33], s[7 * 33]);
            *(GAS v4u*)(WT + (size_t)(n0 + n) * Kdst + k0 + 8 * c) = o; } }
        if (NKB > 1) { const int n = lane & 31, kh = 32 * (lane >> 5);
#pragma unroll 8
            for (int kk = 0; kk < 32; ++kk) { const float w = scr[(kh + kk) * 33 + n]; a0 += w * scr[2112 + kh + kk]; a1 += w * scr[2176 + kh + kk]; a2 += w * scr[2240 + kh + kk]; } }
        LDS_WAIT(); asm volatile("" ::: "memory");
    }
    if (NKB > 1) { float* o = sw + n0 + (lane & 31); unsafeAtomicAdd(o, a0); unsafeAtomicAdd(o + Nsw, a1); unsafeAtomicAdd(o + 2 * Nsw, a2); }
}
__device__ __forceinline__ void p0_ada_item(const float* c, const float* c_ctx, const float* w_ada, const float* b_ada, float* MOD, LAS float* scr, int item, int lane) {
    const int l = item / (32 * 144), r = item - l * (32 * 144), kc = r / 144, cg = r - kc * 144, k0 = kc * 128, col = cg * 256 + lane * 4;
#pragma unroll
    for (int i = 0; i < 2; ++i) { const int k = k0 + i * 64 + lane;
        const float a = c[k], b = c[DM + k], d = c_ctx[k];
        scr[i * 64 + lane] = a * fast_sigmoid(a); scr[256 + i * 64 + lane] = b * fast_sigmoid(b); scr[512 + i * 64 + lane] = d * fast_sigmoid(d); }
    LDS_WAIT(); asm volatile("" ::: "memory");
    const float* wp = w_ada + (size_t)l * DM * MODW + (size_t)k0 * MODW + col;
    f32x4 a0 = {0.f, 0.f, 0.f, 0.f}, a1 = a0, a2 = a0;
#pragma unroll 8
    for (int k = 0; k < 128; ++k) { const f32x4 w = __builtin_nontemporal_load((const f32x4*)(wp + (size_t)k * MODW)); a0 += w * scr[k]; a1 += w * scr[256 + k]; a2 += w * scr[512 + k]; }
    if (kc == 0) { const f32x4 bv = *(const f32x4*)(b_ada + (size_t)l * MODW + col); a0 += bv; a1 += bv; a2 += bv; }
    float* m = MOD + (size_t)l * 3 * MODW + col;
#pragma unroll
    for (int j = 0; j < 4; ++j) { unsafeAtomicAdd(m + j, a0[j]); unsafeAtomicAdd(m + MODW + j, a1[j]); unsafeAtomicAdd(m + 2 * MODW + j, a2[j]); }
    LDS_WAIT(); asm volatile("" ::: "memory");
}

__device__ __forceinline__ void modnorm_phase(const Frame& F, const float* xl, const float* xc, const float* g, const float* modl  , int sub, u16* HN, float* xc_copy  ,
                                              const float* part  , const float* pgate, float pcoef, float* xc_out, float* rowss, bool ctx_only  , unsigned char* hn8  ) {
    const int gw = F.vcu * NWAVES + F.wave, NGW = F.G * NWAVES;
    for (int it = gw; it < (ctx_only ? NB * CTXL : MROWS); it += NGW) {
        const int row = ctx_only ? (it / CTXL) * TPB + SEQ + it % CTXL : it;
        const int b = row / TPB, t = row - b * TPB; const bool isc = t >= SEQ;
        const float* xr = isc ? xc + (size_t)(b * CTXL + t - SEQ) * DM : xl + (size_t)(b * SEQ + t) * DM;
        const float* mv = modl + (size_t)(isc ? 2 : b) * MODW + (size_t)(3 * sub) * DM;
        f32x4 v[16]; float ss = 0.f;
#pragma unroll
        for (int j = 0; j < 16; ++j) { v[j] = *(const f32x4*)(xr + j * 256 + F.lane * 4); ss += (v[j].x * v[j].x + v[j].y * v[j].y) + (v[j].z * v[j].z + v[j].w * v[j].w); }
        if (isc && part) {
            const int cr = b * CTXL + t - SEQ; ss = 0.f;
#pragma unroll
            for (int j = 0; j < 16; ++j) { const int c0 = j * 256 + F.lane * 4; f32x4 a = *(const f32x4*)(part + (size_t)cr * DM + c0);
#pragma unroll
                for (int ks = 1; ks < 8; ++ks) a += *(const f32x4*)(part + ((size_t)ks * (NB * CTXL) + cr) * DM + c0);
                v[j] += a * (*(const f32x4*)(pgate + c0) * pcoef); *(f32x4*)(xc_out + (size_t)cr * DM + c0) = v[j];
                ss += (v[j].x * v[j].x + v[j].y * v[j].y) + (v[j].z * v[j].z + v[j].w * v[j].w); }
        }
        ss = wave_sum(ss); if (F.lane == 0) rowss[row] = ss;
        if (isc && xc_copy) { float* cr = xc_copy + (size_t)(b * CTXL + t - SEQ) * DM;
#pragma unroll
            for (int j = 0; j < 16; ++j) *(f32x4*)(cr + j * 256 + F.lane * 4) = v[j]; }
        u16* orow = HN + (size_t)row * DM;
#pragma unroll
        for (int j = 0; j < 16; ++j) { const int c0 = j * 256 + F.lane * 4;
            const f32x4 gg = *(const f32x4*)(g + c0), sc = *(const f32x4*)(mv + DM + c0);
            const f32x4 y = v[j] * gg * (sc + 1.0f);
            v2u w; w.x = pk2(y.x, y.y); w.y = pk2(y.z, y.w); *(v2u*)(orow + c0) = w;
            if (hn8) *(unsigned*)(hn8 + (size_t)row * DM + c0) = pk4_fp8(y.x, y.y, y.z, y.w); }
    }
}

__device__ __forceinline__ void ctxnorm_phase(const Frame& F, float* xc, const float* g, const float* modl, int sub, u16* HN, const float* part, const float* pgate, float pcoef, float* rowss, unsigned char* hn8) {
    const int gw = F.vcu * NWAVES + F.wave, NGW = F.G * NWAVES;
    const float* mv = modl + (size_t)2 * MODW + (size_t)(3 * sub) * DM;
    for (int it = gw; it < NB * CTXL * 4; it += NGW) {
        const int cr = it >> 2, q = it & 3, b = cr / CTXL, row = b * TPB + SEQ + (cr - b * CTXL);
        float* xr = xc + (size_t)cr * DM + q * 1024 + F.lane * 4;
        f32x4 v[4]; float ss = 0.f;
#pragma unroll
        for (int j = 0; j < 4; ++j) v[j] = *(const f32x4*)(xr + j * 256);
        if (part) {
#pragma unroll
            for (int j = 0; j < 4; ++j) { const int c0 = q * 1024 + j * 256 + F.lane * 4; f32x4 a = *(const f32x4*)(part + (size_t)cr * DM + c0);
#pragma unroll
                for (int ks = 1; ks < 8; ++ks) a += *(const f32x4*)(part + ((size_t)ks * (NB * CTXL) + cr) * DM + c0);
                v[j] += a * (*(const f32x4*)(pgate + c0) * pcoef); *(f32x4*)(xr + j * 256) = v[j]; }
        }
#pragma unroll
        for (int j = 0; j < 4; ++j) ss += (v[j].x * v[j].x + v[j].y * v[j].y) + (v[j].z * v[j].z + v[j].w * v[j].w);
        ss = wave_sum(ss); if (F.lane == 0) unsafeAtomicAdd(rowss + row, ss);
#pragma unroll
        for (int j = 0; j < 4; ++j) { const int c0 = q * 1024 + j * 256 + F.lane * 4;
            const f32x4 gg = *(const f32x4*)(g + c0), sc = *(const f32x4*)(mv + DM + c0);
            const f32x4 y = v[j] * gg * (sc + 1.0f);
            if (hn8) *(unsigned*)(hn8 + (size_t)row * DM + c0) = pk4_fp8(y.x, y.y, y.z, y.w);
            else { v2u w; w.x = pk2(y.x, y.y); w.y = pk2(y.z, y.w); *(v2u*)(HN + (size_t)row * DM + c0) = w; } }
    }
}

template <int KIND  >
__device__ __forceinline__ v4u qk_one(v4u w, const float* gain, bool lat, int gr, int gcl, const f32x2* T, int sub) {
    float x[8]; x[0] = bf_lo(w.x); x[1] = bf_hi(w.x); x[2] = bf_lo(w.y); x[3] = bf_hi(w.y); x[4] = bf_lo(w.z); x[5] = bf_hi(w.z); x[6] = bf_lo(w.w); x[7] = bf_hi(w.w);
    float ss = 0.f;
#pragma unroll
    for (int e = 0; e < 8; ++e) ss += x[e] * x[e];
    ss = (KIND != 2) ? sum16(ss) : sum8(ss);
    const float rstd = 1.0f / sqrtf(ss * (KIND == 2 ? 1.0f / 64.0f : 1.0f / 128.0f) + EPS);
    const int s = KIND == 2 ? (sub & 7) : sub;
    const f32x4 g0 = *(const f32x4*)(gain + 8 * s), g1 = *(const f32x4*)(gain + 8 * s + 4);
    x[0] *= rstd * g0[0]; x[1] *= rstd * g0[1]; x[2] *= rstd * g0[2]; x[3] *= rstd * g0[3]; x[4] *= rstd * g1[0]; x[5] *= rstd * g1[1]; x[6] *= rstd * g1[2]; x[7] *= rstd * g1[3];
    if (KIND != 1 && lat) {
        constexpr int NP = KIND == 0 ? 32 : 16;
        const int i0 = 4 * s; const f32x2* tp = (i0 < NP) ? T + gr * NP + i0 : T + gcl * NP + i0 - NP;
        const f32x4 c01 = *(const f32x4*)tp, c23 = *(const f32x4*)(tp + 2);
        float y;
        y = x[0] * c01[0] - x[1] * c01[1]; x[1] = x[0] * c01[1] + x[1] * c01[0]; x[0] = y;
        y = x[2] * c01[2] - x[3] * c01[3]; x[3] = x[2] * c01[3] + x[3] * c01[2]; x[2] = y;
        y = x[4] * c23[0] - x[5] * c23[1]; x[5] = x[4] * c23[1] + x[5] * c23[0]; x[4] = y;
        y = x[6] * c23[2] - x[7] * c23[3]; x[7] = x[6] * c23[3] + x[7] * c23[2]; x[6] = y;
    }
    v4u o; o.x = pk2(x[0], x[1]); o.y = pk2(x[2], x[3]); o.z = pk2(x[4], x[5]); o.w = pk2(x[6], x[7]); return o;
}
__device__ __forceinline__ void qkprep_phase(const Frame& F, u16* QKV, u16* QOUT, const float* ga, const float* gb, const float* gc, const float* misc) {
    const int gw = F.vcu * NWAVES + F.wave, NGW = F.G * NWAVES, sub = F.lane & 15;
    const f32x2* TA = (const f32x2*)(misc + MI_TA); const f32x2* TC = (const f32x2*)(misc + MI_TC);
    for (int row = gw; row < MROWS; row += NGW) {
        const int t = row % TPB; const bool lat = t < SEQ; const int gr = (t >> 6) & 63, gcl = t & 63;
        u16* rp = QKV + (size_t)row * QKVW + F.lane * 8; u16* wp = QOUT + (size_t)row * QKVW + F.lane * 8;
        v4u v[6];
#pragma unroll
        for (int jj = 0; jj < 6; ++jj) { const int j = jj == 0 ? 3 : (jj < 4 ? 6 + jj : 8 + jj); const int col = j < 4 ? j * 512 : (j < 10 ? CQB + (j - 4) * 512 : CQC + (j - 10) * 512); v[jj] = *(const v4u*)(rp + col); }
#pragma unroll
        for (int jj = 0; jj < 6; ++jj) { const int j = jj == 0 ? 3 : (jj < 4 ? 6 + jj : 8 + jj); const int col = j < 4 ? j * 512 : (j < 10 ? CQB + (j - 4) * 512 : CQC + (j - 10) * 512);
            v4u o;
            if (j < 4)       o = qk_one<0>(v[jj], ga + 128, lat, gr, gcl, TA, sub);
            else if (j < 10) o = qk_one<1>(v[jj], gb + 128, lat, gr, gcl, TA, sub);
            else             o = qk_one<2>(v[jj], gc + 64, lat, gr, gcl, TC, sub);
            *(v4u*)(wp + col) = o; }
    }
}

__device__ __forceinline__ void ccombine_phase(const Frame& F, const u16* OCR, u16* OC, const float* subln, float lam, float one_m_li) {
    const int gw = F.vcu * NWAVES + F.wave, NGW = F.G * NWAVES, sub = F.lane & 15, grp = F.lane >> 4;
    const f32x4 s0 = *(const f32x4*)(subln + 8 * sub) * one_m_li, s1 = *(const f32x4*)(subln + 8 * sub + 4) * one_m_li;
    for (int row = gw; row < MROWS; row += NGW) {
        const u16* rp = OCR + (size_t)row * 2048 + grp * 256 + sub * 8;
        v4u a[2], b[2];
#pragma unroll
        for (int j = 0; j < 2; ++j) { a[j] = *(const v4u*)(rp + j * 1024); b[j] = *(const v4u*)(rp + j * 1024 + 128); }
#pragma unroll
        for (int j = 0; j < 2; ++j) {
            float d[8]; d[0] = bf_lo(a[j].x) - lam * bf_lo(b[j].x); d[1] = bf_hi(a[j].x) - lam * bf_hi(b[j].x); d[2] = bf_lo(a[j].y) - lam * bf_lo(b[j].y); d[3] = bf_hi(a[j].y) - lam * bf_hi(b[j].y);
            d[4] = bf_lo(a[j].z) - lam * bf_lo(b[j].z); d[5] = bf_hi(a[j].z) - lam * bf_hi(b[j].z); d[6] = bf_lo(a[j].w) - lam * bf_lo(b[j].w); d[7] = bf_hi(a[j].w) - lam * bf_hi(b[j].w);
            float ss = 0.f;
#pragma unroll
            for (int e = 0; e < 8; ++e) ss += d[e] * d[e];
            ss = sum16(ss);
            const float rstd = 1.0f / sqrtf(ss * (1.0f / 128.0f) + EPS);
            v4u o; o.x = pk2(d[0] * rstd * s0[0], d[1] * rstd * s0[1]); o.y = pk2(d[2] * rstd * s0[2], d[3] * rstd * s0[3]); o.z = pk2(d[4] * rstd * s1[0], d[5] * rstd * s1[1]); o.w = pk2(d[6] * rstd * s1[2], d[7] * rstd * s1[3]);
            *(v4u*)(OC + (size_t)row * DM + 3072 + (j * 4 + grp) * 128 + sub * 8) = o;
        }
    }
}

constexpr int PPL = 13, NPH = 2 + DEPTH * PPL;
typedef const float* __attribute__((address_space(4))) const* kargp_t;
#define KARGS() kargp_t kp_ = (kargp_t)__builtin_amdgcn_kernarg_segment_ptr(); asm volatile("" : "+s"(kp_))
#define KIN(i) ((const float*)kp_[i])
#define KOUT() ((float*)kp_[22])
#define KWS() ((unsigned char*)kp_[23])
constexpr int H_FIN = (DM / 512) * (2 * FFN / 32), H_IN = (DM / 512) * (INW / 32), H_LAYER = 2 * H_FIN + H_IN;
constexpr int I_FOUT = (FFN / 64) * (DM / 32), I_BRA = (1536 / 64) * (DM / 32), I_BRC = (1024 / 64) * (DM / 32), I_OUT = (DM / 64) * (DM / 32), I_LAYER = 2 * I_FOUT + 2 * I_BRA + I_BRC + I_OUT;
constexpr int TAIL_L1 = 22528, TAIL_H = 12800, T2_H = 7168;
__device__ __forceinline__ void conv_heavy(kargp_t kp_, unsigned char* ws, LAS float* scr, int l, int r, int lane) {
    int ai, Nsrc, smap, which, ksh; size_t wo;
    if (r < H_FIN) { ai = 7; Nsrc = 2 * FFN; wo = WO_1IN; smap = 1; which = 0; ksh = 0; }
    else if ((r -= H_FIN) < H_IN) { ai = 11; Nsrc = INW; wo = WO_IN; smap = 0; which = 1; ksh = 3; }
    else { r -= H_IN; ai = 9; Nsrc = 2 * FFN; wo = WO_2IN; smap = 1; which = 2; ksh = 6; }
    p0_transpose_item<8>(KIN(ai) + (size_t)l * DM * Nsrc, DM, Nsrc, (u16*)(ws + WS_W + (size_t)l * W_LAYER + wo), DM, Nsrc / 32, smap, scr, r, lane,
                         (const float*)(ws + WS_MOD) + (size_t)l * 3 * MODW + (size_t)ksh * DM, (float*)(ws + WS_SW) + (size_t)(l * 3 + which) * SW_STRIDE, Nsrc,
                         which == 1 ? ws + WS_W8 + (size_t)l * W8_LAYER : nullptr);
}
__device__ __forceinline__ void conv_light(kargp_t kp_, unsigned char* ws, LAS float* scr, int l, int r, int lane) {
    int ai, K, Kdst = 0; size_t wo;
    if (r < I_FOUT) { ai = 8; K = FFN; wo = WO_1OUT; }
    else if ((r -= I_FOUT) < I_FOUT) { ai = 10; K = FFN; wo = WO_2OUT; }
    else if ((r -= I_FOUT) < I_BRA) { ai = 18; K = 1536; wo = WO_BR; Kdst = DM; }
    else if ((r -= I_BRA) < I_BRA) { ai = 19; K = 1536; wo = WO_BR + 1536 * 2; Kdst = DM; }
    else if ((r -= I_BRA) < I_BRC) { ai = 20; K = 1024; wo = WO_BR + 3072 * 2; Kdst = DM; }
    else { r -= I_BRC; ai = 21; K = DM; wo = WO_OUT; }
    p0_transpose_item<1>(KIN(ai) + (size_t)l * K * DM, K, DM, (u16*)(ws + WS_W + (size_t)l * W_LAYER + wo), Kdst ? Kdst : K, DM / 32, 0, scr, r, lane, nullptr, nullptr, 0);
}
__device__ __forceinline__ int l0_early(int j) { return j < I_FOUT ? j : j + I_FOUT; }
__device__ __forceinline__ int l0_late(int j) { return j < I_FOUT ? j + I_FOUT : j + 2 * I_BRA + I_BRC + I_FOUT; }
template <int KIND> __device__ __forceinline__ void conv_tail(kargp_t kp_, unsigned char* ws, LAS unsigned char* lds, int G, int c, int busy, int lo, int hi, int wv) {
    if (c < busy || busy >= G) return;
    const int t_ = tid_of(wv); const int wave = wv, lane = t_ & 63;
    LAS float* scr = (LAS float*)(lds + RING_OFF + wave * 16384);
    for (int it = lo + (c - busy) * NWAVES + wave; it < hi; it += (G - busy) * NWAVES) { if (KIND == 1) conv_heavy(kp_, ws, scr, 1, it, lane); else if (KIND == 0) conv_light(kp_, ws, scr, 1, it, lane); else conv_light(kp_, ws, scr, 0, l0_early(it), lane); }
    LDS_WAIT();
}

__device__ __forceinline__ int attq_next(const Frame& F, gu32* head) {
    volatile LAS unsigned* slot = (volatile LAS unsigned*)(F.lds + att::OFF_SLOT);
    __syncthreads();
    if (F.tid == 0) slot[0] = __hip_atomic_fetch_add(head, 1u, RLX_AGENT);
    __syncthreads();
    return __builtin_amdgcn_readfirstlane((int)slot[0]);
}
__device__ __forceinline__ void attn_phase(const Frame& F, const u16* QKV, u16* OCAT, u16* OCR, const float* rel_bias  , gu32* qhead, bool with_ctx,
                                           const float* ga, const float* gb, const float* gc  , const float* misc  , kargp_t kp_, unsigned char* ws, bool conv  ) {
    char* lds = (char*)F.lds;
    int cround = 0; const int crounds = conv ? (TAIL_H - T2_H + F.G * NWAVES - 1) / (F.G * NWAVES) : 0;
#define CONV_ROUND() do { if (cround < crounds) { __syncthreads(); const int it_ = T2_H + cround * F.G * NWAVES + (int)blockIdx.x * NWAVES + F.wave; \
        if (it_ < TAIL_H) conv_heavy(kp_, ws, (LAS float*)(F.lds + RING_OFF + F.wave * 9216), 1, it_, tid_of(F.wave) & 63  ); LDS_WAIT(); ++cround; } } while (0)
    for (;;) {
        const int idx = attq_next(F, qhead); if (idx >= (with_ctx ? 408 : 384)) break;
        att::Unit U; int h, b, qb; const bool ctxq = idx >= 384;
        if (!ctxq) { qb = idx & 15; h = (idx >> 4) % 12; b = idx / 192; } else { const int i = idx - 384; qb = 16; h = i % 12; b = i / 12; }
        const int rowq = b * TPB + qb * 256; U.r0 = 0; U.first = 0; U.base1 = 0;
        if (ctxq) { U.NT = 4; U.n0 = 4; U.base0 = b * TPB + SEQ; } else { U.NT = 68; U.n0 = 68; U.base0 = b * TPB; }
        U.Q = QKV + (size_t)rowq * QKVW + CQA + h * 128; U.K = QKV + CKA + (h / 3) * 128; U.V = QKV + CVA + (h / 3) * 128; U.O = OCAT + (size_t)rowq * DM + h * 128; U.ldo = DM;
        U.qgain = ga; U.qrope = ctxq ? nullptr : misc + MI_TA; U.t0 = ctxq ? 0 : qb * 256;
        att::attn_unit<128, 0, 2>(U, lds, F.wave);
        CONV_ROUND();
    }
    for (;;) {
        const int idx = attq_next(F, qhead + 64); if (idx >= (with_ctx ? 544 : 512)) break;
        att::Unit U; int ph, b, qb; const bool ctxq = idx >= 512;
        if (!ctxq) { qb = idx & 15; ph = (idx >> 4) & 15; b = idx >> 8; } else { const int i = idx - 512; qb = 16; ph = i & 15; b = i >> 4; }
        const int rowq = b * TPB + qb * 256, h = ph >> 1, cmap = ph & 1; U.r0 = 0; U.first = 0; U.base1 = 0;
        if (ctxq) { U.NT = 4; U.n0 = 4; U.base0 = b * TPB + SEQ; } else { U.NT = 68; U.n0 = 68; U.base0 = b * TPB; }
        U.Q = QKV + (size_t)rowq * QKVW + CQC + h * 128 + cmap * 64; U.K = QKV + CKC + h * 128 + cmap * 64; U.V = QKV + CVC + h * 128; U.O = OCR + (size_t)rowq * 2048 + ph * 128; U.ldo = 2048;
        U.qgain = gc; U.qrope = ctxq ? nullptr : misc + MI_TC; U.t0 = ctxq ? 0 : qb * 256;
        att::attn_unit<64, 0, 2>(U, lds, F.wave);
        CONV_ROUND();
    }
    for (;;) {
        const int idx = attq_next(F, qhead + 128); if (idx >= (with_ctx ? 408 : 384)) break;
        att::Unit U; int h, b, qb; const bool ctxq = idx >= 384;
        if (!ctxq) { qb = idx & 15; h = (idx >> 4) % 12; b = idx / 192; } else { const int i = idx - 384; qb = 16; h = i % 12; b = i / 12; }
        const int rowq = b * TPB + qb * 256; U.r0 = 0; U.first = 0; U.base1 = 0; U.NT = 4; U.n0 = 4; U.base0 = b * TPB + SEQ;
        if (!ctxq) {
            const int r0 = qb * 4; int first = min(max(r0 - 4, 0), 56); const int last = min(max(r0 - 1, 0), 56) + 7; int cnt = last - first + 1;
            if (cnt & 1) { if (first > 0) --first; ++cnt; }
            U.NT = 4 + cnt; U.base1 = b * TPB + first * 64; U.r0 = r0; U.first = first;
            LAS float* biasq = (LAS float*)(F.lds + att::OFF_BIAS);
            for (int e = F.tid; e < 465; e += NWAVES * 64) biasq[e] = rel_bias[h * 465 + e] * 11.313708498984761f;
        }
        U.Q = QKV + (size_t)rowq * QKVW + CQB + h * 128; U.K = QKV + CKB + h * 128; U.V = QKV + CVB + h * 128; U.O = OCAT + (size_t)rowq * DM + 1536 + h * 128; U.ldo = DM;
        U.qgain = gb; U.qrope = nullptr; U.t0 = 0;
        att::attn_unit<128, 1, 1>(U, lds, F.wave);
    }
    while (cround < crounds) CONV_ROUND();
#undef CONV_ROUND
}

__device__ __forceinline__ Frame make_frame(unsigned char* ws, LAS unsigned char* lds, int wv) {
    Frame F; F.lds = lds; F.MISC = (volatile LAS unsigned*)(lds + MISC_OFF); F.ctl = (gu32*)(ws + WS_CTL);
    F.tid = tid_of(wv); F.lane = F.tid & 63; F.wave = wv;
    F.G = gridDim.x; { const int bx = blockIdx.x; F.vcu = (F.G % 8 == 0) ? (bx % 8) * (F.G / 8) + bx / 8 : bx; }
    return F;
}
__global__ void __launch_bounds__(NWAVES * 64, 2) trunk_fwd(Args args) {
    extern __shared__ __attribute__((aligned(16))) unsigned char lds[];
    LAS unsigned char* const L = (LAS unsigned char*)lds;
    const int wv_ = __builtin_amdgcn_readfirstlane((int)threadIdx.x >> 6);
    for (int u = tid_of(wv_); u < (LDS_BYTES - LDSCTL_OFF) / 4; u += NWAVES * 64) ((LAS unsigned*)(L + LDSCTL_OFF))[u] = 0u;
    __syncthreads();
    const int lo = args.ph_lo, hi = args.ph_hi;
    if (MK_N_LAUNCHES == 1) { KARGS(); (void)xcd_barrier_post((unsigned*)((gu32*)(KWS() + WS_CTL) + CW_BAR), (volatile LAS unsigned*)(L + MISC_OFF) + 8, tid_of(wv_) == 0); }
#define GRID_BAR() do { if (MK_N_LAUNCHES == 1) { KARGS(); XcdBarrier bar_; bar_.bar = (unsigned*)((gu32*)(KWS() + WS_CTL) + CW_BAR); bar_.x = xb_xcc_id(); bar_.st = (volatile LAS unsigned*)(L + MISC_OFF) + 8; xcd_barrier(bar_, tid_of(wv_) == 0); } } while (0)
#define IN(k) (lo <= (k) && (k) < hi)
#define SEAM(k) do { if (IN((k) + 1)) GRID_BAR(); } while (0)

    if (IN(0)) {
        KARGS(); unsigned char* ws = KWS(); const Frame F = make_frame(ws, L, wv_);
        LAS float* scr = (LAS float*)(F.lds + RING_OFF + F.wave * 16384);
        const int gw = F.vcu * NWAVES + F.wave, NGW = F.G * NWAVES;
        { const float* c_in = KIN(1); const float* cctx_in = KIN(3); const float* w_ada = KIN(4); const float* b_ada = KIN(5); float* MOD = (float*)(ws + WS_MOD);
          for (int it = gw; it < DEPTH * 32 * 144; it += NGW) p0_ada_item(c_in, cctx_in, w_ada, b_ada, MOD, scr, it, F.lane); }
        if (blockIdx.x == 0) {
            float* MISCF = (float*)(ws + WS_MISC); const float* diff_lambda = KIN(16);
            for (int e = F.tid; e < 64 * 32; e += NWAVES * 64) { const int p = e >> 5, i = e & 31; const float inv = powf(10000.0f, -(float)i / 32.0f), ang = (float)p * inv; MISCF[MI_TA + 2 * e] = cosf(ang); MISCF[MI_TA + 2 * e + 1] = sinf(ang); }
            for (int e = F.tid; e < 64 * 16; e += NWAVES * 64) { const int p = e >> 4, i = e & 15; const float inv = powf(10000.0f, -(float)i / 16.0f), ang = (float)p * inv; MISCF[MI_TC + 2 * e] = cosf(ang); MISCF[MI_TC + 2 * e + 1] = sinf(ang); }
            if (F.wave < DEPTH) { const int l = F.wave; const float* dl = diff_lambda + (size_t)l * 4 * 64;
                const float s1 = wave_sum(dl[F.lane] * dl[64 + F.lane]), s2 = wave_sum(dl[128 + F.lane] * dl[192 + F.lane]);
                const float lam_init = 0.8f - 0.6f * expf(-0.3f * (float)l);
                if (F.lane == 0) MISCF[MI_LAM + l] = expf(s1) - expf(s2) + lam_init; }
        }
        LDS_WAIT();
        SEAM(0);
    }
#define PH_BEGIN0() const float* modl = (const float*)(ws + WS_MOD) + (size_t)l * 3 * MODW; float* XC = (float*)(ws + WS_XC)
    if (IN(1)) {
        KARGS(); unsigned char* ws = KWS(); const Frame F = make_frame(ws, L, wv_);
        LAS float* scr = (LAS float*)(F.lds + RING_OFF + F.wave * 16384);
        const int gw = F.vcu * NWAVES + F.wave, NGW = F.G * NWAVES;
        for (int it = gw; it < DEPTH * H_LAYER; it += NGW) {
            const int l = it / H_LAYER, r = it - l * H_LAYER; if (l == 1 && r < TAIL_H) continue;
            conv_heavy(kp_, ws, scr, l, r, F.lane); }
        if (DEPTH > 1) { for (int it = gw; it < TAIL_L1; it += NGW) conv_light(kp_, ws, scr, 0, l0_late(it), F.lane); }
        else { for (int it = gw; it < I_LAYER; it += NGW) conv_light(kp_, ws, scr, 0, it, F.lane); }
        LDS_WAIT();
        { const int l = 0; PH_BEGIN0();
          modnorm_phase(F, KIN(0), KIN(2), KIN(6), modl, 0, (u16*)(ws + WS_HN), XC, nullptr, modl, 0.5f, XC, (float*)(ws + WS_ROWSS), false, nullptr); }
        SEAM(1);
    }

    for (int l = 0; l < DEPTH; ++l) {
        const int P = 2 + l * PPL;
#define PH_BEGIN() KARGS(); unsigned char* ws = KWS(); const Frame F = make_frame(ws, L, wv_); const float* modl = (const float*)(ws + WS_MOD) + (size_t)l * 3 * MODW; \
        const u16* wl = (const u16*)(ws + WS_W + (size_t)l * W_LAYER); float* XL = KOUT(); float* XC = (float*)(ws + WS_XC); \
        float* DXL = rep ? (float*)(ws + WS_MX) : XL; float* DXC = rep ? (float*)(ws + WS_MX) + (size_t)NB * SEQ * DM : XC;     \
        (void)F; (void)modl; (void)wl; (void)XL; (void)XC; (void)DXL; (void)DXC
        if (IN(P + 0) && l != 0) { for (int rep = 0; rep <= DUP(0); ++rep) { PH_BEGIN();
            ctxnorm_phase(F, XC, KIN(6) + (size_t)(l * 3 + 0) * DM, modl, 0, (u16*)(ws + WS_HN), (const float*)(ws + WS_PART), modl - 3 * MODW + 2 * MODW + 8 * DM, 0.5f, (float*)(ws + WS_ROWSS) + (size_t)(l * 3 + 0) * MROWS, nullptr); } SEAM(P + 0); }
        if (IN(P + 1)) { for (int rep = 0; rep <= DUP(1); ++rep) { PH_BEGIN(); pg8::Gemm g{(const u16*)(ws + WS_HN), wl + WO_1IN / 2, MROWS, 2 * FFN, DM}; pg8::StaticOrder S; S.init(MROWS, 2 * FFN, DM, F.G, (int)blockIdx.x);
            pg8::EpiSwiglu E{(u16*)(ws + WS_HD), {(const float*)(ws + WS_ROWSS) + (size_t)(l * 3 + 0) * MROWS, (const float*)(ws + WS_SW) + (size_t)(l * 3 + 0) * SW_STRIDE, 2 * FFN}}; pg8::gemm_phase<pg8::EpiSwiglu, pg8::StaticOrder, true, true>(F.lds + RING_OFF, g, S, E, F.wave); } if (DEPTH > 1) { KARGS(); const int busy_ = ((MROWS / 256) * (2 * FFN / 256)) % (int)gridDim.x;
              if (l == 0) conv_tail<2>(kp_, KWS(), L, (int)gridDim.x, (int)blockIdx.x, busy_, 0, TAIL_L1, wv_); else if (l == 1) conv_tail<0>(kp_, KWS(), L, (int)gridDim.x, (int)blockIdx.x, busy_, TAIL_L1, 2 * TAIL_L1, wv_); } SEAM(P + 1); }
        if (IN(P + 2)) { for (int rep = DUP(2); rep >= 0; --rep) { PH_BEGIN(); pg8::Gemm g{(const u16*)(ws + WS_HD), wl + WO_1OUT / 2, MROWS, DM, FFN}; pg8::ResidOrder S; S.init(DM, FFN, F.G, (int)blockIdx.x, 8, 1);
            pg8::EpiResid E{l == 0 ? KIN(0) : XL, DXL, ws, KIN(6) + (size_t)(l * 3 + 1) * DM, (unsigned)(WS_MOD + ((size_t)l * 3 * MODW + 4 * DM) * 4), (unsigned)(WS_ROWSS + (size_t)(l * 3 + 1) * MROWS * 4), (unsigned)(WS_XG8 >> 20),
                            (unsigned)(WS_MOD + ((size_t)l * 3 * MODW + 2 * DM) * 4), 0.5f, FFN / 64, (l != 0 ? 1 : 0) | 2}; pg8::gemm_phase<pg8::EpiResid, pg8::ResidOrder, true, true>(F.lds + RING_OFF, g, S, E, F.wave); } SEAM(P + 2); }
        if (IN(P + 3)) { for (int rep = 0; rep <= DUP(3); ++rep) { PH_BEGIN(); ctxnorm_phase(F, XC, KIN(6) + (size_t)(l * 3 + 1) * DM, modl, 1, (u16*)(ws + WS_HN), (const float*)(ws + WS_PART), modl + 2 * MODW + 2 * DM, 0.5f, (float*)(ws + WS_ROWSS) + (size_t)(l * 3 + 1) * MROWS, ws + WS_XG8); } SEAM(P + 3); }
        if (IN(P + 4)) { for (int rep = 0; rep <= DUP(4); ++rep) { PH_BEGIN();
            const pg8::NormFix nf{(const float*)(ws + WS_ROWSS) + (size_t)(l * 3 + 1) * MROWS, (const float*)(ws + WS_SW) + (size_t)(l * 3 + 1) * SW_STRIDE, INW};
            { pg8::Gemm g{(const u16*)(ws + WS_XG8), (const u16*)(ws + WS_W8 + (size_t)l * W8_LAYER), MROWS, INW, DM / 2}; pg8::MapOrder<1> S; S.S.init(MROWS, 88 * 256, DM / 2, F.G, (int)blockIdx.x); S.extra = 0;
              pg8::EpiInProj E{(u16*)(ws + WS_QKV), (u16*)(ws + WS_SG), nf, 0, 1.0f / 64.0f}; pg8::gemm_phase<pg8::EpiInProj, pg8::MapOrder<1>, true, true, true>(F.lds + RING_OFF, g, S, E, F.wave); }
            } SEAM(P + 4); }
        if (IN(P + 5)) { for (int rep = DUP(5); rep >= 0; --rep) { PH_BEGIN(); qkprep_phase(F, (u16*)(ws + WS_QKV), rep ? (u16*)(ws + WS_MX) : (u16*)(ws + WS_QKV), KIN(12) + (size_t)l * 256, KIN(13) + (size_t)l * 256, KIN(14) + (size_t)l * 128, (const float*)(ws + WS_MISC)); } SEAM(P + 5); }
        if (IN(P + 6)) { for (int rep = 0; rep <= DUP(6); ++rep) { PH_BEGIN(); attn_phase(F, (const u16*)(ws + WS_QKV), (u16*)(ws + WS_OCAT), (u16*)(ws + WS_OCR), KIN(15) + (size_t)l * 12 * 465, F.ctl + CW_ATTQ + 256 * l + 1024 * rep, l == 0,
                KIN(12) + (size_t)l * 256, KIN(13) + (size_t)l * 256, KIN(14) + (size_t)l * 128, (const float*)(ws + WS_MISC), kp_, ws, l == 0 && DEPTH > 1 && rep == 0); } SEAM(P + 6); }
        if (IN(P + 7)) { for (int rep = 0; rep <= DUP(7); ++rep) { PH_BEGIN(); const float lam_init = 0.8f - 0.6f * expf(-0.3f * (float)l);
            ccombine_phase(F, (const u16*)(ws + WS_OCR), (u16*)(ws + WS_OCAT), KIN(17) + (size_t)l * 128, ((const float*)(ws + WS_MISC))[MI_LAM + l], 1.0f - lam_init); } SEAM(P + 7); }
        if (IN(P + 8)) { for (int rep = 0; rep <= DUP(8); ++rep) { PH_BEGIN(); pg8::Gemm g{(const u16*)(ws + WS_OCAT), wl + WO_BR / 2, MROWS, DM, DM}; pg8::GateOrder S; S.S.init(MROWS, DM, DM, F.G, (int)blockIdx.x, l == DEPTH - 1);
            pg8::EpiGate E{(const u16*)(ws + WS_SG), (u16*)(ws + WS_MXB)}; pg8::gemm_phase<pg8::EpiGate, pg8::GateOrder, true, true>(F.lds + RING_OFF, g, S, E, F.wave); } if (l == 0 && DEPTH > 1) { KARGS(); conv_tail<1>(kp_, KWS(), L, (int)gridDim.x, (int)blockIdx.x, ((MROWS / 256) * (DM / 256)) % (int)gridDim.x, 0, T2_H, wv_); } SEAM(P + 8); }
        if (IN(P + 9)) { for (int rep = DUP(9); rep >= 0; --rep) { PH_BEGIN(); pg8::Gemm g{(const u16*)(ws + WS_MXB), wl + WO_OUT / 2, MROWS, DM, DM}; pg8::ResidOrder S; S.init(DM, DM, F.G, (int)blockIdx.x, 8, l != DEPTH - 1);
            pg8::EpiResid E{XL, DXL, ws, KIN(6) + (size_t)(l * 3 + 2) * DM, (unsigned)(WS_MOD + ((size_t)l * 3 * MODW + 7 * DM) * 4), (unsigned)(WS_ROWSS + (size_t)(l * 3 + 2) * MROWS * 4), 0u,
                            (unsigned)(WS_MOD + ((size_t)l * 3 * MODW + 5 * DM) * 4), 1.0f, DM / 64, 3}; pg8::gemm_phase<pg8::EpiResid, pg8::ResidOrder, true, true>(F.lds + RING_OFF, g, S, E, F.wave); } SEAM(P + 9); }
        if (IN(P + 10) && l != DEPTH - 1) { for (int rep = 0; rep <= DUP(10); ++rep) { PH_BEGIN(); ctxnorm_phase(F, XC, KIN(6) + (size_t)(l * 3 + 2) * DM, modl, 2, (u16*)(ws + WS_HN), (const float*)(ws + WS_PART), modl + 2 * MODW + 5 * DM, 1.0f, (float*)(ws + WS_ROWSS) + (size_t)(l * 3 + 2) * MROWS, nullptr); } SEAM(P + 10); }
        if (IN(P + 11)) { for (int rep = 0; rep <= DUP(11); ++rep) { PH_BEGIN(); pg8::Gemm g{(const u16*)(ws + WS_HN), wl + WO_2IN / 2, MROWS, 2 * FFN, DM}; pg8::StaticOrder S; S.init(MROWS, 2 * FFN, DM, F.G, (int)blockIdx.x, l == DEPTH - 1);
            pg8::EpiSwiglu E{(u16*)(ws + WS_HD), {(const float*)(ws + WS_ROWSS) + (size_t)(l * 3 + 2) * MROWS, (const float*)(ws + WS_SW) + (size_t)(l * 3 + 2) * SW_STRIDE, 2 * FFN}}; pg8::gemm_phase<pg8::EpiSwiglu, pg8::StaticOrder, true, true>(F.lds + RING_OFF, g, S, E, F.wave); } if (l == 0 && DEPTH > 1) { KARGS(); conv_tail<0>(kp_, KWS(), L, (int)gridDim.x, (int)blockIdx.x, ((MROWS / 256) * (2 * FFN / 256)) % (int)gridDim.x, 0, TAIL_L1, wv_); } SEAM(P + 11); }
        if (IN(P + 12)) { for (int rep = DUP(12); rep >= 0; --rep) { PH_BEGIN(); pg8::Gemm g{(const u16*)(ws + WS_HD), wl + WO_2OUT / 2, MROWS, DM, FFN}; pg8::ResidOrder S; S.init(DM, FFN, F.G, (int)blockIdx.x, 8, l != DEPTH - 1);
            pg8::EpiResid E{XL, DXL, ws, l + 1 < DEPTH ? KIN(6) + (size_t)((l + 1) * 3 + 0) * DM : nullptr, (unsigned)(WS_MOD + ((size_t)(l + 1) * 3 * MODW + 1 * DM) * 4), (unsigned)(WS_ROWSS + (size_t)((l + 1) * 3 + 0) * MROWS * 4), 0u,
                            (unsigned)(WS_MOD + ((size_t)l * 3 * MODW + 8 * DM) * 4), 0.5f, FFN / 64, 1 | (l + 1 < DEPTH ? 2 : 0)}; pg8::gemm_phase<pg8::EpiResid, pg8::ResidOrder, true, true>(F.lds + RING_OFF, g, S, E, F.wave); } SEAM(P + 12); }
#undef PH_BEGIN
    }
#undef IN
#undef SEAM
#undef GRID_BAR
}

extern "C" void kernel_launch(void* const* d_in, const int* in_sizes, int n_in, void* d_out, int out_size, void* d_ws, size_t ws_size, hipStream_t stream) {
    static int grid = 0;
    if (grid == 0) {
        if (n_in != 22 || out_size != NB * SEQ * DM || ws_size < WS_END) { fprintf(stderr, "kernel_launch: built for 22 inputs, out %d floats, >= %zu bytes of workspace; got n_in %d, out %d, ws %zu; nothing launched\n", NB * SEQ * DM, (size_t)WS_END, n_in, out_size, ws_size); grid = -1; return; }
        int dev = 0, cus = 0, per_cu = 0;
        if (hipGetDevice(&dev) != hipSuccess || hipDeviceGetAttribute(&cus, hipDeviceAttributeMultiprocessorCount, dev) != hipSuccess) { fprintf(stderr, "kernel_launch: device query failed\n"); grid = -1; return; }
        if (hipFuncSetAttribute((const void*)trunk_fwd, hipFuncAttributeMaxDynamicSharedMemorySize, LDS_BYTES) != hipSuccess) { fprintf(stderr, "kernel_launch: hipFuncSetAttribute failed\n"); grid = -1; return; }
        if (hipOccupancyMaxActiveBlocksPerMultiprocessor(&per_cu, (const void*)trunk_fwd, NWAVES * 64, LDS_BYTES) != hipSuccess || per_cu < 1)
            fprintf(stderr, "kernel_launch: note: occupancy query reports %d workgroups per CU\n", per_cu);
        (void)hipGetLastError();
        grid = cus;
    }
    if (grid < 0) return;
    if (hipMemsetAsync((char*)d_ws + WS_CTL, 0, CTL_ZERO_BYTES, stream) != hipSuccess) { fprintf(stderr, "kernel_launch: hipMemsetAsync failed\n"); return; }
    Args a{};
    for (int i = 0; i < 22; ++i) a.in[i] = (const float*)d_in[i];
    a.out = (float*)d_out; a.ws = (unsigned char*)d_ws;
#if MK_N_LAUNCHES == 1
    a.ph_lo = 0; a.ph_hi = NPH;
    hipLaunchKernelGGL(trunk_fwd, dim3(grid), dim3(NWAVES * 64), LDS_BYTES, stream, a);
#else
    for (int p = 0; p < NPH; ++p) { a.ph_lo = p; a.ph_hi = p + 1; hipLaunchKernelGGL(trunk_fwd, dim3(grid), dim3(NWAVES * 64), LDS_BYTES, stream, a); }
#endif
    const hipError_t le = hipPeekAtLastError();
    if (le != hipSuccess) fprintf(stderr, "kernel_launch: launch failed: %s\n", hipGetErrorName(le));
}
```

```cpp
#include <hip/hip_runtime.h>
#include <cstdio>
#include <cstdint>

#ifndef DUPMASK
#define DUPMASK 0
#endif
#define DUP(k) ((DUPMASK >> (k)) & 1)
#ifndef MK_N_LAUNCHES
#define MK_N_LAUNCHES 1
#endif

constexpr int DM = 4096, NB = 2, SEQ = 4096, CTXL = 256, TPB = SEQ + CTXL  , MROWS = NB * TPB  ;
constexpr int FFN = 7168, NMOD = 9, MODW = NMOD * DM  , DEPTH = 2;
constexpr int INW = 22528, QKVW = 10240, SGW = 12288;
constexpr int PAN_PER_B = TPB / 256;
constexpr float EPS = 1e-6f;
constexpr int CQA = 0, CKA = 1536, CVA = 2048, CQB = 2560, CKB = 4096, CVB = 5632, CQC = 7168, CKC = 8192, CVC = 9216;

#define GAS __attribute__((address_space(1)))
#define LAS __attribute__((address_space(3)))
typedef unsigned short u16;
typedef unsigned v4u __attribute__((ext_vector_type(4)));
typedef unsigned v2u __attribute__((ext_vector_type(2)));
typedef float f32x4 __attribute__((ext_vector_type(4)));
typedef float f32x2 __attribute__((ext_vector_type(2)));
typedef GAS unsigned gu32;
#define RLX_AGENT __ATOMIC_RELAXED, __HIP_MEMORY_SCOPE_AGENT
#define LDS_WAIT() asm volatile("s_waitcnt lgkmcnt(0)" ::: "memory")
#define VM_WAIT() asm volatile("s_waitcnt vmcnt(0)" ::: "memory")
__device__ __forceinline__ unsigned f2bf(float f) { unsigned u = __builtin_bit_cast(unsigned, f); return (u + 0x7fffu + ((u >> 16) & 1u)) >> 16; }
__device__ __forceinline__ unsigned pk2(float lo, float hi) { return f2bf(lo) | (f2bf(hi) << 16); }
__device__ __forceinline__ float bf_lo(unsigned w) { return __builtin_bit_cast(float, w << 16); }
__device__ __forceinline__ float bf_hi(unsigned w) { return __builtin_bit_cast(float, w & 0xffff0000u); }
__device__ __forceinline__ unsigned cvt_pk_bf16(float lo, float hi) { unsigned r; asm volatile("v_cvt_pk_bf16_f32 %0, %1, %2" : "=v"(r) : "v"(lo), "v"(hi)); return r; }
__device__ __forceinline__ unsigned pk4_fp8(float a, float b, float c, float d) { unsigned w = 0; w = __builtin_amdgcn_cvt_pk_fp8_f32(a, b, w, false); w = __builtin_amdgcn_cvt_pk_fp8_f32(c, d, w, true); return w; }
__device__ __forceinline__ float fast_sigmoid(float v) { return __builtin_amdgcn_rcpf(1.0f + __builtin_amdgcn_exp2f(-1.4426950408889634f * v)); }

__device__ __forceinline__ int tid_of(int wv) { int t; asm volatile("v_mbcnt_lo_u32_b32 %0, -1, 0\n\tv_mbcnt_hi_u32_b32 %0, -1, %0\n\tv_lshl_or_b32 %0, %1, 6, %0" : "=&v"(t) : "s"(wv)); return t; }

namespace pg8 {
#define PG8_LAS __attribute__((address_space(3)))
typedef unsigned short bf16_t;
typedef short bf16x8 __attribute__((ext_vector_type(8)));
typedef float f32x4 __attribute__((ext_vector_type(4)));
typedef unsigned u32x4 __attribute__((ext_vector_type(4)));
typedef unsigned u32x2 __attribute__((ext_vector_type(2)));
typedef int i32x4 __attribute__((ext_vector_type(4)));
constexpr int BM = 256, BK = 64, HALF = 128, HTB = HALF * BK * 2  , STAGE_BYTES = 8 * HTB, NXCD = 8, WGM = 4;

__host__ __device__ __forceinline__ int lds_byte(int r, int c) { const int st = (r >> 4) * 2 + (c >> 5), rr = r & 15, cc = c & 31, ob = rr * 64 + cc * 2; return st * 1024 + (ob ^ (((ob >> 9) & 1) << 5)); }
__host__ __device__ __forceinline__ void stage_rc(int b, int& R, int& C) { const int st = b / 1024, sb = b % 1024, swz = sb ^ (((sb >> 9) & 1) << 5); R = (st >> 1) * 16 + swz / 64; C = (st & 1) * 32 + (swz % 64) / 2; }
__host__ __device__ __forceinline__ int perm32(int rho) { const int n = rho >> 4, i = rho & 15; return 8 * (i >> 2) + 4 * n + (i & 3); }

struct Unit { int pm, pn, kt0, nt; };
struct Gemm { const bf16_t* A; const bf16_t* Bt; int M, N, K; };

struct StaticOrder {
    int nM, nN, nwg, G, c, ntf, lat;
    __host__ __device__ void init(int M, int N, int K, int G_, int c_, int lat_only = 0) { lat = lat_only; nM = lat ? 32 : M / BM; nN = N / BM; nwg = nM * nN; G = G_; c = c_; ntf = K / BK; }
    __host__ __device__ __forceinline__ bool map(long L, Unit& u) const {
        if (L >= nwg) return false;
        int wgid = (int)L; { const int q = nwg / NXCD, r = nwg % NXCD, xcd = wgid % NXCD, off = wgid / NXCD; wgid = (xcd < r ? xcd * (q + 1) : r * (q + 1) + (xcd - r) * q) + off; }
        const int nig = WGM * nN, gid = wgid / nig, fm = gid * WGM, gsz = (nM - fm) < WGM ? (nM - fm) : WGM;
        u.pm = fm + ((wgid % nig) % gsz); u.pn = (wgid % nig) / gsz; if (lat) u.pm += u.pm >> 4; u.kt0 = 0; u.nt = ntf; return true;
    }
    __host__ __device__ __forceinline__ bool next(int i, Unit& u) const { return map((long)i * G + c, u); }
    __device__ __forceinline__ void a_ready(const Unit&) const {}
    __device__ __forceinline__ void done(const Unit&) const {}
};
template <int MODE> struct MapOrder { StaticOrder S; int extra;
    __host__ __device__ __forceinline__ bool next(int i, Unit& u) const { const int nl = S.G - extra, pre = extra > 0 ? 2 * nl : 0; long L;
        if (extra > 0 && S.c >= extra) L = i < 2 ? (long)i * nl + (S.c - extra) : (long)pre + (long)(i - 2) * S.G + S.c; else L = (long)pre + (long)i * S.G + S.c;
        const bool ok = S.map(L, u); const int p = u.pn;
        u.pn = p; return ok; }
    __device__ __forceinline__ void a_ready(const Unit&) const {}
    __device__ __forceinline__ void done(const Unit&) const {} };
struct ResidOrder {
    StaticOrder S; int KS, ctx;
    __host__ __device__ void init(int N, int K, int G_, int c_, int KS_, int ctx_) { S.init(MROWS, N, K, G_, c_, 1); KS = KS_; ctx = ctx_; }
    __host__ __device__ __forceinline__ bool next(int i, Unit& u) const {
        const long L = (long)i * S.G + S.c; const bool islat = L < S.nwg;
        Unit a; (void)S.map(islat ? L : 0, a);
        const long L2 = islat ? 0 : L - S.nwg; const int ks = (int)(L2 % KS), t = (int)(L2 / KS), cnt = S.ntf / KS;
        u.pn = islat ? a.pn : t % S.nN; u.pm = islat ? a.pm : (t / S.nN) * PAN_PER_B + (PAN_PER_B - 1); u.nt = islat ? a.nt : cnt; u.kt0 = islat ? 0 : ks * cnt;
        return islat || (ctx && L2 < 2 * S.nN * KS);
    }
    __device__ __forceinline__ void a_ready(const Unit&) const {}
    __device__ __forceinline__ void done(const Unit&) const {}
};


__device__ __forceinline__ size_t panel_off(int pm, bool& is_ctx, int& b) { b = pm / PAN_PER_B; const int j = pm - b * PAN_PER_B; is_ctx = (j == PAN_PER_B - 1); return is_ctx ? (size_t)(b * CTXL) * DM : (size_t)(b * SEQ + j * 256) * DM; }

struct EpiResid {
    static constexpr bool PERM = true, AFTER_DRAIN = false; static constexpr size_t WS_PART_OFF = (size_t)884 << 20, WS_HN_OFF = (size_t)17 << 20, WS_XP_OFF = (size_t)680 << 20;
    __device__ static __forceinline__ bool keep(const Unit&) { return false; }
    const float* src_lat; float* dst_lat; unsigned char* wsb;
    const float* gsn; unsigned scale_off, rowss_off, xg8_off;
    unsigned gate_off; float coef; int ntf; int lay;
    __device__ __forceinline__ void operator()(const f32x4 (&acc)[2][2][4][2], const Unit& u, int wr, int wc, int fr, int fq) const {
        bool isc; int b; const size_t po = panel_off(u.pm, isc, b); const bool split = u.nt != ntf;
        const float* s = src_lat + po; float* d = dst_lat + po; const float* g = (const float*)(wsb + gate_off) + (size_t)b * MODW; float* part = (float*)(wsb + WS_PART_OFF);
        const int row0 = wr * 64 + fr, col0 = u.pn * BM + wc * 32 + 8 * fq;
        float* xp = (float*)(wsb + WS_XP_OFF) + ((size_t)((u.pm - b) * 16 + u.pn) * (32 * 512) + (wr * 4 + wc) * 64 + fq * 16 + fr) * 4;
        f32x4 gv[2][2];
#pragma unroll
        for (int bj = 0; bj < 2; ++bj)
#pragma unroll
            for (int n = 0; n < 2; ++n) gv[bj][n] = *(const f32x4*)(g + col0 + bj * HALF + n * 4) * coef;
        if (split) {
            float* pp = (float*)((bf16_t*)part + ((size_t)((u.kt0 * 8) / ntf) * (NB * CTXL) + (size_t)b * CTXL) * DM);
#pragma unroll
            for (int ai = 0; ai < 2; ++ai)
#pragma unroll
                for (int m = 0; m < 4; ++m) { const size_t off = (size_t)(row0 + ai * HALF + m * 16) * DM + col0;
#pragma unroll
                    for (int bj = 0; bj < 2; ++bj) { const f32x4 p0 = acc[ai][bj][m][0], p1 = acc[ai][bj][m][1]; u32x4 w; w.x = cvt_pk_bf16(p0[0], p0[1]); w.y = cvt_pk_bf16(p0[2], p0[3]); w.z = cvt_pk_bf16(p1[0], p1[1]); w.w = cvt_pk_bf16(p1[2], p1[3]);
                        *(u32x4*)((bf16_t*)pp + off + bj * HALF) = w; } }
        } else {
            const bool mk = gsn != nullptr; float* rsp = (float*)(wsb + rowss_off) + u.pm * BM + row0; const float* scp = (const float*)(wsb + scale_off) + (size_t)b * MODW;
            bf16_t* xg = (bf16_t*)(wsb + WS_HN_OFF) + (size_t)u.pm * BM * DM; unsigned char* xg8 = wsb + ((size_t)xg8_off << 20) + (size_t)u.pm * BM * DM;
#pragma unroll
            for (int ai = 0; ai < 2; ++ai)
#pragma unroll
              for (int mp = 0; mp < 2; ++mp) {
                f32x4 sv[2][2][2];
#pragma unroll
                for (int mm = 0; mm < 2; ++mm) { const size_t off = (size_t)(row0 + ai * HALF + (mp * 2 + mm) * 16) * DM + col0;
#pragma unroll
                    for (int bj = 0; bj < 2; ++bj)
#pragma unroll
                        for (int n = 0; n < 2; ++n) sv[mm][bj][n] = *(const f32x4*)((lay & 1) ? xp + (size_t)((((ai * 2 + bj) * 4 + mp * 2 + mm) * 2 + n) * 2048) : s + off + bj * HALF + n * 4); }
#pragma unroll
                for (int mm = 0; mm < 2; ++mm) { const int m = mp * 2 + mm; const size_t off = (size_t)(row0 + ai * HALF + m * 16) * DM + col0; float q = 0.f;
#pragma unroll
                    for (int bj = 0; bj < 2; ++bj) { f32x4 xn[2];
#pragma unroll
                        for (int n = 0; n < 2; ++n) { xn[n] = sv[mm][bj][n] + gv[bj][n] * acc[ai][bj][m][n]; *(f32x4*)((lay & 2) ? xp + (size_t)((((ai * 2 + bj) * 4 + m) * 2 + n) * 2048) : d + off + bj * HALF + n * 4) = xn[n]; }
                        if (mk) { f32x4 y[2];
#pragma unroll
                            for (int n = 0; n < 2; ++n) { y[n] = xn[n] * (*(const f32x4*)(gsn + col0 + bj * HALF + n * 4) * (*(const f32x4*)(scp + col0 + bj * HALF + n * 4) + 1.0f)); q += (xn[n][0] * xn[n][0] + xn[n][1] * xn[n][1]) + (xn[n][2] * xn[n][2] + xn[n][3] * xn[n][3]); }
                            if (!xg8_off) { u32x4 w; w.x = cvt_pk_bf16(y[0][0], y[0][1]); w.y = cvt_pk_bf16(y[0][2], y[0][3]); w.z = cvt_pk_bf16(y[1][0], y[1][1]); w.w = cvt_pk_bf16(y[1][2], y[1][3]); *(u32x4*)(xg + off + bj * HALF) = w; }
                            else {   u32x2 w8; w8.x = pk4_fp8(y[0][0], y[0][1], y[0][2], y[0][3]); w8.y = pk4_fp8(y[1][0], y[1][1], y[1][2], y[1][3]); *(u32x2*)(xg8 + off + bj * HALF) = w8; } } }
                    if (mk) { q += __builtin_bit_cast(float, __builtin_amdgcn_ds_swizzle(__builtin_bit_cast(int, q), (16 << 10) | 0x1f));
                        if ((fq & 1) == 0) unsafeAtomicAdd(rsp + ai * HALF + m * 16, q); } }
                asm volatile("" ::: "memory"); }
        }
    }
};
struct NormFix {
    const float* rowss;
    const float* sw;
    int N;
    __device__ __forceinline__ void rows(const Unit& u, int wr, int fr, float (&rs)[2][4]) const {
#pragma unroll
        for (int ai = 0; ai < 2; ++ai)
#pragma unroll
            for (int m = 0; m < 4; ++m) rs[ai][m] = __builtin_amdgcn_rsqf(rowss[u.pm * BM + wr * 64 + fr + ai * HALF + m * 16] * (1.0f / DM) + EPS);
    }
    __device__ __forceinline__ const float* vecp(const Unit& u) const { const int b = u.pm / PAN_PER_B; return sw + (size_t)((u.pm - b * PAN_PER_B == PAN_PER_B - 1) ? 2 : b) * N; }
};
struct EpiSwiglu {
    static constexpr bool PERM = true, AFTER_DRAIN = false;
    __device__ static __forceinline__ bool keep(const Unit&) { return false; }
    bf16_t* H; NormFix nf;
    __device__ __forceinline__ void operator()(const f32x4 (&acc)[2][2][4][2], const Unit& u, int wr, int wc, int fr, int fq) const {
        const int row0 = u.pm * BM + wr * 64 + fr, col0 = u.pn * HALF + wc * 32 + 8 * fq;
        float rs[2][4]; nf.rows(u, wr, fr, rs);
        const float* swp = nf.vecp(u) + u.pn * BM + wc * 32 + 8 * fq; f32x4 sg[2], su[2];
#pragma unroll
        for (int n = 0; n < 2; ++n) { sg[n] = *(const f32x4*)(swp + 4 * n); su[n] = *(const f32x4*)(swp + HALF + 4 * n); }
#pragma unroll
        for (int ai = 0; ai < 2; ++ai)
#pragma unroll
            for (int m = 0; m < 4; ++m) { bf16_t* rowp = H + (size_t)(row0 + ai * HALF + m * 16) * FFN + col0;
                float h[8];
#pragma unroll
                for (int n = 0; n < 2; ++n)
#pragma unroll
                    for (int j = 0; j < 4; ++j) { const float gt = acc[ai][0][m][n][j] * rs[ai][m] + sg[n][j], up = acc[ai][1][m][n][j] * rs[ai][m] + su[n][j]; h[n * 4 + j] = gt * fast_sigmoid(gt) * up; }
                u32x4 w; w.x = cvt_pk_bf16(h[0], h[1]); w.y = cvt_pk_bf16(h[2], h[3]); w.z = cvt_pk_bf16(h[4], h[5]); w.w = cvt_pk_bf16(h[6], h[7]);
                *(u32x4*)rowp = w; }
    }
};
struct EpiInProj {
    static constexpr bool PERM = true, AFTER_DRAIN = false;
    __device__ static __forceinline__ bool keep(const Unit&) { return false; }
    bf16_t* QKV; bf16_t* SG; NormFix nf; int pn0; float ascale;
    __device__ __forceinline__ void operator()(const f32x4 (&acc)[2][2][4][2], const Unit& u, int wr, int wc, int fr, int fq) const {
        const int row0 = u.pm * BM + wr * 64 + fr, pn = u.pn + pn0; const bool isg = pn >= QKVW / BM;
        bf16_t* base = isg ? SG : QKV; const int ldc = isg ? SGW : QKVW; const int col0 = (isg ? pn - QKVW / BM : pn) * BM + wc * 32 + 8 * fq;
        float rs[2][4]; nf.rows(u, wr, fr, rs);
#pragma unroll
        for (int ai = 0; ai < 2; ++ai)
#pragma unroll
            for (int m = 0; m < 4; ++m) rs[ai][m] *= ascale;
        const float* swp = nf.vecp(u) + pn * BM + wc * 32 + 8 * fq; f32x4 sv[2][2];
#pragma unroll
        for (int bj = 0; bj < 2; ++bj)
#pragma unroll
            for (int n = 0; n < 2; ++n) sv[bj][n] = *(const f32x4*)(swp + bj * HALF + 4 * n);
#pragma unroll
        for (int ai = 0; ai < 2; ++ai)
#pragma unroll
            for (int m = 0; m < 4; ++m) { bf16_t* rowp = base + (size_t)(row0 + ai * HALF + m * 16) * ldc + col0;
                u32x4 w16 = {0u, 0u, 0u, 0u};
#pragma unroll
                for (int bj = 0; bj < 2; ++bj) { f32x4 v0 = acc[ai][bj][m][0] * rs[ai][m] + sv[bj][0], v1 = acc[ai][bj][m][1] * rs[ai][m] + sv[bj][1];
                    if (isg) {
                        unsigned a = 0u, b = 0u;
#pragma unroll
                        for (int j = 0; j < 4; ++j) { a = __builtin_amdgcn_cvt_pk_u8_f32(fast_sigmoid(v0[j]) * 255.0f, j, a); b = __builtin_amdgcn_cvt_pk_u8_f32(fast_sigmoid(v1[j]) * 255.0f, j, b); }
                        if (bj == 0) { w16.x = a; w16.y = b; } else { w16.z = a; w16.w = b; }
                    } else {
                    u32x4 w; w.x = cvt_pk_bf16(v0[0], v0[1]); w.y = cvt_pk_bf16(v0[2], v0[3]); w.z = cvt_pk_bf16(v1[0], v1[1]); w.w = cvt_pk_bf16(v1[2], v1[3]);
                    *(u32x4*)(rowp + bj * HALF) = w; } }
                if (isg) *(u32x4*)((unsigned char*)SG + (size_t)(row0 + ai * HALF + m * 16) * SGW + (pn - QKVW / BM) * BM + wc * 64 + fq * 16) = w16; }
    }
};
struct EpiGate {
    static constexpr bool PERM = true, AFTER_DRAIN = false;
    __device__ static __forceinline__ bool keep(const Unit& u) { return u.kt0 + u.nt < DM / BK; }
    const bf16_t* SG; bf16_t* MXB;
    __device__ __forceinline__ void operator()(f32x4 (&acc)[2][2][4][2], const Unit& u, int wr, int wc, int fr, int fq) const {
        const int row0 = u.pm * BM + wr * 64 + fr, col0 = u.pn * BM + wc * 32 + 8 * fq;
        const bool lastbr = !keep(u); const int gc0 = (u.kt0 == 0 ? 0 : (u.kt0 == 24 ? DM : 2 * DM));
#pragma unroll
        for (int ai = 0; ai < 2; ++ai)
#pragma unroll
            for (int mp = 0; mp < 2; ++mp) {
                u32x4 gq[2], hq[2];
#pragma unroll
                for (int mm = 0; mm < 2; ++mm) { const unsigned char* rp = (const unsigned char*)SG + (size_t)(row0 + ai * HALF + (mp * 2 + mm) * 16) * SGW + gc0 + u.pn * BM + wc * 64 + fq * 16;
                    gq[mm] = *(const u32x4*)rp; if (!lastbr) hq[mm] = *(const u32x4*)(rp + DM); }
#pragma unroll
                for (int mm = 0; mm < 2; ++mm) { const int m = mp * 2 + mm;
#pragma unroll
                    for (int bj = 0; bj < 2; ++bj) { u32x2 a; a.x = bj ? gq[mm].z : gq[mm].x; a.y = bj ? gq[mm].w : gq[mm].y; f32x4 g[2];
#define GB(w_, j_) fmaxf((float)(((w_) >> (8 * (j_))) & 0xffu), 1e-18f)
#pragma unroll
                        for (int j = 0; j < 4; ++j) { g[0][j] = GB(a.x, j); g[1][j] = GB(a.y, j); }
                        if (!lastbr) { u32x2 h; h.x = bj ? hq[mm].z : hq[mm].x; h.y = bj ? hq[mm].w : hq[mm].y;
#pragma unroll
                            for (int j = 0; j < 4; ++j) { g[0][j] *= __builtin_amdgcn_rcpf(GB(h.x, j)); g[1][j] *= __builtin_amdgcn_rcpf(GB(h.y, j)); }
                            acc[ai][bj][m][0] = acc[ai][bj][m][0] * g[0]; acc[ai][bj][m][1] = acc[ai][bj][m][1] * g[1];
                        } else { const f32x4 v0 = acc[ai][bj][m][0] * (g[0] * (1.0f / 255.0f)), v1 = acc[ai][bj][m][1] * (g[1] * (1.0f / 255.0f)); u32x4 w; w.x = cvt_pk_bf16(v0[0], v0[1]); w.y = cvt_pk_bf16(v0[2], v0[3]); w.z = cvt_pk_bf16(v1[0], v1[1]); w.w = cvt_pk_bf16(v1[2], v1[3]);
                            *(u32x4*)(MXB + (size_t)(row0 + ai * HALF + m * 16) * DM + col0 + bj * HALF) = w; } } }
                asm volatile("" ::: "memory"); }
#undef GB
    }
};
struct GateOrder {
    StaticOrder S;
    __host__ __device__ __forceinline__ bool next(int i, Unit& u) const { const int ti = i / 3, br = i - 3 * ti; const bool ok = S.next(ti, u); u.kt0 = br * 24; u.nt = br == 2 ? 16 : 24; return ok; }
    __device__ __forceinline__ void a_ready(const Unit&) const {}
    __device__ __forceinline__ void done(const Unit&) const {}
};

template <class Epi, class Sched, bool ALIGN_EPI = false, bool SP2 = false, bool FP8 = false>
__device__ __forceinline__ void gemm_phase(PG8_LAS unsigned char* lds, const Gemm g, const Sched& S, const Epi& E, int wv  ) {
    int tid_ = tid_of(wv);
    const int tid = tid_, wid = wv, lane = tid & 63, wr = wid >> 2, wc = wid & 3, fr = lane & 15, fq = lane >> 4;
    const int K = g.K;
    unsigned voffA[2], voffB[2];
#pragma unroll
    for (int i = 0; i < 2; ++i) { int R, C; stage_rc(tid * 16 + i * 8192, R, C); const int Rb = Epi::PERM ? ((R & ~31) + perm32(R & 31)) : R;
        voffA[i] = (unsigned)(R * K + C) * 2u; voffB[i] = (unsigned)(Rb * K + C) * 2u; }
    const size_t kstep = (size_t)(BK * 2);
    const size_t hstep = (size_t)HALF * K * 2;
    const size_t tstep = 2 * hstep;
    const unsigned ldsw = (unsigned)wid * 1024u;
    const int aoff = lds_byte(wr * 64 + fr, fq * 8), boff = lds_byte(wc * 32 + fr, fq * 8);
#define PG8_SA(b, h) (((b) * 2 + (h)) * HTB)
#define PG8_SB(b, h) ((4 + (b) * 2 + (h)) * HTB)
#define PG8_STAGE(bufoff, gbase, voff) do { _Pragma("unroll") for (int _i = 0; _i < 2; ++_i) { unsigned vo_ = (voff)[_i]; asm volatile("" : "+v"(vo_));     \
        __builtin_amdgcn_global_load_lds((const unsigned*)((const char*)(gbase) + vo_), (PG8_LAS unsigned*)(lds + (bufoff) + ldsw + _i * 8192), 16, 0, 0); } } while (0)
#define PG8_LDA(dst, b, h) do { _Pragma("unroll") for (int m = 0; m < 4; ++m) _Pragma("unroll") for (int k = 0; k < 2; ++k) dst[m][k] = *(const PG8_LAS bf16x8*)(lds + PG8_SA(b, h) + aoff + m * 2048 + k * 1024); } while (0)
#define PG8_LDB(dst, b, h) do { _Pragma("unroll") for (int n = 0; n < 2; ++n) _Pragma("unroll") for (int k = 0; k < 2; ++k) dst[n][k] = *(const PG8_LAS bf16x8*)(lds + PG8_SB(b, h) + boff + n * 2048 + k * 1024); } while (0)
#define PG8_CAT(x, y) __builtin_shufflevector(__builtin_bit_cast(i32x4, x), __builtin_bit_cast(i32x4, y), 0, 1, 2, 3, 4, 5, 6, 7)
#define PG8_MMA(ai, bj, At, Bt) do { __builtin_amdgcn_s_setprio(1); _Pragma("unroll") for (int m = 0; m < 4; ++m) _Pragma("unroll") for (int n = 0; n < 2; ++n) { \
        if constexpr (FP8) acc[ai][bj][m][n] = __builtin_amdgcn_mfma_scale_f32_16x16x128_f8f6f4(PG8_CAT(Bt[n][0], Bt[n][1]), PG8_CAT(At[m][0], At[m][1]), acc[ai][bj][m][n], 0, 0, 0, 0x7F7F7F7F, 0, 0x7F7F7F7F); \
        else { _Pragma("unroll") for (int k = 0; k < 2; ++k) acc[ai][bj][m][n] = __builtin_amdgcn_mfma_f32_16x16x32_bf16(Bt[n][k], At[m][k], acc[ai][bj][m][n], 0, 0, 0); } } __builtin_amdgcn_s_setprio(0); } while (0)
#define PG8_WAIT_V(n) asm volatile("s_waitcnt vmcnt(" #n ")" ::: "memory")
#define PG8_WAIT_L(n) asm volatile("s_waitcnt lgkmcnt(" #n ")" ::: "memory")
#define PG8_BAR __builtin_amdgcn_s_barrier()
#define PG8_SCHED __builtin_amdgcn_sched_barrier(0)
    Unit cur, nxt; int ui = 0;
    if (!S.next(0, cur)) return;
    f32x4 acc[2][2][4][2];
#pragma unroll
    for (int a = 0; a < 2; ++a)
#pragma unroll
        for (int b = 0; b < 2; ++b)
#pragma unroll
            for (int m = 0; m < 4; ++m)
#pragma unroll
                for (int n = 0; n < 2; ++n) acc[a][b][m][n] = (f32x4){0.f, 0.f, 0.f, 0.f};
    bf16x8 At[4][2], B0[2][2], B1[2][2];
    const char* cA = (const char*)g.A + (size_t)cur.pm * tstep + (size_t)cur.kt0 * kstep; const char* cB = (const char*)g.Bt + (size_t)cur.pn * tstep + (size_t)cur.kt0 * kstep;
    S.a_ready(cur);
    if constexpr (SP2) {
        PG8_STAGE(PG8_SB(0, 0), cB, voffB); PG8_STAGE(PG8_SB(0, 1), cB + hstep, voffB); PG8_STAGE(PG8_SA(0, 0), cA, voffA); PG8_STAGE(PG8_SA(0, 1), cA + hstep, voffA);
        if (wr == 1) PG8_BAR;
        PG8_WAIT_V(2); PG8_BAR;
        PG8_STAGE(PG8_SB(1, 0), cB + kstep, voffB); PG8_STAGE(PG8_SA(1, 0), cA + kstep, voffA); PG8_STAGE(PG8_SB(1, 1), cB + hstep + kstep, voffB);
        PG8_WAIT_V(6); PG8_BAR;
    } else {
        PG8_STAGE(PG8_SB(0, 0), cB, voffB); PG8_STAGE(PG8_SA(0, 0), cA, voffA); PG8_STAGE(PG8_SB(0, 1), cB + hstep, voffB); PG8_STAGE(PG8_SA(0, 1), cA + hstep, voffA);
        if (wr == 1) PG8_BAR;
        PG8_WAIT_V(4); PG8_BAR;
        PG8_STAGE(PG8_SB(1, 0), cB + kstep, voffB); PG8_STAGE(PG8_SA(1, 0), cA + kstep, voffA); PG8_STAGE(PG8_SB(1, 1), cB + hstep + kstep, voffB);
        PG8_WAIT_V(6); PG8_BAR;
    }
    for (;;) {
        const bool has_next = S.next(ui + 1, nxt);
        const char* nA = has_next ? (const char*)g.A + (size_t)nxt.pm * tstep + (size_t)nxt.kt0 * kstep : cA; const char* nB = has_next ? (const char*)g.Bt + (size_t)nxt.pn * tstep + (size_t)nxt.kt0 * kstep : cB;
        const int nt = cur.nt;
        for (int t = 0; t < nt; t += 2) {
            const bool last = (t == nt - 2);
            const char* a1 = cA + (size_t)(t + 1) * kstep;
            const char* a2 = last ? nA : cA + (size_t)(t + 2) * kstep; const char* b2 = last ? nB : cB + (size_t)(t + 2) * kstep;
            const char* a3 = a2 + kstep; const char* b3 = b2 + kstep;
            if (last && has_next) S.a_ready(nxt);
            if constexpr (SP2) {
            PG8_LDB(B0, 0, 0); PG8_LDB(B1, 0, 1); PG8_SCHED; PG8_LDA(At, 0, 0); PG8_STAGE(PG8_SA(1, 1), a1 + hstep, voffA);
            PG8_WAIT_V(8); PG8_WAIT_L(0); PG8_BAR; PG8_MMA(0, 0, At, B0); PG8_MMA(0, 1, At, B1); PG8_BAR; PG8_SCHED;
            PG8_LDA(At, 0, 1); PG8_STAGE(PG8_SB(0, 0), b2, voffB); PG8_STAGE(PG8_SB(0, 1), b2 + hstep, voffB); PG8_STAGE(PG8_SA(0, 0), a2, voffA);
            PG8_WAIT_V(8); PG8_WAIT_L(0); PG8_BAR; PG8_MMA(1, 0, At, B0); PG8_MMA(1, 1, At, B1); PG8_BAR; PG8_SCHED;
            PG8_LDB(B0, 1, 0); PG8_LDB(B1, 1, 1); PG8_SCHED; PG8_LDA(At, 1, 0); PG8_STAGE(PG8_SA(0, 1), a2 + hstep, voffA);
            PG8_WAIT_V(8); PG8_WAIT_L(0); PG8_BAR; PG8_MMA(0, 0, At, B0); PG8_MMA(0, 1, At, B1); PG8_BAR; PG8_SCHED;
            PG8_LDA(At, 1, 1); PG8_STAGE(PG8_SB(1, 0), b3, voffB); PG8_STAGE(PG8_SB(1, 1), b3 + hstep, voffB); PG8_STAGE(PG8_SA(1, 0), a3, voffA);
            PG8_WAIT_V(8); PG8_WAIT_L(0); PG8_BAR; PG8_MMA(1, 0, At, B0); PG8_MMA(1, 1, At, B1); PG8_BAR; PG8_SCHED;
            } else {
            PG8_LDB(B0, 0, 0); PG8_SCHED; PG8_LDA(At, 0, 0); PG8_STAGE(PG8_SA(1, 1), a1 + hstep, voffA);
            PG8_WAIT_L(8); PG8_BAR; PG8_WAIT_L(0); PG8_MMA(0, 0, At, B0); PG8_BAR; PG8_SCHED;
            PG8_LDB(B1, 0, 1); PG8_STAGE(PG8_SB(0, 0), b2, voffB);
            PG8_BAR; PG8_WAIT_L(0); PG8_MMA(0, 1, At, B1); PG8_BAR;
            PG8_LDA(At, 0, 1); PG8_STAGE(PG8_SA(0, 0), a2, voffA);
            PG8_BAR; PG8_WAIT_L(0); PG8_MMA(1, 0, At, B0); PG8_BAR; PG8_SCHED;
            PG8_STAGE(PG8_SB(0, 1), b2 + hstep, voffB);
            PG8_WAIT_V(6); PG8_BAR; PG8_MMA(1, 1, At, B1); PG8_BAR;
            PG8_LDB(B0, 1, 0); PG8_SCHED; PG8_LDA(At, 1, 0); PG8_STAGE(PG8_SA(0, 1), a2 + hstep, voffA);
            PG8_WAIT_L(8); PG8_BAR; PG8_WAIT_L(0); PG8_MMA(0, 0, At, B0); PG8_BAR; PG8_SCHED;
            PG8_LDB(B1, 1, 1); PG8_STAGE(PG8_SB(1, 0), b3, voffB);
            PG8_BAR; PG8_WAIT_L(0); PG8_MMA(0, 1, At, B1); PG8_BAR;
            PG8_LDA(At, 1, 1); PG8_STAGE(PG8_SA(1, 0), a3, voffA);
            PG8_BAR; PG8_WAIT_L(0); PG8_MMA(1, 0, At, B0); PG8_BAR; PG8_SCHED;
            PG8_STAGE(PG8_SB(1, 1), b3 + hstep, voffB);
            PG8_WAIT_V(6); PG8_BAR; PG8_MMA(1, 1, At, B1); PG8_BAR;
            }
        }
        if constexpr (ALIGN_EPI) { if (wr == 0) PG8_BAR; }
        if constexpr (!Epi::AFTER_DRAIN) { const int t_e = tid_of(wv); const int fr_e = t_e & 15, fq_e = (t_e & 63) >> 4;
            E(acc, cur, wr, wc, fr_e, fq_e); S.done(cur); }
        if (!has_next) break;
        if (!Epi::keep(cur))
#pragma unroll
        for (int a = 0; a < 2; ++a)
#pragma unroll
            for (int b = 0; b < 2; ++b)
#pragma unroll
                for (int m = 0; m < 4; ++m)
#pragma unroll
                    for (int n = 0; n < 2; ++n) acc[a][b][m][n] = (f32x4){0.f, 0.f, 0.f, 0.f};
        cur = nxt; cA = nA; cB = nB; ++ui;
        if constexpr (ALIGN_EPI) { if (wr == 1) PG8_BAR; }
    }
    PG8_WAIT_V(0);
    if constexpr (!ALIGN_EPI) { if (wr == 0) PG8_BAR; }
    PG8_BAR;
#undef PG8_SA
#undef PG8_SB
#undef PG8_STAGE
#undef PG8_LDA
#undef PG8_LDB
#undef PG8_MMA
#undef PG8_CAT
#undef PG8_WAIT_V
#undef PG8_WAIT_L
#undef PG8_BAR
#undef PG8_SCHED
}
}

namespace att {
using bf16x8 = __attribute__((ext_vector_type(8))) short;
using s16x4  = __attribute__((ext_vector_type(4))) short;
using f32x16 = __attribute__((ext_vector_type(16))) float;
using u32x4  = __attribute__((ext_vector_type(4))) unsigned;
constexpr int NW = 8, QBLK = 32, KVBLK = 64;
constexpr int SHM_V = 16384, SHM_K = 16384;
constexpr int OFF_V = 0, OFF_K = 2 * SHM_V, OFF_WS = OFF_K + 2 * SHM_K, OFF_BIAS = OFF_WS + 2048, OFF_SLOT = OFF_BIAS + 2048, ATT_LDS = OFF_SLOT + 64;
constexpr float THR = 8.f;
constexpr int LD = QKVW;
#define KSWZ128(row, colB) ((row) * 256 + ((colB) ^ (((row) & 7) << 4)))
#define KSWZ64(row, colB) ((row) * 128 + ((colB) ^ ((((row) >> 1) & 7) << 4)))
#define SBAR() __builtin_amdgcn_sched_barrier(0)
__device__ __forceinline__ int crow(int r, int hi) { return (r & 3) + 8 * (r >> 2) + 4 * hi; }
__device__ __forceinline__ unsigned cvtpk(float lo, float hi) { unsigned r; asm volatile("v_cvt_pk_bf16_f32 %0, %1, %2" : "=v"(r) : "v"(lo), "v"(hi)); return r; }

struct Unit {
    const u16* Q;
    const u16* K;
    const u16* V;
    u16* O; int ldo;
    int NT, n0, base0, base1;
    int r0, first;
    const float* qgain;
    const float* qrope; int t0;
};

template <int DQK>
__device__ __forceinline__ void partialSM(f32x16& p0, f32x16& p1, float& m_reg, float& mn, float& alpha) {
  constexpr float SCALE = DQK == 128 ? 0.08838834764831845f : 0.125f;
  constexpr float C = SCALE * 1.4426950408889634f;
  float pmax = p0[0];
#pragma unroll
  for (int r = 1; r < 16; ++r) pmax = fmaxf(pmax, p0[r]);
#pragma unroll
  for (int r = 0; r < 16; ++r) pmax = fmaxf(pmax, p1[r]);
  { auto rr = __builtin_amdgcn_permlane32_swap(__float_as_uint(pmax), __float_as_uint(pmax), false, false);
    pmax = fmaxf(__uint_as_float(rr[0]), __uint_as_float(rr[1])); }
  if (__builtin_expect(__all(pmax - m_reg <= THR / SCALE), 1)) { mn = m_reg; alpha = 1.f; }
  else { mn = fmaxf(m_reg, pmax); alpha = __builtin_amdgcn_exp2f((m_reg - mn) * C); m_reg = mn; }
  float mnC = -mn * C;
#pragma unroll
  for (int r = 0; r < 16; ++r) p0[r] = fmaf(p0[r], C, mnC);
#pragma unroll
  for (int r = 0; r < 16; ++r) p1[r] = fmaf(p1[r], C, mnC);
#pragma unroll
  for (int r = 0; r < 16; ++r) p0[r] = __builtin_amdgcn_exp2f(p0[r]);
}
__device__ __forceinline__ void finishSM(f32x16& p0, f32x16& p1, float alpha, float& l_reg, bf16x8& pa0, bf16x8& pa1, bf16x8& pa2, bf16x8& pa3) {
#pragma unroll
  for (int r = 0; r < 16; ++r) p1[r] = __builtin_amdgcn_exp2f(p1[r]);
  float ps = 0;
#pragma unroll
  for (int r = 0; r < 16; ++r) ps += p0[r];
#pragma unroll
  for (int r = 0; r < 16; ++r) ps += p1[r];
  { auto rr = __builtin_amdgcn_permlane32_swap(__float_as_uint(ps), __float_as_uint(ps), false, false);
    ps = __uint_as_float(rr[0]) + __uint_as_float(rr[1]); }
  l_reg = l_reg * alpha + ps;
#define PK4(P, BASE, OUT) do { unsigned a0 = cvtpk(P[BASE + 0], P[BASE + 1]), a1 = cvtpk(P[BASE + 2], P[BASE + 3]);   \
    unsigned b0 = cvtpk(P[BASE + 4], P[BASE + 5]), b1 = cvtpk(P[BASE + 6], P[BASE + 7]);                              \
    auto r0 = __builtin_amdgcn_permlane32_swap(a0, b0, false, false); auto r1 = __builtin_amdgcn_permlane32_swap(a1, b1, false, false); \
    u32x4 w = {r0[0], r1[0], r0[1], r1[1]}; OUT = *reinterpret_cast<bf16x8*>(&w); } while (0)
  PK4(p0, 0, pa0); PK4(p0, 8, pa1); PK4(p1, 0, pa2); PK4(p1, 8, pa3);
#undef PK4
}
template <int DQK>
__device__ __forceinline__ void qkt(f32x16& p0, f32x16& p1, const char* Ks, const bf16x8* qr, int r32, int hi) {
  p0 = f32x16{}; p1 = f32x16{};
#pragma unroll
  for (int d0 = 0; d0 < DQK / 16; ++d0) { const int cb = (d0 * 16 + hi * 8) * 2;
    bf16x8 b0, b1;
    if constexpr (DQK == 128) { b0 = *reinterpret_cast<const bf16x8*>(Ks + KSWZ128(r32, cb)); b1 = *reinterpret_cast<const bf16x8*>(Ks + KSWZ128(32 + r32, cb)); }
    else                      { b0 = *reinterpret_cast<const bf16x8*>(Ks + KSWZ64(r32, cb));  b1 = *reinterpret_cast<const bf16x8*>(Ks + KSWZ64(32 + r32, cb)); }
    p0 = __builtin_amdgcn_mfma_f32_32x32x16_bf16(b0, qr[d0], p0, 0, 0, 0);
    p1 = __builtin_amdgcn_mfma_f32_32x32x16_bf16(b1, qr[d0], p1, 0, 0, 0); }
}
__device__ __forceinline__ int v_st(int k, int c) { const int kk = (k & ~0xC) | ((k & 4) << 1) | ((k & 8) >> 1); return ((kk >> 3) * 4 + (c >> 5)) * 512 + ((kk & 7) * 32 + (c & 31)) * 2; }
__device__ __forceinline__ int v_rd_base(int lane) { return ((lane & 3) << 3) | (((lane >> 2) & 3) << 6) | (((lane >> 4) & 1) << 5) | (((lane >> 5) & 1) << 8); }
constexpr int v_rd_off(int d0, int ks, int half) { return d0 * 512 + ks * 4096 + half * 2048; }
template <int OFF> __device__ __forceinline__ s16x4 tr_read(int vb) {
  s16x4 r; asm volatile("ds_read_b64_tr_b16 %0, %1 offset:%2" : "=&v"(r) : "v"(vb), "i"(OFF) : "memory"); return r;
}
template <int D0> __device__ __forceinline__ void pv_one(f32x16& od, int vb, bf16x8 pa0, bf16x8 pa1, bf16x8 pa2, bf16x8 pa3) {
  const s16x4 l0 = tr_read<v_rd_off(D0, 0, 0)>(vb), h0 = tr_read<v_rd_off(D0, 0, 1)>(vb), l1 = tr_read<v_rd_off(D0, 1, 0)>(vb), h1 = tr_read<v_rd_off(D0, 1, 1)>(vb);
  const s16x4 l2 = tr_read<v_rd_off(D0, 2, 0)>(vb), h2 = tr_read<v_rd_off(D0, 2, 1)>(vb), l3 = tr_read<v_rd_off(D0, 3, 0)>(vb), h3 = tr_read<v_rd_off(D0, 3, 1)>(vb);
  asm volatile("s_waitcnt lgkmcnt(0)" ::: "memory"); SBAR();
#define PK(L, H) (bf16x8){L[0], L[1], L[2], L[3], H[0], H[1], H[2], H[3]}
  od = __builtin_amdgcn_mfma_f32_32x32x16_bf16(pa0, PK(l0, h0), od, 0, 0, 0);
  od = __builtin_amdgcn_mfma_f32_32x32x16_bf16(pa1, PK(l1, h1), od, 0, 0, 0);
  od = __builtin_amdgcn_mfma_f32_32x32x16_bf16(pa2, PK(l2, h2), od, 0, 0, 0);
  od = __builtin_amdgcn_mfma_f32_32x32x16_bf16(pa3, PK(l3, h3), od, 0, 0, 0);
#undef PK
}
__device__ __forceinline__ void pv_d0(f32x16* o, int vb, bf16x8 pa0, bf16x8 pa1, bf16x8 pa2, bf16x8 pa3) {
  pv_one<0>(o[0], vb, pa0, pa1, pa2, pa3); pv_one<1>(o[1], vb, pa0, pa1, pa2, pa3); pv_one<2>(o[2], vb, pa0, pa1, pa2, pa3); pv_one<3>(o[3], vb, pa0, pa1, pa2, pa3);
}

template <int DQK, int MODE, int SD>
__device__ __forceinline__ void attn_unit(const Unit& U, char* lds, int wv) {
  constexpr int ND = DQK / 16;
  int tid_ = tid_of(wv);
  const int tid = tid_, wid = wv, lane = tid & 63, r32 = lane & 31, hi = lane >> 5;
  char* V_lds = lds + OFF_V; char* K_lds = lds + OFF_K;
  float* ws = (float*)(lds + OFF_WS) + wid * 64; float* li_l = ws; float* al_l = ws + 32;
  const float* biasq = (const float*)(lds + OFF_BIAS);
  float m_reg = -1e30f, l_reg = 0; f32x16 o[4] = {}; bf16x8 qr[ND];
  { const char* Qw = (const char*)U.Q + (unsigned)(((wid * QBLK + r32) * LD + hi * 8) * 2);
#pragma unroll
    for (int d0 = 0; d0 < ND; ++d0) qr[d0] = *reinterpret_cast<const bf16x8*>(Qw + d0 * 32);
    float ssq = 0.f;
#pragma unroll
    for (int d0 = 0; d0 < ND; ++d0) { const u32x4 w = *reinterpret_cast<const u32x4*>(&qr[d0]);
#pragma unroll
      for (int e = 0; e < 4; ++e) { const float a = bf_lo(w[e]), b = bf_hi(w[e]); ssq += a * a + b * b; } }
    { auto rr = __builtin_amdgcn_permlane32_swap(__float_as_uint(ssq), __float_as_uint(ssq), false, false); ssq = __uint_as_float(rr[0]) + __uint_as_float(rr[1]); }
    const float rstdq = 1.0f / sqrtf(ssq * (1.0f / DQK) + EPS);
    const int tq = U.t0 + wid * QBLK + r32, gq = (tq >> 6) & 63, cq = tq & 63; constexpr int NP = DQK / 4;
#pragma unroll
    for (int d0 = 0; d0 < ND; ++d0) { const u32x4 w = *reinterpret_cast<const u32x4*>(&qr[d0]); const int dd = d0 * 16 + hi * 8;
      const f32x4 g0 = *(const f32x4*)(U.qgain + dd), g1 = *(const f32x4*)(U.qgain + dd + 4);
      float x[8]; x[0] = bf_lo(w[0]) * rstdq * g0[0]; x[1] = bf_hi(w[0]) * rstdq * g0[1]; x[2] = bf_lo(w[1]) * rstdq * g0[2]; x[3] = bf_hi(w[1]) * rstdq * g0[3];
      x[4] = bf_lo(w[2]) * rstdq * g1[0]; x[5] = bf_hi(w[2]) * rstdq * g1[1]; x[6] = bf_lo(w[3]) * rstdq * g1[2]; x[7] = bf_hi(w[3]) * rstdq * g1[3];
      if (U.qrope != nullptr) { const int i0 = dd >> 1; const float* tp = U.qrope + 2 * ((i0 < NP) ? gq * NP + i0 : cq * NP + i0 - NP);
        const f32x4 c01 = *(const f32x4*)tp, c23 = *(const f32x4*)(tp + 4); float y;
        y = x[0] * c01[0] - x[1] * c01[1]; x[1] = x[0] * c01[1] + x[1] * c01[0]; x[0] = y;
        y = x[2] * c01[2] - x[3] * c01[3]; x[3] = x[2] * c01[3] + x[3] * c01[2]; x[2] = y;
        y = x[4] * c23[0] - x[5] * c23[1]; x[5] = x[4] * c23[1] + x[5] * c23[0]; x[4] = y;
        y = x[6] * c23[2] - x[7] * c23[3]; x[7] = x[6] * c23[3] + x[7] * c23[2]; x[6] = y; }
      u32x4 o = {cvtpk(x[0], x[1]), cvtpk(x[2], x[3]), cvtpk(x[4], x[5]), cvtpk(x[6], x[7])}; qr[d0] = *reinterpret_cast<bf16x8*>(&o); } }
  const int sr = tid >> 4, sc = (tid & 15) * 8, vst0 = v_st(sr, sc), vst1 = v_st(32 + sr, sc);
  const int kr64 = tid >> 3, kc64 = (tid & 7) * 8;
  const unsigned gofs = (unsigned)((sr * LD + sc) * 2), gofs64 = (unsigned)((kr64 * LD + kc64) * 2);
  const int vb0 = (int)(uintptr_t)V_lds + v_rd_base(lane);
  struct { bf16x8 vs0, vs1, ks0, ks1; } sr_[SD];
  const int n0 = U.n0, base0 = U.base0, base1 = U.base1;
#define TROW(j) ((j) < n0 ? base0 + 64 * (j) : base1 + 64 * ((j) - n0))
#define SLOAD(i, j) do { const size_t tb_ = (size_t)(TROW(j)) * (LD * 2); const char* vp_ = (const char*)U.V + tb_; const char* kp_ = (const char*)U.K + tb_; \
    sr_[i].vs0 = *reinterpret_cast<const bf16x8*>(vp_ + gofs); sr_[i].vs1 = *reinterpret_cast<const bf16x8*>(vp_ + 32 * LD * 2 + gofs); \
    if constexpr (DQK == 128) { sr_[i].ks0 = *reinterpret_cast<const bf16x8*>(kp_ + gofs); sr_[i].ks1 = *reinterpret_cast<const bf16x8*>(kp_ + 32 * LD * 2 + gofs); } \
    else { sr_[i].ks0 = *reinterpret_cast<const bf16x8*>(kp_ + gofs64); } } while (0)
#define SWRITE(b, i) do { *(bf16x8*)(V_lds + (b) * SHM_V + vst0) = sr_[i].vs0; *(bf16x8*)(V_lds + (b) * SHM_V + vst1) = sr_[i].vs1; \
    if constexpr (DQK == 128) { const int kc = sc * 2; *(bf16x8*)(K_lds + (b) * SHM_K + KSWZ128(sr, kc)) = sr_[i].ks0; *(bf16x8*)(K_lds + (b) * SHM_K + KSWZ128(32 + sr, kc)) = sr_[i].ks1; } \
    else { *(bf16x8*)(K_lds + (b) * SHM_K + KSWZ64(kr64, kc64 * 2)) = sr_[i].ks0; } } while (0)
#define SWAIT() do { if constexpr (SD == 1) asm volatile("s_waitcnt vmcnt(0)" ::: "memory"); else if constexpr (DQK == 128) asm volatile("s_waitcnt vmcnt(4)" ::: "memory"); else asm volatile("s_waitcnt vmcnt(3)" ::: "memory"); } while (0)
#define RESC(a) do { if (__any((a) < 1.f)) { if (hi == 0) al_l[r32] = (a); asm volatile("s_waitcnt lgkmcnt(0)" ::: "memory"); \
    _Pragma("unroll") for (int d = 0; d < 4; ++d) _Pragma("unroll") for (int r = 0; r < 16; ++r) o[d][r] *= al_l[crow(r, hi)]; } } while (0)
#define MASK(P0, P1, j) do { if constexpr (MODE == 1) { if ((j) >= n0) { const int kr_ = U.first + ((j) - n0); \
      const int qgr_ = U.r0 + (wid >> 1), qc_ = 32 * (wid & 1) + r32, rs_ = min(max(qgr_ - 4, 0), 56), cs_ = min(max(qc_ - 8, 0), 48); \
      if ((unsigned)(kr_ - rs_) < 8u) { const float* brow_ = biasq + (kr_ - qgr_ + 7) * 31 + 15 - qc_; \
        _Pragma("unroll") for (int r = 0; r < 16; ++r) { const int kc_ = crow(r, hi); \
          P0[r] = ((unsigned)(kc_ - cs_) < 16u) ? P0[r] + brow_[kc_] : -__builtin_inff(); \
          P1[r] = ((unsigned)(kc_ + 32 - cs_) < 16u) ? P1[r] + brow_[kc_ + 32] : -__builtin_inff(); } } \
      else { _Pragma("unroll") for (int r = 0; r < 16; ++r) { P0[r] = -__builtin_inff(); P1[r] = -__builtin_inff(); } } } } } while (0)
  f32x16 pA0, pA1, pB0, pB1; float mnA, mnB, alA, alB; bf16x8 pa0, pa1, pa2, pa3; const int NT = U.NT;
  constexpr int SE = 0, SO = SD - 1;
  SLOAD(SE, 0); asm volatile("s_waitcnt vmcnt(0)" ::: "memory"); SWRITE(0, SE); __syncthreads();
  qkt<DQK>(pA0, pA1, K_lds, qr, r32, hi); MASK(pA0, pA1, 0); partialSM<DQK>(pA0, pA1, m_reg, mnA, alA);
  SLOAD(SO, 1); if constexpr (SD == 2) { if (2 < NT) SLOAD(SE, 2); }
  SWAIT(); SWRITE(1, SO); __syncthreads();
  for (int j = 1; j + 1 < NT; j += 2) {
    SBAR(); qkt<DQK>(pB0, pB1, K_lds + SHM_K, qr, r32, hi);
    finishSM(pA0, pA1, alA, l_reg, pa0, pa1, pa2, pa3); SBAR();
    SLOAD(SO, j + SD); SBAR();
    pv_d0(o, vb0, pa0, pa1, pa2, pa3); MASK(pB0, pB1, j); partialSM<DQK>(pB0, pB1, m_reg, mnB, alB);
    __syncthreads(); SWAIT(); SWRITE(0, SE);
    RESC(alB); __syncthreads();
    SBAR(); qkt<DQK>(pA0, pA1, K_lds, qr, r32, hi);
    finishSM(pB0, pB1, alB, l_reg, pa0, pa1, pa2, pa3); SBAR();
    if (SD == 1 || j + 3 < NT) SLOAD(SE, j + 1 + SD); SBAR();
    pv_d0(o, vb0 + SHM_V, pa0, pa1, pa2, pa3); MASK(pA0, pA1, j + 1); partialSM<DQK>(pA0, pA1, m_reg, mnA, alA);
    __syncthreads(); SWAIT(); SWRITE(1, SO);
    RESC(alA); __syncthreads();
  }
  SBAR(); qkt<DQK>(pB0, pB1, K_lds + SHM_K, qr, r32, hi);
  finishSM(pA0, pA1, alA, l_reg, pa0, pa1, pa2, pa3); SBAR();
  pv_d0(o, vb0, pa0, pa1, pa2, pa3); MASK(pB0, pB1, NT - 1); partialSM<DQK>(pB0, pB1, m_reg, mnB, alB);
  __syncthreads(); RESC(alB);
  finishSM(pB0, pB1, alB, l_reg, pa0, pa1, pa2, pa3); SBAR();
  pv_d0(o, vb0 + SHM_V, pa0, pa1, pa2, pa3);
  if (hi == 0) li_l[r32] = l_reg; asm volatile("s_waitcnt lgkmcnt(0)" ::: "memory");
  char* Ow = (char*)U.O + (size_t)(wid * QBLK) * U.ldo * 2;
  __syncthreads();
  { char* Os = lds + wid * 8192;
#pragma unroll
    for (int r = 0; r < 16; ++r) { const int orow = crow(r, hi); const float rl = __builtin_amdgcn_rcpf(li_l[orow]);
#pragma unroll
      for (int d0 = 0; d0 < 4; ++d0) *(u16*)(Os + orow * 256 + (d0 * 32 + r32) * 2) = (u16)f2bf(o[d0][r] * rl); }
    asm volatile("s_waitcnt lgkmcnt(0)" ::: "memory");
#pragma unroll
    for (int i = 0; i < 8; ++i) { const int row = i * 4 + (lane >> 4); const v4u v = *(const v4u*)(Os + row * 256 + (lane & 15) * 16); *(v4u*)(Ow + (size_t)row * U.ldo * 2 + (lane & 15) * 16) = v; } }
#undef TROW
#undef SLOAD
#undef SWRITE
#undef SWAIT
#undef RESC
#undef MASK
}
#undef SBAR
}

constexpr size_t MiB = 1u << 20;
constexpr size_t al1(size_t x) { return (x + MiB - 1) / MiB * MiB; }
constexpr size_t WS_CTL = 0, CTL_ZERO_BYTES = 8 * MiB;
constexpr size_t WS_MOD = 1 * MiB;
constexpr size_t WS_ROWSS = 2 * MiB;
constexpr size_t WS_SW = 4 * MiB;
constexpr int SW_STRIDE = 3 * INW;
constexpr size_t WS_MISC = 8 * MiB;
constexpr size_t WS_XC = 9 * MiB;
constexpr size_t WS_HN = WS_XC + al1((size_t)NB * CTXL * DM * 4);
constexpr size_t WS_HD = WS_HN + al1((size_t)MROWS * DM * 2);
constexpr size_t WS_QKV = WS_HD + al1((size_t)MROWS * FFN * 2);
constexpr size_t WS_SG = WS_QKV + al1((size_t)MROWS * QKVW * 2);
constexpr size_t WS_OCAT = WS_SG + al1((size_t)MROWS * SGW * 2);
constexpr size_t WS_OCR = WS_OCAT + al1((size_t)MROWS * DM * 2);
constexpr size_t WS_MX = WS_OCR + al1((size_t)MROWS * 2048 * 2);
constexpr size_t WS_MXB = WS_MX + al1((size_t)MROWS * DM * 4);
constexpr size_t WS_PART = WS_MXB + al1((size_t)MROWS * DM * 2);
constexpr size_t WS_W = WS_PART + al1((size_t)8 * NB * CTXL * DM * 4);
constexpr size_t WO_1IN = 0, WO_1OUT = WO_1IN + (size_t)2 * FFN * DM * 2, WO_2IN = WO_1OUT + (size_t)DM * FFN * 2, WO_2OUT = WO_2IN + (size_t)2 * FFN * DM * 2,
                 WO_IN = WO_2OUT + (size_t)DM * FFN * 2, WO_BR = WO_IN + (size_t)INW * DM * 2  ,
                 WO_OUT = WO_BR + (size_t)DM * DM * 2, W_LAYER = WO_OUT + (size_t)DM * DM * 2;
constexpr size_t WS_W8 = WS_W + DEPTH * W_LAYER;
constexpr size_t W8_LAYER = (size_t)INW * DM;
constexpr size_t WS_XG8 = WS_W8 + DEPTH * W8_LAYER;
constexpr size_t WS_END = WS_XG8 + al1((size_t)MROWS * DM);
static_assert((WS_XG8 & (MiB - 1)) == 0 && WS_ROWSS + (size_t)DEPTH * 3 * MROWS * 4 <= WS_SW && WS_SW + (size_t)DEPTH * 3 * SW_STRIDE * 4 <= CTL_ZERO_BYTES && WS_MX == pg8::EpiResid::WS_XP_OFF && WS_PART == pg8::EpiResid::WS_PART_OFF && WS_HN == pg8::EpiResid::WS_HN_OFF && WS_MOD + (size_t)DEPTH * 3 * MODW * 4 < ((size_t)1 << 32), "EpiResid's workspace offsets");
constexpr int MI_TA = 0, MI_TC = 64 * 32 * 2, MI_LAM = MI_TC + 64 * 16 * 2;
constexpr int CW_TMO = 0, CW_BAR = 4096, CW_ATTQ = 16384;

constexpr int RING_OFF = 0, RING_BYTES = 131072;
constexpr int LDSCTL_OFF = RING_BYTES, MISC_OFF = LDSCTL_OFF + 320;
constexpr int LDS_BYTES = 147456;
constexpr int NWAVES = 8;

#define XB_TMO      128
#define XB_XCNT(j)  (256  + 64 * (j))
#define XB_XSUB(j)  (1280 + 64 * (j))
#define XB_XGEN(j)  (2304 + 64 * (j))
#define XB_TOP      3328
#define XB_TOPGEN   3392
#define XCD_BAR_WORDS 3456
#define XB_SPIN_CAP (1u << 18)

__device__ __forceinline__ unsigned xb_ld(unsigned* p)              { return __hip_atomic_load(p, __ATOMIC_RELAXED, __HIP_MEMORY_SCOPE_AGENT); }
__device__ __forceinline__ unsigned xb_add(unsigned* p, unsigned v) { return __hip_atomic_fetch_add(p, v, __ATOMIC_RELAXED, __HIP_MEMORY_SCOPE_AGENT); }
__device__ __forceinline__ unsigned xb_xcc_id() { return (unsigned)__builtin_amdgcn_s_getreg((3 << 11) | 20) & 0xFu; }
#define XB_SPIN(cond, bar) do { unsigned _sp = 0; while (cond) { __builtin_amdgcn_s_sleep(1); \
    if ((++_sp & 255u) == 0u) { if (xb_ld(&(bar)[XB_TMO])) break; if (_sp > XB_SPIN_CAP) { atomicAdd(&(bar)[XB_TMO], 1u); break; } } } } while (0)

struct XcdBarrier {
    unsigned* bar; unsigned x;
    volatile LAS unsigned* st;
};
__device__ __forceinline__ XcdBarrier xcd_barrier_post(unsigned* bar, volatile LAS unsigned* st, bool lead  ) {
    XcdBarrier b; b.bar = bar; b.x = xb_xcc_id(); b.st = st;
    if (lead) (void)xb_add(&bar[XB_XCNT(b.x)], 1u);
    return b;
}
__device__ __forceinline__ void xcd_barrier_complete(unsigned* bar, unsigned x, unsigned& nloc, unsigned& nx) {
    const unsigned G = gridDim.x * gridDim.y * gridDim.z;
    unsigned sum, cnt, mine, sp = 0u;
    for (;;) {
        sum = 0u; cnt = 0u; mine = 0u;
#pragma unroll
        for (unsigned j = 0; j < 16; ++j) { const unsigned c = xb_ld(&bar[XB_XCNT(j)]); sum += c; cnt += (c > 0u) ? 1u : 0u; mine = (j == x) ? c : mine; }
        if (sum == G) break;
        __builtin_amdgcn_s_sleep(1);
        if ((++sp & 255u) == 0u) { if (xb_ld(&bar[XB_TMO])) break; if (sp > XB_SPIN_CAP) { atomicAdd(&bar[XB_TMO], 1u); break; } }
    }
    nloc = mine > 0u ? mine : 1u; nx = cnt > 0u ? cnt : 1u;
}
__device__ __forceinline__ void xcd_barrier(const XcdBarrier& b, bool lead  ) {
    asm volatile("s_waitcnt vmcnt(0)" ::: "memory");
    __syncthreads();
    if (lead) {
        unsigned* bar = b.bar;
        __builtin_amdgcn_s_waitcnt(0);
        unsigned nloc = b.st[0], nx = b.st[1];
        if (nloc == 0u) { xcd_barrier_complete(bar, b.x, nloc, nx); b.st[0] = nloc; b.st[1] = nx; }
        const unsigned old = xb_add(&bar[XB_XSUB(b.x)], 1u);
        const unsigned gen = old / nloc;
        if (old + 1u == (gen + 1u) * nloc) {
            __builtin_amdgcn_fence(__ATOMIC_RELEASE, "agent");
            asm volatile("s_waitcnt vmcnt(0)" ::: "memory");
            const unsigned og = xb_add(&bar[XB_TOP], 1u);
            const unsigned tg = og / nx;
            if (og + 1u == (tg + 1u) * nx) xb_add(&bar[XB_TOPGEN], 1u);
            else XB_SPIN(xb_ld(&bar[XB_TOPGEN]) == tg, bar);
            __builtin_amdgcn_fence(__ATOMIC_ACQUIRE, "agent");
            xb_add(&bar[XB_XGEN(b.x)], 1u);
            asm volatile("s_waitcnt vmcnt(0)" ::: "memory");
        } else {
            XB_SPIN(xb_ld(&bar[XB_XGEN(b.x)]) == gen, bar);
            __builtin_amdgcn_fence(__ATOMIC_ACQUIRE, "agent");
            asm volatile("s_waitcnt vmcnt(0)" ::: "memory");
        }
    }
    __syncthreads();
}

struct Args {
    const float* in[22];
    float* out; unsigned char* ws;
    int ph_lo, ph_hi;
};
struct Frame {
    LAS unsigned char* lds;
    volatile LAS unsigned* MISC;
    gu32* ctl;
    int tid, lane, wave, vcu, G;
};
template <int X> __device__ __forceinline__ float swz_xor(float v) { return __builtin_bit_cast(float, __builtin_amdgcn_ds_swizzle(__builtin_bit_cast(int, v), (X << 10) | 0x1f)); }
__device__ __forceinline__ float sum16(float v) { v += swz_xor<1>(v); v += swz_xor<2>(v); v += swz_xor<4>(v); v += swz_xor<8>(v); return v; }
__device__ __forceinline__ float sum8(float v) { v += swz_xor<1>(v); v += swz_xor<2>(v); v += swz_xor<4>(v); return v; }
__device__ __forceinline__ float wave_sum(float v) {
    v = sum16(v); v += swz_xor<16>(v);
    const float lo = __builtin_bit_cast(float, __builtin_amdgcn_readlane(__builtin_bit_cast(int, v), 0)), hi = __builtin_bit_cast(float, __builtin_amdgcn_readlane(__builtin_bit_cast(int, v), 32));
    return lo + hi;
}
template <int NKB>
__device__ __forceinline__ void p0_transpose_item(const float* W, int K, int Nsrc, u16* WT, int Kdst, int nblk, int smap, LAS float* scr, int item, int lane, const float* shift, float* sw, int Nsw, unsigned char* W8 = nullptr) {
    const int kbg = item / nblk, nb = item - kbg * nblk, n0 = 32 * nb;
    const int s0 = smap ? (((n0 & 255) >> 7) * FFN + (n0 >> 8) * 128 + (n0 & 127)) : n0;
    float a0 = 0.f, a1 = 0.f, a2 = 0.f;
    for (int kq = 0; kq < NKB; ++kq) {
        const int k0 = 64 * (kbg * NKB + kq);
        { f32x4 v[8];
#pragma unroll
          for (int i = 0; i < 8; ++i) v[i] = __builtin_nontemporal_load((const f32x4*)(W + (size_t)(k0 + 8 * i + (lane >> 3)) * Nsrc + s0 + (lane & 7) * 4));
#pragma unroll
          for (int i = 0; i < 8; ++i) { LAS float* d = scr + (8 * i + (lane >> 3)) * 33 + (lane & 7) * 4; d[0] = v[i].x; d[1] = v[i].y; d[2] = v[i].z; d[3] = v[i].w; } }
        if (NKB > 1) { scr[2112 + lane] = shift[k0 + lane]; scr[2176 + lane] = shift[MODW + k0 + lane]; scr[2240 + lane] = shift[2 * MODW + k0 + lane]; }
        LDS_WAIT(); asm volatile("" ::: "memory");
        const int c = lane & 7;
#pragma unroll
        for (int j = 0; j < 4; ++j) { const int n = (lane >> 3) + 8 * j; const LAS float* s = scr + (8 * c) * 33 + n;
            if (W8 != nullptr) {
                v2u o; o.x = pk4_fp8(s[0 * 33] * 64.f, s[1 * 33] * 64.f, s[2 * 33] * 64.f, s[3 * 33] * 64.f); o.y = pk4_fp8(s[4 * 33] * 64.f, s[5 * 33] * 64.f, s[6 * 33] * 64.f, s[7 * 33] * 64.f);
                *(GAS v2u*)(W8 + (size_t)(n0 + n) * Kdst + k0 + 8 * c) = o;
            } else {
            v4u o; o.x = pk2(s[0 * 33], s[1 * 33]); o.y = pk2(s[2 * 33], s[3 * 33]); o.z = pk2(s[4 * 33], s[5 * 33]); o.w = pk2(s[6 * 33], s[7 * 33]);
            *(GAS v4u*)(WT + (size_t)(n0 + n) * Kdst + k0 + 8 * c) = o; } }
        if (NKB > 1) { const int n = lane & 31, kh = 32 * (lane >> 5);
#pragma unroll 8
            for (int kk = 0; kk < 32; ++kk) { const float w = scr[(kh + kk) * 33 + n]; a0 += w * scr[2112 + kh + kk]; a1 += w * scr[2176 + kh + kk]; a2 += w * scr[2240 + kh + kk]; } }
        LDS_WAIT(); asm volatile("" ::: "memory");
    }
    if (NKB > 1) { float* o = sw + n0 + (lane & 31); unsafeAtomicAdd(o, a0); unsafeAtomicAdd(o + Nsw, a1); unsafeAtomicAdd(o + 2 * Nsw, a2); }
}
__device__ __forceinline__ void p0_ada_item(const float* c, const float* c_ctx, const float* w_ada, const float* b_ada, float* MOD, LAS float* scr, int item, int lane) {
    const int l = item / (32 * 144), r = item - l * (32 * 144), kc = r / 144, cg = r - kc * 144, k0 = kc * 128, col = cg * 256 + lane * 4;
#pragma unroll
    for (int i = 0; i < 2; ++i) { const int k = k0 + i * 64 + lane;
        const float a = c[k], b = c[DM + k], d = c_ctx[k];
        scr[i * 64 + lane] = a * fast_sigmoid(a); scr[256 + i * 64 + lane] = b * fast_sigmoid(b); scr[512 + i * 64 + lane] = d * fast_sigmoid(d); }
    LDS_WAIT(); asm volatile("" ::: "memory");
    const float* wp = w_ada + (size_t)l * DM * MODW + (size_t)k0 * MODW + col;
    f32x4 a0 = {0.f, 0.f, 0.f, 0.f}, a1 = a0, a2 = a0;
#pragma unroll 8
    for (int k = 0; k < 128; ++k) { const f32x4 w = __builtin_nontemporal_load((const f32x4*)(wp + (size_t)k * MODW)); a0 += w * scr[k]; a1 += w * scr[256 + k]; a2 += w * scr[512 + k]; }
    if (kc == 0) { const f32x4 bv = *(const f32x4*)(b_ada + (size_t)l * MODW + col); a0 += bv; a1 += bv; a2 += bv; }
    float* m = MOD + (size_t)l * 3 * MODW + col;
#pragma unroll
    for (int j = 0; j < 4; ++j) { unsafeAtomicAdd(m + j, a0[j]); unsafeAtomicAdd(m + MODW + j, a1[j]); unsafeAtomicAdd(m + 2 * MODW + j, a2[j]); }
    LDS_WAIT(); asm volatile("" ::: "memory");
}

__device__ __forceinline__ void modnorm_phase(const Frame& F, const float* xl, const float* xc, const float* g, const float* modl  , int sub, u16* HN, float* xc_copy  ,
                                              const float* part  , const float* pgate, float pcoef, float* xc_out, float* rowss, bool ctx_only  , unsigned char* hn8  ) {
    const int gw = F.vcu * NWAVES + F.wave, NGW = F.G * NWAVES;
    for (int it = gw; it < (ctx_only ? NB * CTXL : MROWS); it += NGW) {
        const int row = ctx_only ? (it / CTXL) * TPB + SEQ + it % CTXL : it;
        const int b = row / TPB, t = row - b * TPB; const bool isc = t >= SEQ;
        const float* xr = isc ? xc + (size_t)(b * CTXL + t - SEQ) * DM : xl + (size_t)(b * SEQ + t) * DM;
        const float* mv = modl + (size_t)(isc ? 2 : b) * MODW + (size_t)(3 * sub) * DM;
        f32x4 v[16]; float ss = 0.f;
#pragma unroll
        for (int j = 0; j < 16; ++j) { v[j] = *(const f32x4*)(xr + j * 256 + F.lane * 4); ss += (v[j].x * v[j].x + v[j].y * v[j].y) + (v[j].z * v[j].z + v[j].w * v[j].w); }
        if (isc && part) {
            const int cr = b * CTXL + t - SEQ; ss = 0.f;
#pragma unroll
            for (int j = 0; j < 16; ++j) { const int c0 = j * 256 + F.lane * 4; f32x4 a = *(const f32x4*)(part + (size_t)cr * DM + c0);
#pragma unroll
                for (int ks = 1; ks < 8; ++ks) a += *(const f32x4*)(part + ((size_t)ks * (NB * CTXL) + cr) * DM + c0);
                v[j] += a * (*(const f32x4*)(pgate + c0) * pcoef); *(f32x4*)(xc_out + (size_t)cr * DM + c0) = v[j];
                ss += (v[j].x * v[j].x + v[j].y * v[j].y) + (v[j].z * v[j].z + v[j].w * v[j].w); }
        }
        ss = wave_sum(ss); if (F.lane == 0) rowss[row] = ss;
        if (isc && xc_copy) { float* cr = xc_copy + (size_t)(b * CTXL + t - SEQ) * DM;
#pragma unroll
            for (int j = 0; j < 16; ++j) *(f32x4*)(cr + j * 256 + F.lane * 4) = v[j]; }
        u16* orow = HN + (size_t)row * DM;
#pragma unroll
        for (int j = 0; j < 16; ++j) { const int c0 = j * 256 + F.lane * 4;
            const f32x4 gg = *(const f32x4*)(g + c0), sc = *(const f32x4*)(mv + DM + c0);
            const f32x4 y = v[j] * gg * (sc + 1.0f);
            v2u w; w.x = pk2(y.x, y.y); w.y = pk2(y.z, y.w); *(v2u*)(orow + c0) = w;
            if (hn8) *(unsigned*)(hn8 + (size_t)row * DM + c0) = pk4_fp8(y.x, y.y, y.z, y.w); }
    }
}

__device__ __forceinline__ void ctxnorm_phase(const Frame& F, float* xc, const float* g, const float* modl, int sub, u16* HN, const float* part, const float* pgate, float pcoef, float* rowss, unsigned char* hn8) {
    const int gw = F.vcu * NWAVES + F.wave, NGW = F.G * NWAVES;
    const float* mv = modl + (size_t)2 * MODW + (size_t)(3 * sub) * DM;
    for (int it = gw; it < NB * CTXL * 4; it += NGW) {
        const int cr = it >> 2, q = it & 3, b = cr / CTXL, row = b * TPB + SEQ + (cr - b * CTXL);
        float* xr = xc + (size_t)cr * DM + q * 1024 + F.lane * 4;
        f32x4 v[4]; float ss = 0.f;
#pragma unroll
        for (int j = 0; j < 4; ++j) v[j] = *(const f32x4*)(xr + j * 256);
        if (part) {
#pragma unroll
            for (int j = 0; j < 4; ++j) { const int c0 = q * 1024 + j * 256 + F.lane * 4; f32x4 a = {0.f, 0.f, 0.f, 0.f};
#pragma unroll
                for (int ks = 0; ks < 8; ++ks) { const v2u w = *(const v2u*)((const u16*)part + ((size_t)ks * (NB * CTXL) + cr) * DM + c0); a[0] += bf_lo(w.x); a[1] += bf_hi(w.x); a[2] += bf_lo(w.y); a[3] += bf_hi(w.y); }
                v[j] += a * (*(const f32x4*)(pgate + c0) * pcoef); *(f32x4*)(xr + j * 256) = v[j]; }
        }
#pragma unroll
        for (int j = 0; j < 4; ++j) ss += (v[j].x * v[j].x + v[j].y * v[j].y) + (v[j].z * v[j].z + v[j].w * v[j].w);
        ss = wave_sum(ss); if (F.lane == 0) unsafeAtomicAdd(rowss + row, ss);
#pragma unroll
        for (int j = 0; j < 4; ++j) { const int c0 = q * 1024 + j * 256 + F.lane * 4;
            const f32x4 gg = *(const f32x4*)(g + c0), sc = *(const f32x4*)(mv + DM + c0);
            const f32x4 y = v[j] * gg * (sc + 1.0f);
            if (hn8) *(unsigned*)(hn8 + (size_t)row * DM + c0) = pk4_fp8(y.x, y.y, y.z, y.w);
            else { v2u w; w.x = pk2(y.x, y.y); w.y = pk2(y.z, y.w); *(v2u*)(HN + (size_t)row * DM + c0) = w; } }
    }
}

template <int KIND  >
__device__ __forceinline__ v4u qk_one(v4u w, const float* gain, bool lat, int gr, int gcl, const f32x2* T, int sub) {
    float x[8]; x[0] = bf_lo(w.x); x[1] = bf_hi(w.x); x[2] = bf_lo(w.y); x[3] = bf_hi(w.y); x[4] = bf_lo(w.z); x[5] = bf_hi(w.z); x[6] = bf_lo(w.w); x[7] = bf_hi(w.w);
    float ss = 0.f;
#pragma unroll
    for (int e = 0; e < 8; ++e) ss += x[e] * x[e];
    ss = (KIND != 2) ? sum16(ss) : sum8(ss);
    const float rstd = 1.0f / sqrtf(ss * (KIND == 2 ? 1.0f / 64.0f : 1.0f / 128.0f) + EPS);
    const int s = KIND == 2 ? (sub & 7) : sub;
    const f32x4 g0 = *(const f32x4*)(gain + 8 * s), g1 = *(const f32x4*)(gain + 8 * s + 4);
    x[0] *= rstd * g0[0]; x[1] *= rstd * g0[1]; x[2] *= rstd * g0[2]; x[3] *= rstd * g0[3]; x[4] *= rstd * g1[0]; x[5] *= rstd * g1[1]; x[6] *= rstd * g1[2]; x[7] *= rstd * g1[3];
    if (KIND != 1 && lat) {
        constexpr int NP = KIND == 0 ? 32 : 16;
        const int i0 = 4 * s; const f32x2* tp = (i0 < NP) ? T + gr * NP + i0 : T + gcl * NP + i0 - NP;
        const f32x4 c01 = *(const f32x4*)tp, c23 = *(const f32x4*)(tp + 2);
        float y;
        y = x[0] * c01[0] - x[1] * c01[1]; x[1] = x[0] * c01[1] + x[1] * c01[0]; x[0] = y;
        y = x[2] * c01[2] - x[3] * c01[3]; x[3] = x[2] * c01[3] + x[3] * c01[2]; x[2] = y;
        y = x[4] * c23[0] - x[5] * c23[1]; x[5] = x[4] * c23[1] + x[5] * c23[0]; x[4] = y;
        y = x[6] * c23[2] - x[7] * c23[3]; x[7] = x[6] * c23[3] + x[7] * c23[2]; x[6] = y;
    }
    v4u o; o.x = pk2(x[0], x[1]); o.y = pk2(x[2], x[3]); o.z = pk2(x[4], x[5]); o.w = pk2(x[6], x[7]); return o;
}
__device__ __forceinline__ void qkprep_phase(const Frame& F, u16* QKV, u16* QOUT, const float* ga, const float* gb, const float* gc, const float* misc) {
    const int gw = F.vcu * NWAVES + F.wave, NGW = F.G * NWAVES, sub = F.lane & 15;
    const f32x2* TA = (const f32x2*)(misc + MI_TA); const f32x2* TC = (const f32x2*)(misc + MI_TC);
    for (int row = gw; row < MROWS; row += NGW) {
        const int t = row % TPB; const bool lat = t < SEQ; const int gr = (t >> 6) & 63, gcl = t & 63;
        u16* rp = QKV + (size_t)row * QKVW + F.lane * 8; u16* wp = QOUT + (size_t)row * QKVW + F.lane * 8;
        v4u v[6];
#pragma unroll
        for (int jj = 0; jj < 6; ++jj) { const int j = jj == 0 ? 3 : (jj < 4 ? 6 + jj : 8 + jj); const int col = j < 4 ? j * 512 : (j < 10 ? CQB + (j - 4) * 512 : CQC + (j - 10) * 512); v[jj] = *(const v4u*)(rp + col); }
#pragma unroll
        for (int jj = 0; jj < 6; ++jj) { const int j = jj == 0 ? 3 : (jj < 4 ? 6 + jj : 8 + jj); const int col = j < 4 ? j * 512 : (j < 10 ? CQB + (j - 4) * 512 : CQC + (j - 10) * 512);
            v4u o;
            if (j < 4)       o = qk_one<0>(v[jj], ga + 128, lat, gr, gcl, TA, sub);
            else if (j < 10) o = qk_one<1>(v[jj], gb + 128, lat, gr, gcl, TA, sub);
            else             o = qk_one<2>(v[jj], gc + 64, lat, gr, gcl, TC, sub);
            *(v4u*)(wp + col) = o; }
    }
}

__device__ __forceinline__ void ccombine_phase(const Frame& F, const u16* OCR, u16* OC, const float* subln, float lam, float one_m_li) {
    const int gw = F.vcu * NWAVES + F.wave, NGW = F.G * NWAVES, sub = F.lane & 15, grp = F.lane >> 4;
    const f32x4 s0 = *(const f32x4*)(subln + 8 * sub) * one_m_li, s1 = *(const f32x4*)(subln + 8 * sub + 4) * one_m_li;
    for (int row = gw; row < MROWS; row += NGW) {
        const u16* rp = OCR + (size_t)row * 2048 + grp * 256 + sub * 8;
        v4u a[2], b[2];
#pragma unroll
        for (int j = 0; j < 2; ++j) { a[j] = *(const v4u*)(rp + j * 1024); b[j] = *(const v4u*)(rp + j * 1024 + 128); }
#pragma unroll
        for (int j = 0; j < 2; ++j) {
            float d[8]; d[0] = bf_lo(a[j].x) - lam * bf_lo(b[j].x); d[1] = bf_hi(a[j].x) - lam * bf_hi(b[j].x); d[2] = bf_lo(a[j].y) - lam * bf_lo(b[j].y); d[3] = bf_hi(a[j].y) - lam * bf_hi(b[j].y);
            d[4] = bf_lo(a[j].z) - lam * bf_lo(b[j].z); d[5] = bf_hi(a[j].z) - lam * bf_hi(b[j].z); d[6] = bf_lo(a[j].w) - lam * bf_lo(b[j].w); d[7] = bf_hi(a[j].w) - lam * bf_hi(b[j].w);
            float ss = 0.f;
#pragma unroll
            for (int e = 0; e < 8; ++e) ss += d[e] * d[e];
            ss = sum16(ss);
            const float rstd = 1.0f / sqrtf(ss * (1.0f / 128.0f) + EPS);
            v4u o; o.x = pk2(d[0] * rstd * s0[0], d[1] * rstd * s0[1]); o.y = pk2(d[2] * rstd * s0[2], d[3] * rstd * s0[3]); o.z = pk2(d[4] * rstd * s1[0], d[5] * rstd * s1[1]); o.w = pk2(d[6] * rstd * s1[2], d[7] * rstd * s1[3]);
            *(v4u*)(OC + (size_t)row * DM + 3072 + (j * 4 + grp) * 128 + sub * 8) = o;
        }
    }
}

constexpr int PPL = 13, NPH = 2 + DEPTH * PPL;
typedef const float* __attribute__((address_space(4))) const* kargp_t;
#define KARGS() kargp_t kp_ = (kargp_t)__builtin_amdgcn_kernarg_segment_ptr(); asm volatile("" : "+s"(kp_))
#define KIN(i) ((const float*)kp_[i])
#define KOUT() ((float*)kp_[22])
#define KWS() ((unsigned char*)kp_[23])
constexpr int H_FIN = (DM / 512) * (2 * FFN / 32), H_IN = (DM / 512) * (INW / 32), H_LAYER = 2 * H_FIN + H_IN;
constexpr int I_FOUT = (FFN / 64) * (DM / 32), I_BRA = (1536 / 64) * (DM / 32), I_BRC = (1024 / 64) * (DM / 32), I_OUT = (DM / 64) * (DM / 32), I_LAYER = 2 * I_FOUT + 2 * I_BRA + I_BRC + I_OUT;
constexpr int TAIL_L1 = 22528, TAIL_H = 12800, T2_H = 7168;
__device__ __forceinline__ void conv_heavy(kargp_t kp_, unsigned char* ws, LAS float* scr, int l, int r, int lane) {
    int ai, Nsrc, smap, which, ksh; size_t wo;
    if (r < H_FIN) { ai = 7; Nsrc = 2 * FFN; wo = WO_1IN; smap = 1; which = 0; ksh = 0; }
    else if ((r -= H_FIN) < H_IN) { ai = 11; Nsrc = INW; wo = WO_IN; smap = 0; which = 1; ksh = 3; }
    else { r -= H_IN; ai = 9; Nsrc = 2 * FFN; wo = WO_2IN; smap = 1; which = 2; ksh = 6; }
    p0_transpose_item<8>(KIN(ai) + (size_t)l * DM * Nsrc, DM, Nsrc, (u16*)(ws + WS_W + (size_t)l * W_LAYER + wo), DM, Nsrc / 32, smap, scr, r, lane,
                         (const float*)(ws + WS_MOD) + (size_t)l * 3 * MODW + (size_t)ksh * DM, (float*)(ws + WS_SW) + (size_t)(l * 3 + which) * SW_STRIDE, Nsrc,
                         which == 1 ? ws + WS_W8 + (size_t)l * W8_LAYER : nullptr);
}
__device__ __forceinline__ void conv_light(kargp_t kp_, unsigned char* ws, LAS float* scr, int l, int r, int lane) {
    int ai, K, Kdst = 0; size_t wo;
    if (r < I_FOUT) { ai = 8; K = FFN; wo = WO_1OUT; }
    else if ((r -= I_FOUT) < I_FOUT) { ai = 10; K = FFN; wo = WO_2OUT; }
    else if ((r -= I_FOUT) < I_BRA) { ai = 18; K = 1536; wo = WO_BR; Kdst = DM; }
    else if ((r -= I_BRA) < I_BRA) { ai = 19; K = 1536; wo = WO_BR + 1536 * 2; Kdst = DM; }
    else if ((r -= I_BRA) < I_BRC) { ai = 20; K = 1024; wo = WO_BR + 3072 * 2; Kdst = DM; }
    else { r -= I_BRC; ai = 21; K = DM; wo = WO_OUT; }
    p0_transpose_item<1>(KIN(ai) + (size_t)l * K * DM, K, DM, (u16*)(ws + WS_W + (size_t)l * W_LAYER + wo), Kdst ? Kdst : K, DM / 32, 0, scr, r, lane, nullptr, nullptr, 0);
}
__device__ __forceinline__ int l0_early(int j) { return j < I_FOUT ? j : j + I_FOUT; }
__device__ __forceinline__ int l0_late(int j) { return j < I_FOUT ? j + I_FOUT : j + 2 * I_BRA + I_BRC + I_FOUT; }
template <int KIND> __device__ __forceinline__ void conv_tail(kargp_t kp_, unsigned char* ws, LAS unsigned char* lds, int G, int c, int busy, int lo, int hi, int wv) {
    if (c < busy || busy >= G) return;
    const int t_ = tid_of(wv); const int wave = wv, lane = t_ & 63;
    LAS float* scr = (LAS float*)(lds + RING_OFF + wave * 16384);
    for (int it = lo + (c - busy) * NWAVES + wave; it < hi; it += (G - busy) * NWAVES) { if (KIND == 1) conv_heavy(kp_, ws, scr, 1, it, lane); else if (KIND == 0) conv_light(kp_, ws, scr, 1, it, lane); else conv_light(kp_, ws, scr, 0, l0_early(it), lane); }
    LDS_WAIT();
}

__device__ __forceinline__ int attq_next(const Frame& F, gu32* head) {
    volatile LAS unsigned* slot = (volatile LAS unsigned*)(F.lds + att::OFF_SLOT);
    __syncthreads();
    if (F.tid == 0) slot[0] = __hip_atomic_fetch_add(head, 1u, RLX_AGENT);
    __syncthreads();
    return __builtin_amdgcn_readfirstlane((int)slot[0]);
}
__device__ __forceinline__ void attn_phase(const Frame& F, const u16* QKV, u16* OCAT, u16* OCR, const float* rel_bias  , gu32* qhead, bool with_ctx,
                                           const float* ga, const float* gb, const float* gc  , const float* misc  , kargp_t kp_, unsigned char* ws, bool conv  ) {
    char* lds = (char*)F.lds;
    int cround = 0; const int crounds = conv ? (TAIL_H - T2_H + F.G * NWAVES - 1) / (F.G * NWAVES) : 0;
#define CONV_ROUND() do { if (cround < crounds) { __syncthreads(); const int it_ = T2_H + cround * F.G * NWAVES + (int)blockIdx.x * NWAVES + F.wave; \
        if (it_ < TAIL_H) conv_heavy(kp_, ws, (LAS float*)(F.lds + RING_OFF + F.wave * 9216), 1, it_, tid_of(F.wave) & 63  ); LDS_WAIT(); ++cround; } } while (0)
    for (;;) {
        const int idx = attq_next(F, qhead); if (idx >= (with_ctx ? 408 : 384)) break;
        att::Unit U; int h, b, qb; const bool ctxq = idx >= 384;
        if (!ctxq) { qb = idx & 15; h = (idx >> 4) % 12; b = idx / 192; } else { const int i = idx - 384; qb = 16; h = i % 12; b = i / 12; }
        const int rowq = b * TPB + qb * 256; U.r0 = 0; U.first = 0; U.base1 = 0;
        if (ctxq) { U.NT = 4; U.n0 = 4; U.base0 = b * TPB + SEQ; } else { U.NT = 68; U.n0 = 68; U.base0 = b * TPB; }
        U.Q = QKV + (size_t)rowq * QKVW + CQA + h * 128; U.K = QKV + CKA + (h / 3) * 128; U.V = QKV + CVA + (h / 3) * 128; U.O = OCAT + (size_t)rowq * DM + h * 128; U.ldo = DM;
        U.qgain = ga; U.qrope = ctxq ? nullptr : misc + MI_TA; U.t0 = ctxq ? 0 : qb * 256;
        att::attn_unit<128, 0, 2>(U, lds, F.wave);
        CONV_ROUND();
    }
    for (;;) {
        const int idx = attq_next(F, qhead + 64); if (idx >= (with_ctx ? 544 : 512)) break;
        att::Unit U; int ph, b, qb; const bool ctxq = idx >= 512;
        if (!ctxq) { qb = idx & 15; ph = (idx >> 4) & 15; b = idx >> 8; } else { const int i = idx - 512; qb = 16; ph = i & 15; b = i >> 4; }
        const int rowq = b * TPB + qb * 256, h = ph >> 1, cmap = ph & 1; U.r0 = 0; U.first = 0; U.base1 = 0;
        if (ctxq) { U.NT = 4; U.n0 = 4; U.base0 = b * TPB + SEQ; } else { U.NT = 68; U.n0 = 68; U.base0 = b * TPB; }
        U.Q = QKV + (size_t)rowq * QKVW + CQC + h * 128 + cmap * 64; U.K = QKV + CKC + h * 128 + cmap * 64; U.V = QKV + CVC + h * 128; U.O = OCR + (size_t)rowq * 2048 + ph * 128; U.ldo = 2048;
        U.qgain = gc; U.qrope = ctxq ? nullptr : misc + MI_TC; U.t0 = ctxq ? 0 : qb * 256;
        att::attn_unit<64, 0, 2>(U, lds, F.wave);
        CONV_ROUND();
    }
    for (;;) {
        const int idx = attq_next(F, qhead + 128); if (idx >= (with_ctx ? 408 : 384)) break;
        att::Unit U; int h, b, qb; const bool ctxq = idx >= 384;
        if (!ctxq) { qb = idx & 15; h = (idx >> 4) % 12; b = idx / 192; } else { const int i = idx - 384; qb = 16; h = i % 12; b = i / 12; }
        const int rowq = b * TPB + qb * 256; U.r0 = 0; U.first = 0; U.base1 = 0; U.NT = 4; U.n0 = 4; U.base0 = b * TPB + SEQ;
        if (!ctxq) {
            const int r0 = qb * 4; int first = min(max(r0 - 4, 0), 56); const int last = min(max(r0 - 1, 0), 56) + 7; int cnt = last - first + 1;
            if (cnt & 1) { if (first > 0) --first; ++cnt; }
            U.NT = 4 + cnt; U.base1 = b * TPB + first * 64; U.r0 = r0; U.first = first;
            LAS float* biasq = (LAS float*)(F.lds + att::OFF_BIAS);
            for (int e = F.tid; e < 465; e += NWAVES * 64) biasq[e] = rel_bias[h * 465 + e] * 11.313708498984761f;
        }
        U.Q = QKV + (size_t)rowq * QKVW + CQB + h * 128; U.K = QKV + CKB + h * 128; U.V = QKV + CVB + h * 128; U.O = OCAT + (size_t)rowq * DM + 1536 + h * 128; U.ldo = DM;
        U.qgain = gb; U.qrope = nullptr; U.t0 = 0;
        att::attn_unit<128, 1, 1>(U, lds, F.wave);
    }
    while (cround < crounds) CONV_ROUND();
#undef CONV_ROUND
}

__device__ __forceinline__ Frame make_frame(unsigned char* ws, LAS unsigned char* lds, int wv) {
    Frame F; F.lds = lds; F.MISC = (volatile LAS unsigned*)(lds + MISC_OFF); F.ctl = (gu32*)(ws + WS_CTL);
    F.tid = tid_of(wv); F.lane = F.tid & 63; F.wave = wv;
    F.G = gridDim.x; { const int bx = blockIdx.x; F.vcu = (F.G % 8 == 0) ? (bx % 8) * (F.G / 8) + bx / 8 : bx; }
    return F;
}
__global__ void __launch_bounds__(NWAVES * 64, 2) trunk_fwd(Args args) {
    extern __shared__ __attribute__((aligned(16))) unsigned char lds[];
    LAS unsigned char* const L = (LAS unsigned char*)lds;
    const int wv_ = __builtin_amdgcn_readfirstlane((int)threadIdx.x >> 6);
    for (int u = tid_of(wv_); u < (LDS_BYTES - LDSCTL_OFF) / 4; u += NWAVES * 64) ((LAS unsigned*)(L + LDSCTL_OFF))[u] = 0u;
    __syncthreads();
    const int lo = args.ph_lo, hi = args.ph_hi;
    if (MK_N_LAUNCHES == 1) { KARGS(); (void)xcd_barrier_post((unsigned*)((gu32*)(KWS() + WS_CTL) + CW_BAR), (volatile LAS unsigned*)(L + MISC_OFF) + 8, tid_of(wv_) == 0); }
#define GRID_BAR() do { if (MK_N_LAUNCHES == 1) { KARGS(); XcdBarrier bar_; bar_.bar = (unsigned*)((gu32*)(KWS() + WS_CTL) + CW_BAR); bar_.x = xb_xcc_id(); bar_.st = (volatile LAS unsigned*)(L + MISC_OFF) + 8; xcd_barrier(bar_, tid_of(wv_) == 0); } } while (0)
#define IN(k) (lo <= (k) && (k) < hi)
#define SEAM(k) do { if (IN((k) + 1)) GRID_BAR(); } while (0)

    if (IN(0)) {
        KARGS(); unsigned char* ws = KWS(); const Frame F = make_frame(ws, L, wv_);
        LAS float* scr = (LAS float*)(F.lds + RING_OFF + F.wave * 16384);
        const int gw = F.vcu * NWAVES + F.wave, NGW = F.G * NWAVES;
        { const float* c_in = KIN(1); const float* cctx_in = KIN(3); const float* w_ada = KIN(4); const float* b_ada = KIN(5); float* MOD = (float*)(ws + WS_MOD);
          for (int it = gw; it < DEPTH * 32 * 144; it += NGW) p0_ada_item(c_in, cctx_in, w_ada, b_ada, MOD, scr, it, F.lane); }
        if (blockIdx.x == 0) {
            float* MISCF = (float*)(ws + WS_MISC); const float* diff_lambda = KIN(16);
            for (int e = F.tid; e < 64 * 32; e += NWAVES * 64) { const int p = e >> 5, i = e & 31; const float inv = powf(10000.0f, -(float)i / 32.0f), ang = (float)p * inv; MISCF[MI_TA + 2 * e] = cosf(ang); MISCF[MI_TA + 2 * e + 1] = sinf(ang); }
            for (int e = F.tid; e < 64 * 16; e += NWAVES * 64) { const int p = e >> 4, i = e & 15; const float inv = powf(10000.0f, -(float)i / 16.0f), ang = (float)p * inv; MISCF[MI_TC + 2 * e] = cosf(ang); MISCF[MI_TC + 2 * e + 1] = sinf(ang); }
            if (F.wave < DEPTH) { const int l = F.wave; const float* dl = diff_lambda + (size_t)l * 4 * 64;
                const float s1 = wave_sum(dl[F.lane] * dl[64 + F.lane]), s2 = wave_sum(dl[128 + F.lane] * dl[192 + F.lane]);
                const float lam_init = 0.8f - 0.6f * expf(-0.3f * (float)l);
                if (F.lane == 0) MISCF[MI_LAM + l] = expf(s1) - expf(s2) + lam_init; }
        }
        LDS_WAIT();
        SEAM(0);
    }
#define PH_BEGIN0() const float* modl = (const float*)(ws + WS_MOD) + (size_t)l * 3 * MODW; float* XC = (float*)(ws + WS_XC)
    if (IN(1)) {
        KARGS(); unsigned char* ws = KWS(); const Frame F = make_frame(ws, L, wv_);
        LAS float* scr = (LAS float*)(F.lds + RING_OFF + F.wave * 16384);
        const int gw = F.vcu * NWAVES + F.wave, NGW = F.G * NWAVES;
        for (int it = gw; it < DEPTH * H_LAYER; it += NGW) {
            const int l = it / H_LAYER, r = it - l * H_LAYER; if (l == 1 && r < TAIL_H) continue;
            conv_heavy(kp_, ws, scr, l, r, F.lane); }
        if (DEPTH > 1) { for (int it = gw; it < TAIL_L1; it += NGW) conv_light(kp_, ws, scr, 0, l0_late(it), F.lane); }
        else { for (int it = gw; it < I_LAYER; it += NGW) conv_light(kp_, ws, scr, 0, it, F.lane); }
        LDS_WAIT();
        { const int l = 0; PH_BEGIN0();
          modnorm_phase(F, KIN(0), KIN(2), KIN(6), modl, 0, (u16*)(ws + WS_HN), XC, nullptr, modl, 0.5f, XC, (float*)(ws + WS_ROWSS), false, nullptr); }
        SEAM(1);
    }

    for (int l = 0; l < DEPTH; ++l) {
        const int P = 2 + l * PPL;
#define PH_BEGIN() KARGS(); unsigned char* ws = KWS(); const Frame F = make_frame(ws, L, wv_); const float* modl = (const float*)(ws + WS_MOD) + (size_t)l * 3 * MODW; \
        const u16* wl = (const u16*)(ws + WS_W + (size_t)l * W_LAYER); float* XL = KOUT(); float* XC = (float*)(ws + WS_XC); \
        float* DXL = rep ? (float*)(ws + WS_MX) : XL; float* DXC = rep ? (float*)(ws + WS_MX) + (size_t)NB * SEQ * DM : XC;     \
        (void)F; (void)modl; (void)wl; (void)XL; (void)XC; (void)DXL; (void)DXC
        if (IN(P + 0) && l != 0) { for (int rep = 0; rep <= DUP(0); ++rep) { PH_BEGIN();
            ctxnorm_phase(F, XC, KIN(6) + (size_t)(l * 3 + 0) * DM, modl, 0, (u16*)(ws + WS_HN), (const float*)(ws + WS_PART), modl - 3 * MODW + 2 * MODW + 8 * DM, 0.5f, (float*)(ws + WS_ROWSS) + (size_t)(l * 3 + 0) * MROWS, nullptr); } SEAM(P + 0); }
        if (IN(P + 1)) { for (int rep = 0; rep <= DUP(1); ++rep) { PH_BEGIN(); pg8::Gemm g{(const u16*)(ws + WS_HN), wl + WO_1IN / 2, MROWS, 2 * FFN, DM}; pg8::StaticOrder S; S.init(MROWS, 2 * FFN, DM, F.G, (int)blockIdx.x);
            pg8::EpiSwiglu E{(u16*)(ws + WS_HD), {(const float*)(ws + WS_ROWSS) + (size_t)(l * 3 + 0) * MROWS, (const float*)(ws + WS_SW) + (size_t)(l * 3 + 0) * SW_STRIDE, 2 * FFN}}; pg8::gemm_phase<pg8::EpiSwiglu, pg8::StaticOrder, true, true>(F.lds + RING_OFF, g, S, E, F.wave); } if (DEPTH > 1) { KARGS(); const int busy_ = ((MROWS / 256) * (2 * FFN / 256)) % (int)gridDim.x;
              if (l == 0) conv_tail<2>(kp_, KWS(), L, (int)gridDim.x, (int)blockIdx.x, busy_, 0, TAIL_L1, wv_); else if (l == 1) conv_tail<0>(kp_, KWS(), L, (int)gridDim.x, (int)blockIdx.x, busy_, TAIL_L1, 2 * TAIL_L1, wv_); } SEAM(P + 1); }
        if (IN(P + 2)) { for (int rep = DUP(2); rep >= 0; --rep) { PH_BEGIN(); pg8::Gemm g{(const u16*)(ws + WS_HD), wl + WO_1OUT / 2, MROWS, DM, FFN}; pg8::ResidOrder S; S.init(DM, FFN, F.G, (int)blockIdx.x, 8, 1);
            pg8::EpiResid E{l == 0 ? KIN(0) : XL, DXL, ws, KIN(6) + (size_t)(l * 3 + 1) * DM, (unsigned)(WS_MOD + ((size_t)l * 3 * MODW + 4 * DM) * 4), (unsigned)(WS_ROWSS + (size_t)(l * 3 + 1) * MROWS * 4), (unsigned)(WS_XG8 >> 20),
                            (unsigned)(WS_MOD + ((size_t)l * 3 * MODW + 2 * DM) * 4), 0.5f, FFN / 64, (l != 0 ? 1 : 0) | 2}; pg8::gemm_phase<pg8::EpiResid, pg8::ResidOrder, true, true>(F.lds + RING_OFF, g, S, E, F.wave); } SEAM(P + 2); }
        if (IN(P + 3)) { for (int rep = 0; rep <= DUP(3); ++rep) { PH_BEGIN(); ctxnorm_phase(F, XC, KIN(6) + (size_t)(l * 3 + 1) * DM, modl, 1, (u16*)(ws + WS_HN), (const float*)(ws + WS_PART), modl + 2 * MODW + 2 * DM, 0.5f, (float*)(ws + WS_ROWSS) + (size_t)(l * 3 + 1) * MROWS, ws + WS_XG8); } SEAM(P + 3); }
        if (IN(P + 4)) { for (int rep = 0; rep <= DUP(4); ++rep) { PH_BEGIN();
            const pg8::NormFix nf{(const float*)(ws + WS_ROWSS) + (size_t)(l * 3 + 1) * MROWS, (const float*)(ws + WS_SW) + (size_t)(l * 3 + 1) * SW_STRIDE, INW};
            { pg8::Gemm g{(const u16*)(ws + WS_XG8), (const u16*)(ws + WS_W8 + (size_t)l * W8_LAYER), MROWS, INW, DM / 2}; pg8::MapOrder<1> S; S.S.init(MROWS, 88 * 256, DM / 2, F.G, (int)blockIdx.x); S.extra = 0;
              pg8::EpiInProj E{(u16*)(ws + WS_QKV), (u16*)(ws + WS_SG), nf, 0, 1.0f / 64.0f}; pg8::gemm_phase<pg8::EpiInProj, pg8::MapOrder<1>, true, true, true>(F.lds + RING_OFF, g, S, E, F.wave); }
            } SEAM(P + 4); }
        if (IN(P + 5)) { for (int rep = DUP(5); rep >= 0; --rep) { PH_BEGIN(); qkprep_phase(F, (u16*)(ws + WS_QKV), rep ? (u16*)(ws + WS_MX) : (u16*)(ws + WS_QKV), KIN(12) + (size_t)l * 256, KIN(13) + (size_t)l * 256, KIN(14) + (size_t)l * 128, (const float*)(ws + WS_MISC)); } SEAM(P + 5); }
        if (IN(P + 6)) { for (int rep = 0; rep <= DUP(6); ++rep) { PH_BEGIN(); attn_phase(F, (const u16*)(ws + WS_QKV), (u16*)(ws + WS_OCAT), (u16*)(ws + WS_OCR), KIN(15) + (size_t)l * 12 * 465, F.ctl + CW_ATTQ + 256 * l + 1024 * rep, l == 0,
                KIN(12) + (size_t)l * 256, KIN(13) + (size_t)l * 256, KIN(14) + (size_t)l * 128, (const float*)(ws + WS_MISC), kp_, ws, l == 0 && DEPTH > 1 && rep == 0); } SEAM(P + 6); }
        if (IN(P + 7)) { for (int rep = 0; rep <= DUP(7); ++rep) { PH_BEGIN(); const float lam_init = 0.8f - 0.6f * expf(-0.3f * (float)l);
            ccombine_phase(F, (const u16*)(ws + WS_OCR), (u16*)(ws + WS_OCAT), KIN(17) + (size_t)l * 128, ((const float*)(ws + WS_MISC))[MI_LAM + l], 1.0f - lam_init); } SEAM(P + 7); }
        if (IN(P + 8)) { for (int rep = 0; rep <= DUP(8); ++rep) { PH_BEGIN(); pg8::Gemm g{(const u16*)(ws + WS_OCAT), wl + WO_BR / 2, MROWS, DM, DM}; pg8::GateOrder S; S.S.init(MROWS, DM, DM, F.G, (int)blockIdx.x, l == DEPTH - 1);
            pg8::EpiGate E{(const u16*)(ws + WS_SG), (u16*)(ws + WS_MXB)}; pg8::gemm_phase<pg8::EpiGate, pg8::GateOrder, true, true>(F.lds + RING_OFF, g, S, E, F.wave); } if (l == 0 && DEPTH > 1) { KARGS(); conv_tail<1>(kp_, KWS(), L, (int)gridDim.x, (int)blockIdx.x, ((MROWS / 256) * (DM / 256)) % (int)gridDim.x, 0, T2_H, wv_); } SEAM(P + 8); }
        if (IN(P + 9)) { for (int rep = DUP(9); rep >= 0; --rep) { PH_BEGIN(); pg8::Gemm g{(const u16*)(ws + WS_MXB), wl + WO_OUT / 2, MROWS, DM, DM}; pg8::ResidOrder S; S.init(DM, DM, F.G, (int)blockIdx.x, 8, l != DEPTH - 1);
            pg8::EpiResid E{XL, DXL, ws, KIN(6) + (size_t)(l * 3 + 2) * DM, (unsigned)(WS_MOD + ((size_t)l * 3 * MODW + 7 * DM) * 4), (unsigned)(WS_ROWSS + (size_t)(l * 3 + 2) * MROWS * 4), 0u,
                            (unsigned)(WS_MOD + ((size_t)l * 3 * MODW + 5 * DM) * 4), 1.0f, DM / 64, 3}; pg8::gemm_phase<pg8::EpiResid, pg8::ResidOrder, true, true>(F.lds + RING_OFF, g, S, E, F.wave); } SEAM(P + 9); }
        if (IN(P + 10) && l != DEPTH - 1) { for (int rep = 0; rep <= DUP(10); ++rep) { PH_BEGIN(); ctxnorm_phase(F, XC, KIN(6) + (size_t)(l * 3 + 2) * DM, modl, 2, (u16*)(ws + WS_HN), (const float*)(ws + WS_PART), modl + 2 * MODW + 5 * DM, 1.0f, (float*)(ws + WS_ROWSS) + (size_t)(l * 3 + 2) * MROWS, nullptr); } SEAM(P + 10); }
        if (IN(P + 11)) { for (int rep = 0; rep <= DUP(11); ++rep) { PH_BEGIN(); pg8::Gemm g{(const u16*)(ws + WS_HN), wl + WO_2IN / 2, MROWS, 2 * FFN, DM}; pg8::StaticOrder S; S.init(MROWS, 2 * FFN, DM, F.G, (int)blockIdx.x, l == DEPTH - 1);
            pg8::EpiSwiglu E{(u16*)(ws + WS_HD), {(const float*)(ws + WS_ROWSS) + (size_t)(l * 3 + 2) * MROWS, (const float*)(ws + WS_SW) + (size_t)(l * 3 + 2) * SW_STRIDE, 2 * FFN}}; pg8::gemm_phase<pg8::EpiSwiglu, pg8::StaticOrder, true, true>(F.lds + RING_OFF, g, S, E, F.wave); } if (l == 0 && DEPTH > 1) { KARGS(); conv_tail<0>(kp_, KWS(), L, (int)gridDim.x, (int)blockIdx.x, ((MROWS / 256) * (2 * FFN / 256)) % (int)gridDim.x, 0, TAIL_L1, wv_); } SEAM(P + 11); }
        if (IN(P + 12)) { for (int rep = DUP(12); rep >= 0; --rep) { PH_BEGIN(); pg8::Gemm g{(const u16*)(ws + WS_HD), wl + WO_2OUT / 2, MROWS, DM, FFN}; pg8::ResidOrder S; S.init(DM, FFN, F.G, (int)blockIdx.x, 8, l != DEPTH - 1);
            pg8::EpiResid E{XL, DXL, ws, l + 1 < DEPTH ? KIN(6) + (size_t)((l + 1) * 3 + 0) * DM : nullptr, (unsigned)(WS_MOD + ((size_t)(l + 1) * 3 * MODW + 1 * DM) * 4), (unsigned)(WS_ROWSS + (size_t)((l + 1) * 3 + 0) * MROWS * 4), 0u,
                            (unsigned)(WS_MOD + ((size_t)l * 3 * MODW + 8 * DM) * 4), 0.5f, FFN / 64, 1 | (l + 1 < DEPTH ? 2 : 0)}; pg8::gemm_phase<pg8::EpiResid, pg8::ResidOrder, true, true>(F.lds + RING_OFF, g, S, E, F.wave); } SEAM(P + 12); }
#undef PH_BEGIN
    }
#undef IN
#undef SEAM
#undef GRID_BAR
}

extern "C" void kernel_launch(void* const* d_in, const int* in_sizes, int n_in, void* d_out, int out_size, void* d_ws, size_t ws_size, hipStream_t stream) {
    static int grid = 0;
    if (grid == 0) {
        if (n_in != 22 || out_size != NB * SEQ * DM || ws_size < WS_END) { fprintf(stderr, "kernel_launch: built for 22 inputs, out %d floats, >= %zu bytes of workspace; got n_in %d, out %d, ws %zu; nothing launched\n", NB * SEQ * DM, (size_t)WS_END, n_in, out_size, ws_size); grid = -1; return; }
        int dev = 0, cus = 0, per_cu = 0;
        if (hipGetDevice(&dev) != hipSuccess || hipDeviceGetAttribute(&cus, hipDeviceAttributeMultiprocessorCount, dev) != hipSuccess) { fprintf(stderr, "kernel_launch: device query failed\n"); grid = -1; return; }
        if (hipFuncSetAttribute((const void*)trunk_fwd, hipFuncAttributeMaxDynamicSharedMemorySize, LDS_BYTES) != hipSuccess) { fprintf(stderr, "kernel_launch: hipFuncSetAttribute failed\n"); grid = -1; return; }
        if (hipOccupancyMaxActiveBlocksPerMultiprocessor(&per_cu, (const void*)trunk_fwd, NWAVES * 64, LDS_BYTES) != hipSuccess || per_cu < 1)
            fprintf(stderr, "kernel_launch: note: occupancy query reports %d workgroups per CU\n", per_cu);
        (void)hipGetLastError();
        grid = cus;
    }
    if (grid < 0) return;
    if (hipMemsetAsync((char*)d_ws + WS_CTL, 0, CTL_ZERO_BYTES, stream) != hipSuccess) { fprintf(stderr, "kernel_launch: hipMemsetAsync failed\n"); return; }
    Args a{};
    for (int i = 0; i < 22; ++i) a.in[i] = (const float*)d_in[i];
    a.out = (float*)d_out; a.ws = (unsigned char*)d_ws;
#if MK_N_LAUNCHES == 1
    a.ph_lo = 0; a.ph_hi = NPH;
    hipLaunchKernelGGL(trunk_fwd, dim3(grid), dim3(NWAVES * 64), LDS_BYTES, stream, a);
#else
    for (int p = 0; p < NPH; ++p) { a.ph_lo = p; a.ph_hi = p + 1; hipLaunchKernelGGL(trunk_fwd, dim3(grid), dim3(NWAVES * 64), LDS_BYTES, stream, a); }
#endif
    const hipError_t le = hipPeekAtLastError();
    if (le != hipSuccess) fprintf(stderr, "kernel_launch: launch failed: %s\n", hipGetErrorName(le));
}
```
